# Optimizing an MI355X kernel written in HIP

```python
import math
import jax, jax.numpy as jnp
from jax import lax
import numpy as np

D_MODEL = 1024
BATCH = 8
SEQ = 2048
DEPTH = 1
DEC_BATCH = 128
DEC_SEQ = 8
PAST_LEN = 16384
PAGE_SIZE = 128

D_MIX = 2 * D_MODEL
CONV_K = 4
CHUNK = 64
DN_HEADS = 8
DN_DK = 128
DN_DV = 128
DN_WIDTH = DN_HEADS * DN_DV
DN_QKV = 2 * DN_HEADS * DN_DK + DN_WIDTH
SSM_HEADDIM = 64
SSM_HEADS = (D_MIX - DN_WIDTH) // SSM_HEADDIM
SSM_GROUPS = 2
SSM_HPG = SSM_HEADS // SSM_GROUPS
SSM_STATE = 128
SSM_WIDTH = SSM_HEADS * SSM_HEADDIM
SSM_XBC = SSM_WIDTH + 2 * SSM_GROUPS * SSM_STATE
IN_SIZES = (DN_QKV, SSM_XBC, DN_WIDTH, SSM_WIDTH, DN_HEADS, DN_HEADS, SSM_HEADS)
D_IN_PROJ = DN_QKV + SSM_XBC + DN_WIDTH + SSM_WIDTH + 2 * DN_HEADS + SSM_HEADS
MEM_LEN = 256
MEM_HEADS = 4
MEM_HD = D_MODEL // MEM_HEADS
PEER_HEADS = 8
PEER_NKEYS = 128
PEER_EXPERTS = PEER_NKEYS * PEER_NKEYS
PEER_TOPK = 16
PEER_DKEY = 256
PEER_HALF = PEER_DKEY // 2
PEER_BLOCK = 256
EPS = 1e-6

kernel_name = 'hybrid_deltanet_ssd_peer_decoder'


def rmsnorm(x, w):
    xf = x.astype(jnp.float32)
    y = xf * lax.rsqrt(jnp.mean(xf * xf, axis=-1, keepdims=True) + EPS)
    return (y * w.astype(jnp.float32)).astype(x.dtype)


def l2norm(x):
    xf = x.astype(jnp.float32)
    return (xf * lax.rsqrt(jnp.sum(xf * xf, axis=-1, keepdims=True) + EPS)).astype(x.dtype)


def split_cols(t, sizes):
    out, o = [], 0
    for s in sizes:
        out.append(t[..., o:o + s])
        o += s
    return out


def causal_dwconv(x, buf, w, b=None):
    xp = jnp.concatenate([buf.astype(x.dtype), x], axis=1)
    c = x.shape[-1]
    y = lax.conv_general_dilated(xp, w[:, None, :], window_strides=(1,), padding='VALID',
                                 dimension_numbers=('NWC', 'WIO', 'NWC'), feature_group_count=c)
    if b is not None:
        y = y + b
    return y, xp[:, -(CONV_K - 1):]


def _pad_time(t, pad):
    return jnp.pad(t, [(0, 0), (0, pad)] + [(0, 0)] * (t.ndim - 2))


def _to_chunks(t, nc):
    b = t.shape[0]
    t = t.reshape((b, nc, CHUNK) + t.shape[2:])
    return t.transpose((1, 0, 3, 2) + tuple(range(4, t.ndim)))


def gated_delta_rule(q, k, v, beta, g, s0):
    f32 = jnp.float32
    b, l, h, _ = q.shape
    dv = v.shape[-1]
    nc = -(-l // CHUNK)
    pad = nc * CHUNK - l
    q, k, v, beta, g = [_to_chunks(_pad_time(t.astype(f32), pad), nc) for t in (q, k, v, beta, g)]
    gc = jnp.cumsum(g, axis=-1)
    incl = jnp.tril(jnp.ones((CHUNK, CHUNK), bool))
    strict = jnp.tril(jnp.ones((CHUNK, CHUNK), bool), -1)
    diff = gc[..., :, None] - gc[..., None, :]
    decay = jnp.where(incl, jnp.exp(jnp.where(incl, diff, 0.0)), 0.0)
    kb = k * beta[..., None]
    lower = jnp.where(strict, jnp.einsum('nbhid,nbhjd->nbhij', kb, k) * decay, 0.0)
    rhs = jnp.concatenate([v * beta[..., None], kb * jnp.exp(gc)[..., None]], axis=-1)
    uw = lax.linalg.triangular_solve(jnp.eye(CHUNK, dtype=f32) + lower, rhs,
                                     left_side=True, lower=True, unit_diagonal=True)
    u, w = uw[..., :dv], uw[..., dv:]
    attn = jnp.einsum('nbhid,nbhjd->nbhij', q, k) * decay
    q_dec = q * jnp.exp(gc)[..., None]
    k_dec = k * jnp.exp(gc[..., -1:] - gc)[..., None]
    g_tot = jnp.exp(gc[..., -1])

    def step(s, inp):
        u_c, w_c, qd_c, kd_c, a_c, gt_c = inp
        v_new = u_c - jnp.einsum('bhcd,bhde->bhce', w_c, s)
        o_c = jnp.einsum('bhcd,bhde->bhce', qd_c, s) + jnp.einsum('bhij,bhje->bhie', a_c, v_new)
        s = s * gt_c[..., None, None] + jnp.einsum('bhcd,bhce->bhde', kd_c, v_new)
        return s, o_c

    s, o = lax.scan(step, s0.astype(f32), (u, w, q_dec, k_dec, attn, g_tot))
    o = o.transpose(1, 0, 3, 2, 4).reshape(b, nc * CHUNK, h, dv)[:, :l]
    return o, s


def ssd_scan(x, dt, a_head, bm, cm, s0):
    f32 = jnp.float32
    b, l, ng, ne, p = x.shape
    n = bm.shape[-1]
    nc = -(-l // CHUNK)
    pad = nc * CHUNK - l
    dt = dt.astype(f32)
    xd = _pad_time(x.astype(f32) * dt[..., None], pad).reshape(b, nc, CHUNK, ng, ne, p)
    ac = _pad_time(dt * a_head, pad).reshape(b, nc, CHUNK, ng, ne).transpose(0, 1, 3, 4, 2)
    bc = _pad_time(bm.astype(f32), pad).reshape(b, nc, CHUNK, ng, n)
    cc = _pad_time(cm.astype(f32), pad).reshape(b, nc, CHUNK, ng, n)
    acs = jnp.cumsum(ac, axis=-1)
    incl = jnp.tril(jnp.ones((CHUNK, CHUNK), bool))
    diff = acs[..., :, None] - acs[..., None, :]
    lmat = jnp.where(incl, jnp.exp(jnp.where(incl, diff, 0.0)), 0.0)
    cb = jnp.einsum('bclgn,bcsgn->bcgls', cc, bc)
    y_diag = jnp.einsum('bcgls,bcgels,bcsgep->bclgep', cb, lmat, xd)
    ends = jnp.exp(acs[..., -1:] - acs)
    states = jnp.einsum('bclgn,bcgel,bclgep->bcgepn', bc, ends, xd)
    chunk_decay = jnp.exp(acs[..., -1])

    def step(hs, inp):
        st, dc = inp
        return hs * dc[..., None, None] + st, hs

    s, prev = lax.scan(step, s0.astype(f32), (jnp.moveaxis(states, 1, 0), jnp.moveaxis(chunk_decay, 1, 0)))
    prev = jnp.moveaxis(prev, 0, 1)
    y_off = jnp.einsum('bclgn,bcgepn,bcgel->bclgep', cc, prev, jnp.exp(acs))
    y = (y_diag + y_off).reshape(b, nc * CHUNK, ng, ne, p)[:, :l]
    return y, s


def memory_kv(mem, g_mem, w_mkv):
    b, m, _ = mem.shape
    mk, mv = split_cols(rmsnorm(mem, g_mem) @ w_mkv, (D_MODEL, D_MODEL))
    return mk.reshape(b, m, MEM_HEADS, MEM_HD), mv.reshape(b, m, MEM_HEADS, MEM_HD)


def memory_cross_attention(c, mem_k, mem_v, w_xq, w_xo):
    b, l, _ = c.shape
    q = (c @ w_xq).reshape(b, l, MEM_HEADS, MEM_HD)
    s = jnp.einsum('blhd,bmhd->bhlm', q, mem_k.astype(c.dtype)).astype(jnp.float32) * (MEM_HD ** -0.5)
    pr = jax.nn.softmax(s, axis=-1).astype(c.dtype)
    o = jnp.einsum('bhlm,bmhd->blhd', pr, mem_v.astype(c.dtype)).reshape(b, l, D_MODEL)
    return o @ w_xo


def peer_ffn(h, w_pq, sub_keys, peer_u, peer_v):
    bsz, l, d = h.shape
    n = bsz * l
    nb = -(-n // PEER_BLOCK)
    t = jnp.pad(h.reshape(n, d), ((0, nb * PEER_BLOCK - n), (0, 0))).reshape(nb, PEER_BLOCK, d)

    def block(tb):
        q = (tb @ w_pq).reshape(PEER_BLOCK, PEER_HEADS, 2, PEER_HALF)
        s = jnp.einsum('thcd,ckd->thck', q, sub_keys).astype(jnp.float32)
        s_top, i_top = lax.top_k(s, PEER_TOPK)
        cand_s = (s_top[:, :, 0, :, None] + s_top[:, :, 1, None, :]).reshape(PEER_BLOCK, PEER_HEADS, PEER_TOPK * PEER_TOPK)
        cand_i = (i_top[:, :, 0, :, None] * PEER_NKEYS + i_top[:, :, 1, None, :]).reshape(PEER_BLOCK, PEER_HEADS, PEER_TOPK * PEER_TOPK)
        best_s, pos = lax.top_k(cand_s, PEER_TOPK)
        idx = jnp.take_along_axis(cand_i, pos, axis=-1)
        gate = jax.nn.softmax(best_s, axis=-1).astype(tb.dtype)
        act = jax.nn.gelu(jnp.einsum('thkd,td->thk', peer_u[idx], tb), approximate=False)
        return jnp.einsum('thk,thkd->td', gate * act, peer_v[idx])

    out = lax.map(block, t)
    return out.reshape(nb * PEER_BLOCK, d)[:n].reshape(bsz, l, d)


def trunk_layer(x, mem_k, mem_v, dn_buf, dn_s, ssm_buf, ssm_s,
                g_mix, w_in, dn_conv_w, dn_A_log, dn_dt_bias, dn_norm_w,
                ssm_conv_w, ssm_conv_b, ssm_A_log, ssm_dt_bias, ssm_D, ssm_norm_w, w_out,
                g_xattn, w_xq, w_xo, g_ffn, w_pq, peer_sub_keys, peer_u, peer_v):
    f32 = jnp.float32
    bsz, l, _ = x.shape
    dtype = x.dtype
    proj = rmsnorm(x, g_mix) @ w_in
    qkv, xbc, z_dn, z_ssm, beta_raw, alpha_raw, dt_raw = split_cols(proj, IN_SIZES)
    qkv, dn_buf_new = causal_dwconv(qkv, dn_buf, dn_conv_w)
    q, k, v = split_cols(jax.nn.silu(qkv), (DN_HEADS * DN_DK, DN_HEADS * DN_DK, DN_WIDTH))
    q = l2norm(q.reshape(bsz, l, DN_HEADS, DN_DK)) * (DN_DK ** -0.5)
    k = l2norm(k.reshape(bsz, l, DN_HEADS, DN_DK))
    v = v.reshape(bsz, l, DN_HEADS, DN_DV)
    beta = jax.nn.sigmoid(beta_raw.astype(f32))
    g = -jnp.exp(dn_A_log.astype(f32)) * jax.nn.softplus(alpha_raw.astype(f32) + dn_dt_bias.astype(f32))
    o, dn_s_new = gated_delta_rule(q, k, v, beta, g, dn_s)
    o = rmsnorm(o.astype(dtype), dn_norm_w) * jax.nn.silu(z_dn.reshape(bsz, l, DN_HEADS, DN_DV))
    o_dn = o.reshape(bsz, l, DN_WIDTH)
    xbc, ssm_buf_new = causal_dwconv(xbc, ssm_buf, ssm_conv_w, ssm_conv_b)
    xs, bm, cm = split_cols(jax.nn.silu(xbc), (SSM_WIDTH, SSM_GROUPS * SSM_STATE, SSM_GROUPS * SSM_STATE))
    xs = xs.reshape(bsz, l, SSM_GROUPS, SSM_HPG, SSM_HEADDIM)
    bm = bm.reshape(bsz, l, SSM_GROUPS, SSM_STATE)
    cm = cm.reshape(bsz, l, SSM_GROUPS, SSM_STATE)
    dt = jax.nn.softplus(dt_raw.astype(f32) + ssm_dt_bias.astype(f32)).reshape(bsz, l, SSM_GROUPS, SSM_HPG)
    a_head = -jnp.exp(ssm_A_log.astype(f32)).reshape(SSM_GROUPS, SSM_HPG)
    y, ssm_s_new = ssd_scan(xs, dt, a_head, bm, cm,
                            ssm_s.reshape(bsz, SSM_GROUPS, SSM_HPG, SSM_HEADDIM, SSM_STATE))
    y = y + ssm_D.astype(f32).reshape(SSM_GROUPS, SSM_HPG)[..., None] * xs.astype(f32)
    y = y.astype(dtype) * jax.nn.silu(z_ssm.reshape(bsz, l, SSM_GROUPS, SSM_HPG, SSM_HEADDIM))
    y = rmsnorm(y.reshape(bsz, l, SSM_GROUPS, SSM_WIDTH // SSM_GROUPS), ssm_norm_w.reshape(SSM_GROUPS, -1))
    o_ssm = y.reshape(bsz, l, SSM_WIDTH)
    x = x + jnp.concatenate([o_dn, o_ssm], axis=-1) @ w_out
    x = x + memory_cross_attention(rmsnorm(x, g_xattn), mem_k, mem_v, w_xq, w_xo)
    x = x + peer_ffn(rmsnorm(x, g_ffn), w_pq, peer_sub_keys, peer_u, peer_v)
    ssm_s_out = ssm_s_new.reshape(bsz, SSM_HEADS, SSM_HEADDIM, SSM_STATE).astype(dtype)
    return x, dn_buf_new, dn_s_new.astype(dtype), ssm_buf_new, ssm_s_out


def setup_inputs(seed: int = 0) -> dict:
    key = jax.random.key(seed)
    ks = jax.random.split(key, 40)
    f32 = jnp.float32

    def nrm(i, shape, scale):
        return jax.random.normal(ks[i], shape, f32) * scale

    def gain(i, shape):
        return 1.0 + 0.05 * jax.random.normal(ks[i], shape, f32)

    def a_log(i, n):
        return jnp.log(jax.random.uniform(ks[i], (DEPTH, n), f32, 1.0, 16.0))

    def dt_bias(i, n):
        dt = jnp.exp(jax.random.uniform(ks[i], (DEPTH, n), f32, math.log(1e-3), math.log(1e-1)))
        return dt + jnp.log(-jnp.expm1(-dt))

    return {
        'x_prompt': nrm(0, (BATCH, SEQ, D_MODEL), 1.0),
        'x_sample': nrm(1, (DEC_BATCH, DEC_SEQ, D_MODEL), 1.0),
        'state_dn_conv': nrm(2, (DEPTH, DEC_BATCH, CONV_K - 1, DN_QKV), 1.0),
        'state_dn': nrm(3, (DEPTH, DEC_BATCH, DN_HEADS, DN_DK, DN_DV), 0.1),
        'state_ssm_conv': nrm(4, (DEPTH, DEC_BATCH, CONV_K - 1, SSM_XBC), 1.0),
        'state_ssm': nrm(5, (DEPTH, DEC_BATCH, SSM_HEADS, SSM_HEADDIM, SSM_STATE), 0.1),
        'cache_mem_k': nrm(6, (DEPTH, DEC_BATCH, MEM_LEN, MEM_HEADS, MEM_HD), 1.0),
        'cache_mem_v': nrm(7, (DEPTH, DEC_BATCH, MEM_LEN, MEM_HEADS, MEM_HD), 1.0),
        'mem_prompt': nrm(8, (BATCH, MEM_LEN, D_MODEL), 1.0),
        'g_mix': gain(9, (DEPTH, D_MODEL)),
        'w_in': nrm(10, (DEPTH, D_MODEL, D_IN_PROJ), D_MODEL ** -0.5),
        'dn_conv_w': nrm(11, (DEPTH, CONV_K, DN_QKV), CONV_K ** -0.5),
        'dn_A_log': a_log(12, DN_HEADS),
        'dn_dt_bias': dt_bias(13, DN_HEADS),
        'dn_norm_w': gain(14, (DEPTH, DN_DV)),
        'ssm_conv_w': nrm(15, (DEPTH, CONV_K, SSM_XBC), CONV_K ** -0.5),
        'ssm_conv_b': nrm(16, (DEPTH, SSM_XBC), 0.02),
        'ssm_A_log': a_log(17, SSM_HEADS),
        'ssm_dt_bias': dt_bias(18, SSM_HEADS),
        'ssm_D': gain(19, (DEPTH, SSM_HEADS)),
        'ssm_norm_w': gain(20, (DEPTH, SSM_WIDTH)),
        'w_out': nrm(21, (DEPTH, D_MIX, D_MODEL), D_MIX ** -0.5),
        'g_xattn': gain(22, (DEPTH, D_MODEL)),
        'g_mem': gain(23, (DEPTH, D_MODEL)),
        'w_xq': nrm(24, (DEPTH, D_MODEL, D_MODEL), D_MODEL ** -0.5),
        'w_mkv': nrm(25, (DEPTH, D_MODEL, 2 * D_MODEL), D_MODEL ** -0.5),
        'w_xo': nrm(26, (DEPTH, D_MODEL, D_MODEL), D_MODEL ** -0.5),
        'g_ffn': gain(27, (DEPTH, D_MODEL)),
        'w_pq': nrm(28, (DEPTH, D_MODEL, PEER_HEADS * PEER_DKEY), D_MODEL ** -0.5),
        'peer_sub_keys': nrm(29, (DEPTH, 2, PEER_NKEYS, PEER_HALF), PEER_HALF ** -0.5),
        'peer_u': nrm(30, (DEPTH, PEER_EXPERTS, D_MODEL), D_MODEL ** -0.5),
        'peer_v': nrm(31, (DEPTH, PEER_EXPERTS, D_MODEL), 0.25),
        'g_final': gain(32, (D_MODEL,)),
    }


def reference(x_prompt, x_sample, state_dn_conv, state_dn, state_ssm_conv, state_ssm,
              cache_mem_k, cache_mem_v, mem_prompt,
              g_mix, w_in, dn_conv_w, dn_A_log, dn_dt_bias, dn_norm_w,
              ssm_conv_w, ssm_conv_b, ssm_A_log, ssm_dt_bias, ssm_D, ssm_norm_w, w_out,
              g_xattn, g_mem, w_xq, w_mkv, w_xo, g_ffn, w_pq, peer_sub_keys, peer_u, peer_v, g_final):
    bp = x_prompt.shape[0]
    dtype = x_prompt.dtype
    hp, hs = x_prompt, x_sample
    p_dnc, p_dn, p_sc, p_ss, p_mk, p_mv = [], [], [], [], [], []
    s_dnc, s_dn, s_sc, s_ss = [], [], [], []
    for i in range(DEPTH):
        lp = (g_mix[i], w_in[i], dn_conv_w[i], dn_A_log[i], dn_dt_bias[i], dn_norm_w[i],
              ssm_conv_w[i], ssm_conv_b[i], ssm_A_log[i], ssm_dt_bias[i], ssm_D[i], ssm_norm_w[i], w_out[i],
              g_xattn[i], w_xq[i], w_xo[i], g_ffn[i], w_pq[i], peer_sub_keys[i], peer_u[i], peer_v[i])
        mk_p, mv_p = memory_kv(mem_prompt, g_mem[i], w_mkv[i])
        hp, dnc, dns, sc, ss = trunk_layer(
            hp, mk_p, mv_p,
            jnp.zeros((bp, CONV_K - 1, DN_QKV), dtype),
            jnp.zeros((bp, DN_HEADS, DN_DK, DN_DV), dtype),
            jnp.zeros((bp, CONV_K - 1, SSM_XBC), dtype),
            jnp.zeros((bp, SSM_HEADS, SSM_HEADDIM, SSM_STATE), dtype),
            *lp)
        p_dnc.append(dnc); p_dn.append(dns); p_sc.append(sc); p_ss.append(ss)
        p_mk.append(mk_p); p_mv.append(mv_p)
        hs, dnc, dns, sc, ss = trunk_layer(
            hs, cache_mem_k[i], cache_mem_v[i],
            state_dn_conv[i], state_dn[i], state_ssm_conv[i], state_ssm[i], *lp)
        s_dnc.append(dnc); s_dn.append(dns); s_sc.append(sc); s_ss.append(ss)
    y_prompt = rmsnorm(hp, g_final)
    y_sample = rmsnorm(hs, g_final)
    return (y_prompt, y_sample,
            jnp.stack(p_dnc), jnp.stack(p_dn), jnp.stack(p_sc), jnp.stack(p_ss),
            jnp.stack(p_mk), jnp.stack(p_mv),
            jnp.stack(s_dnc), jnp.stack(s_dn), jnp.stack(s_sc), jnp.stack(s_ss))
```

```cpp
#include <hip/hip_runtime.h>
#include <stdint.h>
#include <stdio.h>

constexpr int D = 1024, BATCH = 8, SEQ = 2048, DECB = 128, DECS = 8;
constexpr int TP = BATCH * SEQ, TS = DECB * DECS, T = TP + TS;
constexpr int DN_QKV = 3072, SSM_XBC = 1536, NPROJ = 6688;
constexpr size_t O_Y = 0;
constexpr size_t O_P_DNC = 17825792, O_P_DN = 17899520, O_P_SC = 18948096, O_P_SS = 18984960, O_P_MK = 20033536, O_P_MV = 22130688;
constexpr size_t O_S_DNC = 24227840, O_S_DN = 25407488, O_S_SC = 42184704, O_S_SS = 42774528;

namespace nv {

__device__ __forceinline__ float siluf(float x) { return x / (1.0f + expf(-x)); }
__device__ __forceinline__ float sigmoidf(float x) { return 1.0f / (1.0f + expf(-x)); }
__device__ __forceinline__ float softplusf(float x) { return x > 20.f ? x : log1pf(expf(x)); }
__device__ __forceinline__ float geluf(float x) { return 0.5f * x * (1.0f + erff(x * 0.70710678118654752f)); }

__device__ __forceinline__ float block_sum(float v, float* red) {
    for (int o = 32; o > 0; o >>= 1) v += __shfl_xor(v, o);
    const int w = threadIdx.x >> 6, nw = blockDim.x >> 6;
    __syncthreads();
    if ((threadIdx.x & 63) == 0) red[w] = v;
    __syncthreads();
    float s = 0.f;
    for (int i = 0; i < nw; ++i) s += red[i];
    return s;
}
__device__ __forceinline__ float block_max(float v, float* red) {
    for (int o = 32; o > 0; o >>= 1) v = fmaxf(v, __shfl_xor(v, o));
    const int w = threadIdx.x >> 6, nw = blockDim.x >> 6;
    __syncthreads();
    if ((threadIdx.x & 63) == 0) red[w] = v;
    __syncthreads();
    float s = red[0];
    for (int i = 1; i < nw; ++i) s = fmaxf(s, red[i]);
    return s;
}

__global__ void __launch_bounds__(256) rmsnorm_rows(const float* __restrict__ x, const float* __restrict__ g, float* __restrict__ out) {
    __shared__ float red[16];
    const size_t r = blockIdx.x;
    const float4 v = ((const float4*)(x + r * 1024))[threadIdx.x];
    float ss = v.x * v.x + v.y * v.y + v.z * v.z + v.w * v.w;
    ss = block_sum(ss, red);
    const float rstd = rsqrtf(ss * (1.0f / 1024.0f) + 1e-6f);
    const float4 gg = ((const float4*)g)[threadIdx.x];
    float4 o; o.x = v.x * rstd * gg.x; o.y = v.y * rstd * gg.y; o.z = v.z * rstd * gg.z; o.w = v.w * rstd * gg.w;
    ((float4*)(out + r * 1024))[threadIdx.x] = o;
}

__global__ void __launch_bounds__(256) gemm_f32(const float* __restrict__ A, int lda, const float* __restrict__ B, int ldb, float* __restrict__ C, int ldc,
                                                int M, int N, int K, const float* __restrict__ R, int ldr) {
    __shared__ float As[16][65];
    __shared__ float Bs[16][65];
    const int tx = threadIdx.x & 15, ty = threadIdx.x >> 4;
    const int m0 = blockIdx.y * 64, n0 = blockIdx.x * 64;
    float acc[4][4];
    for (int i = 0; i < 4; ++i) for (int j = 0; j < 4; ++j) acc[i][j] = 0.f;
    for (int k0 = 0; k0 < K; k0 += 16) {
        for (int e = threadIdx.x; e < 64 * 16; e += 256) {
            const int r = e >> 4, c = e & 15;
            As[c][r] = A[(size_t)(m0 + r) * lda + k0 + c];
            const int kr = e >> 6, nc = e & 63;
            Bs[kr][nc] = (n0 + nc < N) ? B[(size_t)(k0 + kr) * ldb + n0 + nc] : 0.f;
        }
        __syncthreads();
#pragma unroll
        for (int k = 0; k < 16; ++k) {
            float a[4], b[4];
#pragma unroll
            for (int i = 0; i < 4; ++i) a[i] = As[k][ty * 4 + i];
#pragma unroll
            for (int j = 0; j < 4; ++j) b[j] = Bs[k][tx * 4 + j];
#pragma unroll
            for (int i = 0; i < 4; ++i)
#pragma unroll
                for (int j = 0; j < 4; ++j) acc[i][j] += a[i] * b[j];
        }
        __syncthreads();
    }
    for (int i = 0; i < 4; ++i)
        for (int j = 0; j < 4; ++j) {
            const int m = m0 + ty * 4 + i, n = n0 + tx * 4 + j;
            if (n < N) { float v = acc[i][j]; if (R) v += R[(size_t)m * ldr + n]; C[(size_t)m * ldc + n] = v; }
        }
}

__device__ __forceinline__ float preconv(const float* __restrict__ proj, int t0, int l, int col, const float* __restrict__ buf, int b, int width, int c) {
    if (l >= 0) return proj[(size_t)(t0 + l) * NPROJ + col];
    if (!buf) return 0.f;
    return buf[((size_t)b * 3 + (3 + l)) * width + c];
}

__global__ void __launch_bounds__(128) dn_naive(const float* __restrict__ proj, const float* __restrict__ conv_state, const float* __restrict__ state_in,
                                                const float* __restrict__ conv_w, const float* __restrict__ A_log, const float* __restrict__ dt_bias,
                                                const float* __restrict__ norm_w, float* __restrict__ ocat, float* __restrict__ p_state, float* __restrict__ s_state) {
    __shared__ float red[16];
    __shared__ float ks[128], qs[128];
    const int bid = blockIdx.x, j = threadIdx.x;
    const bool prompt = bid < 64;
    int b, h, L, t0;
    if (prompt) { b = bid / 8; h = bid % 8; L = SEQ; t0 = b * SEQ; } else { const int bb = bid - 64; b = bb / 8; h = bb % 8; L = DECS; t0 = TP + b * DECS; }
    float S[128];
    for (int i = 0; i < 128; ++i) S[i] = prompt ? 0.f : state_in[(((size_t)b * 8 + h) * 128 + i) * 128 + j];
    const int cq = h * 128 + j, ck = 1024 + h * 128 + j, cv = 2048 + h * 128 + j;
    float wq[4], wk[4], wv[4];
    for (int tp = 0; tp < 4; ++tp) { wq[tp] = conv_w[tp * DN_QKV + cq]; wk[tp] = conv_w[tp * DN_QKV + ck]; wv[tp] = conv_w[tp * DN_QKV + cv]; }
    const float* buf = prompt ? nullptr : conv_state;
    const float Ah = -expf(A_log[h]), dtb = dt_bias[h], nw = norm_w[j];
    for (int l = 0; l < L; ++l) {
        float q = 0.f, k = 0.f, v = 0.f;
        for (int tp = 0; tp < 4; ++tp) {
            q += wq[tp] * preconv(proj, t0, l - 3 + tp, cq, buf, b, DN_QKV, cq);
            k += wk[tp] * preconv(proj, t0, l - 3 + tp, ck, buf, b, DN_QKV, ck);
            v += wv[tp] * preconv(proj, t0, l - 3 + tp, cv, buf, b, DN_QKV, cv);
        }
        q = siluf(q); k = siluf(k); v = siluf(v);
        const float sq = block_sum(q * q, red);
        const float sk2 = block_sum(k * k, red);
        q = q * rsqrtf(sq + 1e-6f) * 0.08838834764831845f;
        k = k * rsqrtf(sk2 + 1e-6f);
        const size_t t = (size_t)(t0 + l);
        const float beta = sigmoidf(proj[t * NPROJ + 6656 + h]);
        const float g = Ah * softplusf(proj[t * NPROJ + 6664 + h] + dtb);
        const float a = expf(g);
        __syncthreads();
        ks[j] = k; qs[j] = q;
        __syncthreads();
        float sk = 0.f;
        for (int i = 0; i < 128; ++i) { S[i] *= a; sk += S[i] * ks[i]; }
        const float delta = beta * (v - sk);
        float o = 0.f;
        for (int i = 0; i < 128; ++i) { S[i] += ks[i] * delta; o += S[i] * qs[i]; }
        const float so = block_sum(o * o, red);
        const float rstd = rsqrtf(so * (1.0f / 128.0f) + 1e-6f);
        const float z = proj[t * NPROJ + 4608 + h * 128 + j];
        ocat[t * 2048 + h * 128 + j] = o * rstd * nw * siluf(z);
    }
    float* so = prompt ? p_state : s_state;
    for (int i = 0; i < 128; ++i) so[(((size_t)b * 8 + h) * 128 + i) * 128 + j] = S[i];
}

__global__ void __launch_bounds__(64) ssd_naive(const float* __restrict__ proj, const float* __restrict__ conv_state, const float* __restrict__ state_in,
                                                const float* __restrict__ conv_w, const float* __restrict__ conv_b, const float* __restrict__ A_log,
                                                const float* __restrict__ dt_bias, const float* __restrict__ Dp, float* __restrict__ yg,
                                                float* __restrict__ p_state, float* __restrict__ s_state) {
    __shared__ float Bs[128], Cs[128];
    const int bid = blockIdx.x, p = threadIdx.x;
    const bool prompt = bid < 128;
    int b, hd, L, t0;
    if (prompt) { b = bid / 16; hd = bid % 16; L = SEQ; t0 = b * SEQ; } else { const int bb = bid - 128; b = bb / 16; hd = bb % 16; L = DECS; t0 = TP + b * DECS; }
    const int g = hd / 8;
    float hs[128];
    for (int n = 0; n < 128; ++n) hs[n] = prompt ? 0.f : state_in[(((size_t)b * 16 + hd) * 64 + p) * 128 + n];
    const float* buf = prompt ? nullptr : conv_state;
    const float Ah = -expf(A_log[hd]), dtb = dt_bias[hd], Dh = Dp[hd];
    const int cx = hd * 64 + p;
    for (int l = 0; l < L; ++l) {
        const size_t t = (size_t)(t0 + l);
        float x = conv_b[cx];
        for (int tp = 0; tp < 4; ++tp) x += conv_w[tp * SSM_XBC + cx] * preconv(proj, t0, l - 3 + tp, 3072 + cx, buf, b, SSM_XBC, cx);
        x = siluf(x);
        __syncthreads();
        for (int r = 0; r < 2; ++r) {
            const int n = p + 64 * r;
            const int cb = 1024 + g * 128 + n, cc = 1280 + g * 128 + n;
            float bv = conv_b[cb], cv = conv_b[cc];
            for (int tp = 0; tp < 4; ++tp) {
                bv += conv_w[tp * SSM_XBC + cb] * preconv(proj, t0, l - 3 + tp, 3072 + cb, buf, b, SSM_XBC, cb);
                cv += conv_w[tp * SSM_XBC + cc] * preconv(proj, t0, l - 3 + tp, 3072 + cc, buf, b, SSM_XBC, cc);
            }
            Bs[n] = siluf(bv); Cs[n] = siluf(cv);
        }
        __syncthreads();
        const float dt = softplusf(proj[t * NPROJ + 6672 + hd] + dtb);
        const float dA = expf(dt * Ah);
        const float dx = dt * x;
        float y = 0.f;
        for (int n = 0; n < 128; ++n) { hs[n] = dA * hs[n] + dx * Bs[n]; y += hs[n] * Cs[n]; }
        y += Dh * x;
        const float z = proj[t * NPROJ + 5632 + cx];
        yg[t * 1024 + cx] = y * siluf(z);
    }
    float* so = prompt ? p_state : s_state;
    for (int n = 0; n < 128; ++n) so[(((size_t)b * 16 + hd) * 64 + p) * 128 + n] = hs[n];
}

__global__ void __launch_bounds__(256) ssd_groupnorm(const float* __restrict__ yg, const float* __restrict__ w, float* __restrict__ ocat) {
    __shared__ float red[4];
    const size_t t = blockIdx.x;
    const int tid = threadIdx.x;
    const float4 v = ((const float4*)(yg + t * 1024))[tid];
    float ss = v.x * v.x + v.y * v.y + v.z * v.z + v.w * v.w;
    for (int o = 32; o > 0; o >>= 1) ss += __shfl_xor(ss, o);
    if ((tid & 63) == 0) red[tid >> 6] = ss;
    __syncthreads();
    const int gq = tid >> 7;
    const float tot = red[2 * gq] + red[2 * gq + 1];
    const float rstd = rsqrtf(tot * (1.0f / 512.0f) + 1e-6f);
    const float4 ww = ((const float4*)w)[tid];
    float4 o; o.x = v.x * rstd * ww.x; o.y = v.y * rstd * ww.y; o.z = v.z * rstd * ww.z; o.w = v.w * rstd * ww.w;
    ((float4*)(ocat + t * 2048 + 1024))[tid] = o;
}

__global__ void __launch_bounds__(256) conv_state_out(const float* __restrict__ proj, float* __restrict__ p_dnc, float* __restrict__ p_sc, float* __restrict__ s_dnc, float* __restrict__ s_sc) {
    const int bid = blockIdx.x;
    const bool prompt = bid < 8;
    const int b = prompt ? bid : bid - 8;
    const int tlast = prompt ? (b * SEQ + SEQ - 3) : (TP + b * DECS + DECS - 3);
    float* dnc = (prompt ? p_dnc : s_dnc) + (size_t)b * 3 * DN_QKV;
    float* sc = (prompt ? p_sc : s_sc) + (size_t)b * 3 * SSM_XBC;
    for (int r = 0; r < 3; ++r) {
        for (int c = threadIdx.x; c < DN_QKV; c += 256) dnc[r * DN_QKV + c] = proj[(size_t)(tlast + r) * NPROJ + c];
        for (int c = threadIdx.x; c < SSM_XBC; c += 256) sc[r * SSM_XBC + c] = proj[(size_t)(tlast + r) * NPROJ + 3072 + c];
    }
}

__global__ void __launch_bounds__(256) attn_naive(const float* __restrict__ q, const float* __restrict__ mk, const float* __restrict__ mv,
                                                  const float* __restrict__ ck, const float* __restrict__ cvv, float* __restrict__ o) {
    __shared__ float red[16];
    __shared__ float qs[256];
    __shared__ float ps[256];
    const int t = blockIdx.x, tid = threadIdx.x;
    const float* K; const float* V;
    if (t < TP) { const int b = t / SEQ; K = mk + (size_t)b * 256 * 1024; V = mv + (size_t)b * 256 * 1024; }
    else { const int b = (t - TP) / DECS; K = ck + (size_t)b * 256 * 1024; V = cvv + (size_t)b * 256 * 1024; }
    for (int h = 0; h < 4; ++h) {
        __syncthreads();
        qs[tid] = q[(size_t)t * 1024 + h * 256 + tid];
        __syncthreads();
        const float4* kr = (const float4*)(K + (size_t)tid * 1024 + h * 256);
        float s = 0.f;
        for (int d4 = 0; d4 < 64; ++d4) { const float4 kv = kr[d4]; s += kv.x * qs[4 * d4] + kv.y * qs[4 * d4 + 1] + kv.z * qs[4 * d4 + 2] + kv.w * qs[4 * d4 + 3]; }
        s *= 0.0625f;
        const float mx = block_max(s, red);
        const float e = expf(s - mx);
        const float sum = block_sum(e, red);
        ps[tid] = e / sum;
        __syncthreads();
        float acc = 0.f;
        for (int m = 0; m < 256; ++m) acc += ps[m] * V[(size_t)m * 1024 + h * 256 + tid];
        o[(size_t)t * 1024 + h * 256 + tid] = acc;
    }
}

__global__ void __launch_bounds__(256) peer_naive(const float* __restrict__ pq, const float* __restrict__ tb, const float* __restrict__ h2,
                                                  const float* __restrict__ subk, const float* __restrict__ pu, const float* __restrict__ pv,
                                                  const float* __restrict__ gfin, float* __restrict__ y) {
    __shared__ float red[16];
    __shared__ float qv[2048];
    __shared__ float sc[2048];
    __shared__ float tops[16][16];
    __shared__ int topi[16][16];
    __shared__ int cnt[16];
    __shared__ float cand[8][256];
    __shared__ float bests[8][16];
    __shared__ int besti[8][16];
    __shared__ int cnt2[8];
    __shared__ float coef[128];
    __shared__ float xs[1024];
    const size_t t = blockIdx.x; const int tid = threadIdx.x;
    for (int i = tid; i < 2048; i += 256) qv[i] = pq[t * 2048 + i];
    for (int i = tid; i < 1024; i += 256) xs[i] = tb[t * 1024 + i];
    if (tid < 16) cnt[tid] = 0;
    if (tid < 8) cnt2[tid] = 0;
    __syncthreads();
    for (int s = tid; s < 2048; s += 256) {
        const int hc = s >> 7, k = s & 127, c = hc & 1;
        const float* kr = subk + ((size_t)c * 128 + k) * 128;
        const float* qr = qv + hc * 128;
        float a = 0.f;
        for (int d = 0; d < 128; ++d) a += qr[d] * kr[d];
        sc[s] = a;
    }
    __syncthreads();
    for (int s = tid; s < 2048; s += 256) {
        const int hc = s >> 7, k = s & 127;
        const float v = sc[s];
        int rank = 0;
        for (int k2 = 0; k2 < 128; ++k2) { const float w = sc[hc * 128 + k2]; rank += (w > v || (w == v && k2 < k)) ? 1 : 0; }
        if (rank < 16) { tops[hc][rank] = v; topi[hc][rank] = k; }
    }
    __syncthreads();
    for (int s = tid; s < 2048; s += 256) {
        const int h = s >> 8, ij = s & 255, i = ij >> 4, jj = ij & 15;
        cand[h][ij] = tops[h * 2][i] + tops[h * 2 + 1][jj];
    }
    __syncthreads();
    for (int s = tid; s < 2048; s += 256) {
        const int h = s >> 8, ij = s & 255;
        const float v = cand[h][ij];
        int rank = 0;
        for (int k2 = 0; k2 < 256; ++k2) { const float w = cand[h][k2]; rank += (w > v || (w == v && k2 < ij)) ? 1 : 0; }
        if (rank < 16) { bests[h][rank] = v; besti[h][rank] = topi[h * 2][ij >> 4] * 128 + topi[h * 2 + 1][ij & 15]; }
    }
    __syncthreads();
    {
        const int w = tid >> 6, lane = tid & 63;
        for (int pp = 0; pp < 32; ++pp) {
            const int p = w * 32 + pp, h = p >> 4, k = p & 15;
            const int e = besti[h][k];
            const float* ur = pu + (size_t)e * 1024;
            float a = 0.f;
            for (int d = lane; d < 1024; d += 64) a += ur[d] * xs[d];
            for (int o = 32; o > 0; o >>= 1) a += __shfl_xor(a, o);
            if (lane == 0) {
                float mx = bests[h][0];
                for (int k2 = 1; k2 < 16; ++k2) mx = fmaxf(mx, bests[h][k2]);
                float sum = 0.f;
                for (int k2 = 0; k2 < 16; ++k2) sum += expf(bests[h][k2] - mx);
                const float gate = expf(bests[h][k] - mx) / sum;
                coef[p] = gate * geluf(a);
            }
        }
    }
    __syncthreads();
    float4 acc = make_float4(0.f, 0.f, 0.f, 0.f);
    for (int p = 0; p < 128; ++p) {
        const int e = besti[p >> 4][p & 15];
        const float c = coef[p];
        const float4 vv = ((const float4*)(pv + (size_t)e * 1024))[tid];
        acc.x += c * vv.x; acc.y += c * vv.y; acc.z += c * vv.z; acc.w += c * vv.w;
    }
    const float4 hh = ((const float4*)(h2 + t * 1024))[tid];
    float4 r; r.x = hh.x + acc.x; r.y = hh.y + acc.y; r.z = hh.z + acc.z; r.w = hh.w + acc.w;
    float ss = r.x * r.x + r.y * r.y + r.z * r.z + r.w * r.w;
    ss = block_sum(ss, red);
    const float rstd = rsqrtf(ss * (1.0f / 1024.0f) + 1e-6f);
    const float4 gg = ((const float4*)gfin)[tid];
    float4 o; o.x = r.x * rstd * gg.x; o.y = r.y * rstd * gg.y; o.z = r.z * rstd * gg.z; o.w = r.w * rstd * gg.w;
    ((float4*)(y + t * 1024))[tid] = o;
}

}

static void gemm_naive(hipStream_t s, const float* A, int lda, const float* B, int ldb, float* C, int ldc, int M, int N, int K, const float* R, int ldr) {
    dim3 grid((N + 63) / 64, M / 64);
    nv::gemm_f32<<<grid, 256, 0, s>>>(A, lda, B, ldb, C, ldc, M, N, K, R, ldr);
}

extern "C" void kernel_launch(void* const* d_in, const int* in_sizes, int n_in, void* d_out, int out_size, void* d_ws, size_t ws_size, hipStream_t stream) {
    const float* x_prompt = (const float*)d_in[0];  const float* x_sample = (const float*)d_in[1];
    const float* st_dnc = (const float*)d_in[2];    const float* st_dn = (const float*)d_in[3];
    const float* st_sc = (const float*)d_in[4];     const float* st_ss = (const float*)d_in[5];
    const float* cache_k = (const float*)d_in[6];   const float* cache_v = (const float*)d_in[7];
    const float* mem_prompt = (const float*)d_in[8];
    const float* g_mix = (const float*)d_in[9];     const float* w_in = (const float*)d_in[10];
    const float* dn_conv_w = (const float*)d_in[11]; const float* dn_A_log = (const float*)d_in[12]; const float* dn_dt_bias = (const float*)d_in[13];
    const float* dn_norm_w = (const float*)d_in[14];
    const float* ssm_conv_w = (const float*)d_in[15]; const float* ssm_conv_b = (const float*)d_in[16]; const float* ssm_A_log = (const float*)d_in[17];
    const float* ssm_dt_bias = (const float*)d_in[18]; const float* ssm_D = (const float*)d_in[19]; const float* ssm_norm_w = (const float*)d_in[20];
    const float* w_out = (const float*)d_in[21];    const float* g_xattn = (const float*)d_in[22];  const float* g_mem = (const float*)d_in[23];
    const float* w_xq = (const float*)d_in[24];     const float* w_mkv = (const float*)d_in[25];    const float* w_xo = (const float*)d_in[26];
    const float* g_ffn = (const float*)d_in[27];    const float* w_pq = (const float*)d_in[28];     const float* subk = (const float*)d_in[29];
    const float* peer_u = (const float*)d_in[30];   const float* peer_v = (const float*)d_in[31];   const float* g_final = (const float*)d_in[32];
    float* out = (float*)d_out;
    float* ws = (float*)d_ws;
    float* PROJ = ws;
    float* OCAT = ws + (size_t)T * NPROJ;
    float* YR = out + O_Y;
    float* H1 = ws;
    float* TMP1 = ws + (size_t)T * 1024;
    float* Q = ws + (size_t)2 * T * 1024;
    float* MEMN = ws + (size_t)3 * T * 1024;
    float* OA = MEMN + (size_t)2048 * 1024;
    float* H2 = OA + (size_t)T * 1024;
    float* PQ = H2 + (size_t)T * 1024;

    nv::rmsnorm_rows<<<TP, 256, 0, stream>>>(x_prompt, g_mix, YR);
    nv::rmsnorm_rows<<<TS, 256, 0, stream>>>(x_sample, g_mix, YR + (size_t)TP * 1024);
    gemm_naive(stream, YR, 1024, w_in, NPROJ, PROJ, NPROJ, T, NPROJ, 1024, nullptr, 0);
    nv::dn_naive<<<64 + 1024, 128, 0, stream>>>(PROJ, st_dnc, st_dn, dn_conv_w, dn_A_log, dn_dt_bias, dn_norm_w, OCAT, out + O_P_DN, out + O_S_DN);
    nv::ssd_naive<<<128 + 2048, 64, 0, stream>>>(PROJ, st_sc, st_ss, ssm_conv_w, ssm_conv_b, ssm_A_log, ssm_dt_bias, ssm_D, YR, out + O_P_SS, out + O_S_SS);
    nv::ssd_groupnorm<<<T, 256, 0, stream>>>(YR, ssm_norm_w, OCAT);
    nv::conv_state_out<<<8 + 128, 256, 0, stream>>>(PROJ, out + O_P_DNC, out + O_P_SC, out + O_S_DNC, out + O_S_SC);
    gemm_naive(stream, OCAT, 2048, w_out, 1024, H1, 1024, TP, 1024, 2048, x_prompt, 1024);
    gemm_naive(stream, OCAT + (size_t)TP * 2048, 2048, w_out, 1024, H1 + (size_t)TP * 1024, 1024, TS, 1024, 2048, x_sample, 1024);
    nv::rmsnorm_rows<<<T, 256, 0, stream>>>(H1, g_xattn, TMP1);
    gemm_naive(stream, TMP1, 1024, w_xq, 1024, Q, 1024, T, 1024, 1024, nullptr, 0);
    nv::rmsnorm_rows<<<2048, 256, 0, stream>>>(mem_prompt, g_mem, MEMN);
    gemm_naive(stream, MEMN, 1024, w_mkv, 2048, out + O_P_MK, 1024, 2048, 1024, 1024, nullptr, 0);
    gemm_naive(stream, MEMN, 1024, w_mkv + 1024, 2048, out + O_P_MV, 1024, 2048, 1024, 1024, nullptr, 0);
    nv::attn_naive<<<T, 256, 0, stream>>>(Q, out + O_P_MK, out + O_P_MV, cache_k, cache_v, OA);
    gemm_naive(stream, OA, 1024, w_xo, 1024, H2, 1024, T, 1024, 1024, H1, 1024);
    nv::rmsnorm_rows<<<T, 256, 0, stream>>>(H2, g_ffn, TMP1);
    gemm_naive(stream, TMP1, 1024, w_pq, 2048, PQ, 2048, T, 2048, 1024, nullptr, 0);
    nv::peer_naive<<<T, 256, 0, stream>>>(PQ, TMP1, H2, subk, peer_u, peer_v, g_final, out + O_Y);
}
```

```cpp
#include <hip/hip_runtime.h>
#include <stdint.h>
#include <stdio.h>

constexpr int D = 1024, BATCH = 8, SEQ = 2048, DECB = 128, DECS = 8;
constexpr int TP = BATCH * SEQ, TS = DECB * DECS, T = TP + TS;
constexpr int DN_QKV = 3072, SSM_XBC = 1536, NPROJ = 6688;
constexpr size_t O_Y = 0;
constexpr size_t O_P_DNC = 17825792, O_P_DN = 17899520, O_P_SC = 18948096, O_P_SS = 18984960, O_P_MK = 20033536, O_P_MV = 22130688;
constexpr size_t O_S_DNC = 24227840, O_S_DN = 25407488, O_S_SC = 42184704, O_S_SS = 42774528;

#define XB_TMO      128
#define XB_XCNT(j)  (256  + 64 * (j))
#define XB_XSUB(j)  (1280 + 64 * (j))
#define XB_XGEN(j)  (2304 + 64 * (j))
#define XB_TOP      3328
#define XB_TOPGEN   3392
#define XCD_BAR_WORDS 3456
#define XB_SPIN_CAP (1u << 18)
#define LAS __attribute__((address_space(3)))

__device__ __forceinline__ unsigned xb_ld(unsigned* p)              { return __hip_atomic_load(p, __ATOMIC_RELAXED, __HIP_MEMORY_SCOPE_AGENT); }
__device__ __forceinline__ unsigned xb_add(unsigned* p, unsigned v) { return __hip_atomic_fetch_add(p, v, __ATOMIC_RELAXED, __HIP_MEMORY_SCOPE_AGENT); }
__device__ __forceinline__ unsigned xb_xcc_id() { return (unsigned)__builtin_amdgcn_s_getreg((3 << 11) | 20) & 0xFu; }
#define XB_SPIN(cond, bar) do { unsigned _sp = 0; while (cond) { __builtin_amdgcn_s_sleep(1); \
    if ((++_sp & 255u) == 0u) { if (xb_ld(&(bar)[XB_TMO])) break; if (_sp > XB_SPIN_CAP) { atomicAdd(&(bar)[XB_TMO], 1u); break; } } } } while (0)

struct XcdBarrier {
    unsigned* bar; unsigned x;
    volatile LAS unsigned* st;
};

__device__ __forceinline__ XcdBarrier xcd_barrier_post(unsigned* bar, volatile LAS unsigned* st) {
    XcdBarrier b; b.bar = bar; b.x = xb_xcc_id(); b.st = st;
    if (threadIdx.x == 0) (void)xb_add(&bar[XB_XCNT(b.x)], 1u);
    return b;
}
__device__ __forceinline__ void xcd_barrier_complete(unsigned* bar, unsigned x, unsigned& nloc, unsigned& nx) {
    const unsigned G = gridDim.x * gridDim.y * gridDim.z;
    unsigned sum, cnt, mine, sp = 0u;
    for (;;) {
        sum = 0u; cnt = 0u; mine = 0u;
#pragma unroll
        for (unsigned j = 0; j < 16; ++j) { const unsigned c = xb_ld(&bar[XB_XCNT(j)]); sum += c; cnt += (c > 0u) ? 1u : 0u; mine = (j == x) ? c : mine; }
        if (sum == G) break;
        __builtin_amdgcn_s_sleep(1);
        if ((++sp & 255u) == 0u) { if (xb_ld(&bar[XB_TMO])) break; if (sp > XB_SPIN_CAP) { atomicAdd(&bar[XB_TMO], 1u); break; } }
    }
    nloc = mine > 0u ? mine : 1u; nx = cnt > 0u ? cnt : 1u;
}

__device__ __forceinline__ void xcd_barrier(const XcdBarrier& b) {
    asm volatile("s_waitcnt vmcnt(0)" ::: "memory");
    __syncthreads();
    if (threadIdx.x == 0) {
        unsigned* bar = b.bar;
        __builtin_amdgcn_s_waitcnt(0);
        unsigned nloc = b.st[0], nx = b.st[1];
        if (nloc == 0u) { xcd_barrier_complete(bar, b.x, nloc, nx); b.st[0] = nloc; b.st[1] = nx; }
        const unsigned old = xb_add(&bar[XB_XSUB(b.x)], 1u);
        const unsigned gen = old / nloc;
        if (old + 1u == (gen + 1u) * nloc) {
            __builtin_amdgcn_fence(__ATOMIC_RELEASE, "agent");
            asm volatile("s_waitcnt vmcnt(0)" ::: "memory");
            const unsigned og = xb_add(&bar[XB_TOP], 1u);
            const unsigned tg = og / nx;
            if (og + 1u == (tg + 1u) * nx) xb_add(&bar[XB_TOPGEN], 1u);
            else XB_SPIN(xb_ld(&bar[XB_TOPGEN]) == tg, bar);
            __builtin_amdgcn_fence(__ATOMIC_ACQUIRE, "agent");
            xb_add(&bar[XB_XGEN(b.x)], 1u);
            asm volatile("s_waitcnt vmcnt(0)" ::: "memory");
        } else {
            XB_SPIN(xb_ld(&bar[XB_XGEN(b.x)]) == gen, bar);
            __builtin_amdgcn_fence(__ATOMIC_ACQUIRE, "agent");
            asm volatile("s_waitcnt vmcnt(0)" ::: "memory");
        }
    }
    __syncthreads();
}

namespace pg8 {
#define PG8_LAS __attribute__((address_space(3)))
typedef unsigned short bf16_t;
typedef short bf16x8 __attribute__((ext_vector_type(8)));
typedef float f32x4 __attribute__((ext_vector_type(4)));
typedef unsigned u32x4 __attribute__((ext_vector_type(4)));
constexpr int BM = 256, BK = 64, HALF = 128, HTB = HALF * BK * 2  , STAGE_BYTES = 8 * HTB, NXCD = 8, WGM = 8;

__host__ __device__ __forceinline__ int lds_byte(int r, int c) { const int st = (r >> 4) * 2 + (c >> 5), rr = r & 15, cc = c & 31, ob = rr * 64 + cc * 2; return st * 1024 + (ob ^ (((ob >> 9) & 1) << 5)); }
__host__ __device__ __forceinline__ void stage_rc(int b, int& R, int& C) { const int st = b / 1024, sb = b % 1024, swz = sb ^ (((sb >> 9) & 1) << 5); R = (st >> 1) * 16 + swz / 64; C = (st & 1) * 32 + (swz % 64) / 2; }
__host__ __device__ __forceinline__ int perm32(int rho) { const int n = rho >> 4, i = rho & 15; return 8 * (i >> 2) + 4 * n + (i & 3); }

struct Unit { int pm, pn; };
struct Gemm { const bf16_t* A; const bf16_t* Bt; int M, N, K; };

struct StaticOrder {
    int nM, nN, nwg, G, c;
    __host__ __device__ void init(int M, int N, int G_, int c_) { nM = M / BM; nN = N / BM; nwg = nM * nN; G = G_; c = c_; }
    __host__ __device__ bool next(int i, Unit& u) const {
        const long L = (long)i * G + c; if (L >= nwg) return false;
        int wgid = (int)L; { const int q = nwg / NXCD, r = nwg % NXCD, xcd = wgid % NXCD, off = wgid / NXCD; wgid = (xcd < r ? xcd * (q + 1) : r * (q + 1) + (xcd - r) * q) + off; }
        const int nig = WGM * nN, gid = wgid / nig, fm = gid * WGM, gsz = (nM - fm) < WGM ? (nM - fm) : WGM;
        u.pm = fm + ((wgid % nig) % gsz); u.pn = (wgid % nig) / gsz; return true;
    }
    __device__ __forceinline__ void a_ready(const Unit&) const {}
    __device__ __forceinline__ void done(const Unit&) const {}
};
__device__ __forceinline__ unsigned cvt_pk_bf16(float lo, float hi) { unsigned r; asm volatile("v_cvt_pk_bf16_f32 %0, %1, %2" : "=v"(r) : "v"(lo), "v"(hi)); return r; }
typedef float f32x2 __attribute__((ext_vector_type(2)));
template <class Epi, class Sched, bool STAMP = false>
__device__ __forceinline__ void gemm_phase(PG8_LAS unsigned char* lds, const Gemm g, const Sched& S, const Epi& E, unsigned long long* stamps) {
    const int tid = threadIdx.x, wid = __builtin_amdgcn_readfirstlane(tid >> 6), lane = tid & 63, wr = wid >> 2, wc = wid & 3, fr = lane & 15, fq = lane >> 4;
    const int K = g.K, nt = K / BK;
    int ts_lo = 0, ts_hi = 0, nts = 0; const unsigned long long rt_entry = STAMP ? (unsigned long long)wall_clock64() : 0ull;
#define PG8_STAMP() do { if (STAMP && wid == 0 && nts < 64) { const unsigned long long _c = (unsigned long long)clock64(); \
        ts_lo = (lane == nts) ? (int)(unsigned)_c : ts_lo; ts_hi = (lane == nts) ? (int)(unsigned)(_c >> 32) : ts_hi; ++nts; } } while (0)
    PG8_STAMP();
    unsigned voffA[2], voffB[2];
#pragma unroll
    for (int i = 0; i < 2; ++i) { int R, C; stage_rc(tid * 16 + i * 8192, R, C); const int Rb = Epi::PERM ? ((R & ~31) + perm32(R & 31)) : R;
        voffA[i] = (unsigned)(R * K + C) * 2u; voffB[i] = (unsigned)(Rb * K + C) * 2u; }
    const size_t kstep = (size_t)(BK * 2);
    const size_t hstep = (size_t)HALF * K * 2;
    const size_t tstep = 2 * hstep;
    const unsigned ldsw = (unsigned)wid * 1024u;
    const int aoff = lds_byte(wr * 64 + fr, fq * 8), boff = lds_byte(wc * 32 + fr, fq * 8);
#define PG8_SA(b, h) (((b) * 2 + (h)) * HTB)
#define PG8_SB(b, h) ((4 + (b) * 2 + (h)) * HTB)
#define PG8_STAGE(bufoff, gbase, voff) do { _Pragma("unroll") for (int _i = 0; _i < 2; ++_i) \
        __builtin_amdgcn_global_load_lds((const unsigned*)((const char*)(gbase) + (voff)[_i]), (PG8_LAS unsigned*)(lds + (bufoff) + ldsw + _i * 8192), 16, 0, 0); } while (0)
#define PG8_LDA(dst, b, h) do { _Pragma("unroll") for (int m = 0; m < 4; ++m) _Pragma("unroll") for (int k = 0; k < 2; ++k) dst[m][k] = *(const PG8_LAS bf16x8*)(lds + PG8_SA(b, h) + aoff + m * 2048 + k * 1024); } while (0)
#define PG8_LDB(dst, b, h) do { _Pragma("unroll") for (int n = 0; n < 2; ++n) _Pragma("unroll") for (int k = 0; k < 2; ++k) dst[n][k] = *(const PG8_LAS bf16x8*)(lds + PG8_SB(b, h) + boff + n * 2048 + k * 1024); } while (0)
#define PG8_MMA(ai, bj, At, Bt) do { __builtin_amdgcn_s_setprio(1); _Pragma("unroll") for (int m = 0; m < 4; ++m) _Pragma("unroll") for (int n = 0; n < 2; ++n) _Pragma("unroll") for (int k = 0; k < 2; ++k) \
        acc[ai][bj][m][n] = __builtin_amdgcn_mfma_f32_16x16x32_bf16(Bt[n][k], At[m][k], acc[ai][bj][m][n], 0, 0, 0); __builtin_amdgcn_s_setprio(0); } while (0)
#define PG8_WAIT_V(n) asm volatile("s_waitcnt vmcnt(" #n ")" ::: "memory")
#define PG8_WAIT_L(n) asm volatile("s_waitcnt lgkmcnt(" #n ")" ::: "memory")
#define PG8_BAR __builtin_amdgcn_s_barrier()
#define PG8_SCHED __builtin_amdgcn_sched_barrier(0)
    Unit cur, nxt; int ui = 0;
    if (!S.next(0, cur)) return;
    f32x4 acc[2][2][4][2];
#pragma unroll
    for (int a = 0; a < 2; ++a)
#pragma unroll
        for (int b = 0; b < 2; ++b)
#pragma unroll
            for (int m = 0; m < 4; ++m)
#pragma unroll
                for (int n = 0; n < 2; ++n) acc[a][b][m][n] = (f32x4){0.f, 0.f, 0.f, 0.f};
    bf16x8 At[4][2], B0[2][2], B1[2][2];
    const char* cA = (const char*)g.A + (size_t)cur.pm * tstep; const char* cB = (const char*)g.Bt + (size_t)cur.pn * tstep;
    S.a_ready(cur);
    PG8_STAGE(PG8_SB(0, 0), cB, voffB); PG8_STAGE(PG8_SA(0, 0), cA, voffA); PG8_STAGE(PG8_SB(0, 1), cB + hstep, voffB); PG8_STAGE(PG8_SA(0, 1), cA + hstep, voffA);
    if (wr == 1) PG8_BAR;
    PG8_WAIT_V(4); PG8_BAR;
    PG8_STAGE(PG8_SB(1, 0), cB + kstep, voffB); PG8_STAGE(PG8_SA(1, 0), cA + kstep, voffA); PG8_STAGE(PG8_SB(1, 1), cB + hstep + kstep, voffB);
    PG8_WAIT_V(6); PG8_BAR;
    PG8_STAMP();
    for (;;) {
        const bool has_next = S.next(ui + 1, nxt);
        const char* nA = has_next ? (const char*)g.A + (size_t)nxt.pm * tstep : cA; const char* nB = has_next ? (const char*)g.Bt + (size_t)nxt.pn * tstep : cB;
        for (int t = 0; t < nt; t += 2) {
            const bool last = (t == nt - 2);
            const char* a1 = cA + (size_t)(t + 1) * kstep;
            const char* a2 = last ? nA : cA + (size_t)(t + 2) * kstep; const char* b2 = last ? nB : cB + (size_t)(t + 2) * kstep;
            const char* a3 = a2 + kstep; const char* b3 = b2 + kstep;
            if (last && has_next) S.a_ready(nxt);
            PG8_LDB(B0, 0, 0); PG8_SCHED; PG8_LDA(At, 0, 0); PG8_STAGE(PG8_SA(1, 1), a1 + hstep, voffA);
            PG8_WAIT_L(8); PG8_BAR; PG8_WAIT_L(0); PG8_MMA(0, 0, At, B0); PG8_BAR; PG8_SCHED;
            PG8_LDB(B1, 0, 1); PG8_STAGE(PG8_SB(0, 0), b2, voffB);
            PG8_BAR; PG8_WAIT_L(0); PG8_MMA(0, 1, At, B1); PG8_BAR;
            PG8_LDA(At, 0, 1); PG8_STAGE(PG8_SA(0, 0), a2, voffA);
            PG8_BAR; PG8_WAIT_L(0); PG8_MMA(1, 0, At, B0); PG8_BAR; PG8_SCHED;
            PG8_STAGE(PG8_SB(0, 1), b2 + hstep, voffB);
            PG8_WAIT_V(6); PG8_BAR; PG8_MMA(1, 1, At, B1); PG8_BAR;
            PG8_LDB(B0, 1, 0); PG8_SCHED; PG8_LDA(At, 1, 0); PG8_STAGE(PG8_SA(0, 1), a2 + hstep, voffA);
            PG8_WAIT_L(8); PG8_BAR; PG8_WAIT_L(0); PG8_MMA(0, 0, At, B0); PG8_BAR; PG8_SCHED;
            PG8_LDB(B1, 1, 1); PG8_STAGE(PG8_SB(1, 0), b3, voffB);
            PG8_BAR; PG8_WAIT_L(0); PG8_MMA(0, 1, At, B1); PG8_BAR;
            PG8_LDA(At, 1, 1); PG8_STAGE(PG8_SA(1, 0), a3, voffA);
            PG8_BAR; PG8_WAIT_L(0); PG8_MMA(1, 0, At, B0); PG8_BAR; PG8_SCHED;
            PG8_STAGE(PG8_SB(1, 1), b3 + hstep, voffB);
            PG8_WAIT_V(6); PG8_BAR; PG8_MMA(1, 1, At, B1); PG8_BAR;
        }
        PG8_STAMP();
        if constexpr (!Epi::AFTER_DRAIN) { E(acc, cur, wr, wc, fr, fq); S.done(cur); }
        PG8_STAMP();
        if (!has_next) break;
#pragma unroll
        for (int a = 0; a < 2; ++a)
#pragma unroll
            for (int b = 0; b < 2; ++b)
#pragma unroll
                for (int m = 0; m < 4; ++m)
#pragma unroll
                    for (int n = 0; n < 2; ++n) acc[a][b][m][n] = (f32x4){0.f, 0.f, 0.f, 0.f};
        cur = nxt; cA = nA; cB = nB; ++ui;
    }
    PG8_WAIT_V(0);
    if (wr == 0) PG8_BAR;
    PG8_BAR;
    if constexpr (Epi::AFTER_DRAIN) { E.fused(acc, cur, wr, wc, fr, fq, lds, wid, lane); S.done(cur); }
    PG8_STAMP();
    if (STAMP && wid == 0) { stamps[lane] = lane < nts ? (((unsigned long long)(unsigned)ts_hi << 32) | (unsigned)ts_lo) : 0ull;
        if (lane == 62) stamps[62] = rt_entry; if (lane == 63) stamps[63] = (unsigned long long)wall_clock64(); }
#undef PG8_STAMP
#undef PG8_SA
#undef PG8_SB
#undef PG8_STAGE
#undef PG8_LDA
#undef PG8_LDB
#undef PG8_MMA
#undef PG8_WAIT_V
#undef PG8_WAIT_L
#undef PG8_BAR
#undef PG8_SCHED
}
}

namespace fk {
typedef unsigned short bf16;
typedef float f32x4 __attribute__((ext_vector_type(4)));
typedef unsigned u32x4 __attribute__((ext_vector_type(4)));
typedef unsigned u32x2 __attribute__((ext_vector_type(2)));

__device__ __forceinline__ bf16 f2bf(float f) { unsigned u = __float_as_uint(f); u += 0x7FFFu + ((u >> 16) & 1u); return (bf16)(u >> 16); }
__device__ __forceinline__ float bf2f(bf16 b) { return __uint_as_float(((unsigned)b) << 16); }
__device__ __forceinline__ unsigned pack2(float lo, float hi) { return (unsigned)f2bf(lo) | ((unsigned)f2bf(hi) << 16); }

constexpr int NT = 512;
constexpr int LDS_BYTES = 163840, LDS_MISC = LDS_BYTES - 1024;
constexpr int NPAD = 6912;
constexpr int PROJW = 6656;

constexpr size_t al256(size_t x) { return (x + 255) & ~(size_t)255; }
constexpr size_t WS_CTL = 0, CTL_BYTES = 262144;
constexpr size_t CTL_SS1 = 65536, CTL_SS2 = 163840;
constexpr size_t WS_WIN = WS_CTL + CTL_BYTES;
constexpr size_t WS_WOUT = WS_WIN + (size_t)NPAD * 1024 * 2;
constexpr size_t WS_WXQ = WS_WOUT + (size_t)1024 * 2048 * 2;
constexpr size_t WS_WMKV = WS_WXQ + (size_t)1024 * 1024 * 2;
constexpr size_t WS_WXO = WS_WMKV + (size_t)2048 * 1024 * 2;
constexpr size_t WS_WPQ = WS_WXO + (size_t)1024 * 1024 * 2;
constexpr size_t WS_SUBK = WS_WPQ + (size_t)2048 * 1024 * 2;
constexpr size_t WS_PU = WS_SUBK + (size_t)2 * 128 * 128 * 2;
constexpr size_t WS_PV = WS_PU + (size_t)16384 * 1024 * 2;
constexpr size_t WS_XN = WS_PV + (size_t)16384 * 1024 * 2;
constexpr size_t WS_MEMN = WS_XN + (size_t)T * 1024 * 2;
constexpr size_t WS_MKB = WS_MEMN + (size_t)2048 * 1024 * 2;
constexpr size_t WS_MVB = WS_MKB + (size_t)2048 * 1024 * 2;
constexpr size_t WS_SMALL = WS_MVB + (size_t)2048 * 1024 * 2;
constexpr size_t WS_OCATB = WS_SMALL + (size_t)T * 32 * 4;
constexpr size_t WS_PROJB = WS_OCATB + (size_t)T * 2048 * 2;
constexpr size_t WS_MIX = WS_PROJB + (size_t)T * PROJW * 2;
constexpr size_t WS_H = WS_PROJB;
constexpr size_t WS_HB = WS_H + (size_t)T * 1024 * 4;
constexpr size_t WS_QB = WS_HB + (size_t)T * 1024 * 2;
constexpr size_t WS_OB = WS_QB + (size_t)T * 1024 * 2;
constexpr size_t WS_PQB = WS_OCATB;

struct Params {
    const float* in[33];
    float* out;
    unsigned char* ws;
    int ph_lo, ph_hi;
    int use_bar;
    int pad;
};

__device__ __forceinline__ void transpose_cvt(const float* __restrict__ W, int K, int N, int Npad, const float* __restrict__ gain, bf16* __restrict__ Wt,
                                              float* ft  , int vb, int nvb) {
    const int tid = threadIdx.x;
    const int ntk = K / 64, ntn = Npad / 64, ntiles = ntk * ntn;
    for (int tile = vb; tile < ntiles; tile += nvb) {
        const int k0 = (tile % ntk) * 64, n0 = (tile / ntk) * 64;
        __syncthreads();
#pragma unroll
        for (int i = 0; i < 2; ++i) {
            const int e = tid + i * NT;
            const int kr = e >> 4, c4 = e & 15;
            const int n = n0 + c4 * 4;
            float4 v = make_float4(0.f, 0.f, 0.f, 0.f);
            if (n + 3 < N) v = *(const float4*)(W + (size_t)(k0 + kr) * N + n);
            else { const float* wr = W + (size_t)(k0 + kr) * N; if (n < N) v.x = wr[n]; if (n + 1 < N) v.y = wr[n + 1]; if (n + 2 < N) v.z = wr[n + 2]; }
            const float g = gain ? gain[k0 + kr] : 1.0f;
            float* d = ft + kr * 65 + c4 * 4;
            d[0] = v.x * g; d[1] = v.y * g; d[2] = v.z * g; d[3] = v.w * g;
        }
        __syncthreads();
        const int kc8 = tid & 7, nr = tid >> 3;
        u32x4 w;
        w.x = pack2(ft[(kc8 * 8 + 0) * 65 + nr], ft[(kc8 * 8 + 1) * 65 + nr]);
        w.y = pack2(ft[(kc8 * 8 + 2) * 65 + nr], ft[(kc8 * 8 + 3) * 65 + nr]);
        w.z = pack2(ft[(kc8 * 8 + 4) * 65 + nr], ft[(kc8 * 8 + 5) * 65 + nr]);
        w.w = pack2(ft[(kc8 * 8 + 6) * 65 + nr], ft[(kc8 * 8 + 7) * 65 + nr]);
        *(u32x4*)(Wt + (size_t)(n0 + nr) * K + k0 + kc8 * 8) = w;
    }
}
__device__ __forceinline__ void cvt_stream(const float* __restrict__ src, bf16* __restrict__ dst, size_t n, int vb, int nvb) {
    const size_t n8 = n / 8;
    for (size_t i = (size_t)vb * NT + threadIdx.x; i < n8; i += (size_t)nvb * NT) {
        const float4 a = ((const float4*)src)[2 * i], b = ((const float4*)src)[2 * i + 1];
        u32x4 w; w.x = pack2(a.x, a.y); w.y = pack2(a.z, a.w); w.z = pack2(b.x, b.y); w.w = pack2(b.z, b.w);
        ((u32x4*)dst)[i] = w;
    }
}
__device__ __forceinline__ void norm_rows_bf16(const Params& p, bf16* __restrict__ XN, bf16* __restrict__ MEMN, int vb, int nvb) {
    const int lane = threadIdx.x & 63, wv = threadIdx.x >> 6;
    const int nrows = T + 2048;
    for (int r = vb * 8 + wv; r < nrows; r += nvb * 8) {
        const float* src; bf16* dst;
        if (r < TP) { src = p.in[0] + (size_t)r * 1024; dst = XN + (size_t)r * 1024; }
        else if (r < T) { src = p.in[1] + (size_t)(r - TP) * 1024; dst = XN + (size_t)r * 1024; }
        else { src = p.in[8] + (size_t)(r - T) * 1024; dst = MEMN + (size_t)(r - T) * 1024; }
        float4 v[4]; float ss = 0.f;
#pragma unroll
        for (int i = 0; i < 4; ++i) { v[i] = ((const float4*)src)[lane + 64 * i]; ss += v[i].x * v[i].x + v[i].y * v[i].y + v[i].z * v[i].z + v[i].w * v[i].w; }
#pragma unroll
        for (int o = 32; o > 0; o >>= 1) ss += __shfl_xor(ss, o);
        const float rstd = rsqrtf(ss * (1.0f / 1024.0f) + 1e-6f);
#pragma unroll
        for (int i = 0; i < 4; ++i) { u32x2 w; w.x = pack2(v[i].x * rstd, v[i].y * rstd); w.y = pack2(v[i].z * rstd, v[i].w * rstd); ((u32x2*)dst)[lane + 64 * i] = w; }
    }
}
__device__ __forceinline__ void p0_prologue(const Params& p, LAS unsigned char* lds) {
    float* ft = (float*)(unsigned char*)lds;
    unsigned char* ws = p.ws;
    const int vb = blockIdx.x, nvb = gridDim.x;
    transpose_cvt(p.in[10], 1024, NPROJ, NPAD, p.in[9], (bf16*)(ws + WS_WIN), ft, vb, nvb);
    transpose_cvt(p.in[21], 2048, 1024, 1024, nullptr, (bf16*)(ws + WS_WOUT), ft, vb, nvb);
    transpose_cvt(p.in[24], 1024, 1024, 1024, p.in[22], (bf16*)(ws + WS_WXQ), ft, vb, nvb);
    transpose_cvt(p.in[25], 1024, 2048, 2048, p.in[23], (bf16*)(ws + WS_WMKV), ft, vb, nvb);
    transpose_cvt(p.in[26], 1024, 1024, 1024, nullptr, (bf16*)(ws + WS_WXO), ft, vb, nvb);
    transpose_cvt(p.in[28], 1024, 2048, 2048, p.in[27], (bf16*)(ws + WS_WPQ), ft, vb, nvb);
    cvt_stream(p.in[29], (bf16*)(ws + WS_SUBK), (size_t)2 * 128 * 128, vb, nvb);
    cvt_stream(p.in[30], (bf16*)(ws + WS_PU), (size_t)16384 * 1024, vb, nvb);
    cvt_stream(p.in[31], (bf16*)(ws + WS_PV), (size_t)16384 * 1024, vb, nvb);
    norm_rows_bf16(p, (bf16*)(ws + WS_XN), (bf16*)(ws + WS_MEMN), vb, nvb);
}

using pg8::Unit;
struct EpiProj {
    static constexpr bool PERM = true, AFTER_DRAIN = false;
    bf16* O; float* SM;
    __device__ __forceinline__ void operator()(const f32x4 (&acc)[2][2][4][2], const Unit& u, int wr, int wc, int fr, int fq) const {
        const int row0 = u.pm * 256 + wr * 64 + fr;
        if (u.pn < 26) {
            const int col0 = u.pn * 256 + wc * 32 + 8 * fq;
#pragma unroll
            for (int ai = 0; ai < 2; ++ai)
#pragma unroll
                for (int m = 0; m < 4; ++m) {
                    bf16* rowp = O + (size_t)(row0 + ai * 128 + m * 16) * PROJW + col0;
#pragma unroll
                    for (int bj = 0; bj < 2; ++bj) {
                        const f32x4 v0 = acc[ai][bj][m][0], v1 = acc[ai][bj][m][1];
                        u32x4 w; w.x = pack2(v0[0], v0[1]); w.y = pack2(v0[2], v0[3]); w.z = pack2(v1[0], v1[1]); w.w = pack2(v1[2], v1[3]);
                        *(u32x4*)(rowp + bj * 128) = w;
                    }
                }
        } else if (wc == 0) {
#pragma unroll
            for (int ai = 0; ai < 2; ++ai)
#pragma unroll
                for (int m = 0; m < 4; ++m) {
                    float* rowp = SM + (size_t)(row0 + ai * 128 + m * 16) * 32 + 8 * fq;
                    *(f32x4*)(rowp) = acc[ai][0][m][0];
                    *(f32x4*)(rowp + 4) = acc[ai][0][m][1];
                }
        }
    }
};
struct EpiRes {
    static constexpr bool PERM = false, AFTER_DRAIN = false;
    const float* res_p; const float* res_s;
    float* H; bf16* HB; float* SS;
    __device__ __forceinline__ void operator()(const f32x4 (&acc)[2][2][4][2], const Unit& u, int wr, int wc, int fr, int fq) const {
        const int row0 = u.pm * 256 + wr * 64 + fr, col0 = u.pn * 256 + wc * 32 + 4 * fq;
        const float* rbase = (u.pm < TP / 256) ? res_p : res_s - (size_t)TP * 1024;
#pragma unroll
        for (int ai = 0; ai < 2; ++ai)
#pragma unroll
            for (int m = 0; m < 4; ++m) {
                const int row = row0 + ai * 128 + m * 16;
                float ssq = 0.f;
#pragma unroll
                for (int bj = 0; bj < 2; ++bj)
#pragma unroll
                    for (int n = 0; n < 2; ++n) {
                        const size_t off = (size_t)row * 1024 + col0 + bj * 128 + n * 16;
                        const f32x4 r = *(const f32x4*)(rbase + off);
                        const f32x4 v = acc[ai][bj][m][n] + r;
                        *(f32x4*)(H + off) = v;
                        u32x2 w; w.x = pack2(v[0], v[1]); w.y = pack2(v[2], v[3]);
                        *(u32x2*)(HB + off) = w;
                        ssq += v[0] * v[0] + v[1] * v[1] + v[2] * v[2] + v[3] * v[3];
                    }
                ssq += __shfl_xor(ssq, 16); ssq += __shfl_xor(ssq, 32);
                if (fq == 0) atomicAdd(SS + row, ssq);
            }
    }
};
struct EpiScale {
    static constexpr bool PERM = true, AFTER_DRAIN = false;
    bf16* O; int ldc; const float* SS; float extra;
    __device__ __forceinline__ void operator()(const f32x4 (&acc)[2][2][4][2], const Unit& u, int wr, int wc, int fr, int fq) const {
        const int row0 = u.pm * 256 + wr * 64 + fr, col0 = u.pn * 256 + wc * 32 + 8 * fq;
#pragma unroll
        for (int ai = 0; ai < 2; ++ai)
#pragma unroll
            for (int m = 0; m < 4; ++m) {
                const int row = row0 + ai * 128 + m * 16;
                const float s = rsqrtf(SS[row] * (1.0f / 1024.0f) + 1e-6f) * extra;
                bf16* rowp = O + (size_t)row * ldc + col0;
#pragma unroll
                for (int bj = 0; bj < 2; ++bj) {
                    const f32x4 v0 = acc[ai][bj][m][0] * s, v1 = acc[ai][bj][m][1] * s;
                    u32x4 w; w.x = pack2(v0[0], v0[1]); w.y = pack2(v0[2], v0[3]); w.z = pack2(v1[0], v1[1]); w.w = pack2(v1[2], v1[3]);
                    *(u32x4*)(rowp + bj * 128) = w;
                }
            }
    }
};
struct EpiMkv {
    static constexpr bool PERM = false, AFTER_DRAIN = false;
    float* OK; float* OV; bf16* KB; bf16* VB;
    __device__ __forceinline__ void operator()(const f32x4 (&acc)[2][2][4][2], const Unit& u, int wr, int wc, int fr, int fq) const {
        const int row0 = u.pm * 256 + wr * 64 + fr;
        const bool isv = u.pn >= 4;
        const int col0 = (u.pn & 3) * 256 + wc * 32 + 4 * fq;
        float* Of = isv ? OV : OK; bf16* Ob = isv ? VB : KB;
#pragma unroll
        for (int ai = 0; ai < 2; ++ai)
#pragma unroll
            for (int m = 0; m < 4; ++m) {
                const int row = row0 + ai * 128 + m * 16;
#pragma unroll
                for (int bj = 0; bj < 2; ++bj)
#pragma unroll
                    for (int n = 0; n < 2; ++n) {
                        const size_t off = (size_t)row * 1024 + col0 + bj * 128 + n * 16;
                        const f32x4 v = acc[ai][bj][m][n];
                        *(f32x4*)(Of + off) = v;
                        u32x2 w; w.x = pack2(v[0], v[1]); w.y = pack2(v[2], v[3]);
                        *(u32x2*)(Ob + off) = w;
                    }
            }
    }
};

template <class Epi>
__device__ __forceinline__ void run_gemm(LAS unsigned char* lds, const bf16* A, const bf16* Bt, int M, int N, int K, const Epi& E) {
    pg8::Gemm g{A, Bt, M, N, K};
    pg8::StaticOrder S; S.init(M, N, (int)gridDim.x, (int)blockIdx.x);
    pg8::gemm_phase<Epi, pg8::StaticOrder, false>(lds, g, S, E, nullptr);
}


typedef short bf16x8 __attribute__((ext_vector_type(8)));
typedef short s16x4 __attribute__((ext_vector_type(4)));

__device__ __forceinline__ bf16x8 pack8(const f32x4& a, const f32x4& b) {
    u32x4 w; w.x = pack2(a[0], a[1]); w.y = pack2(a[2], a[3]); w.z = pack2(b[0], b[1]); w.w = pack2(b[2], b[3]);
    return __builtin_bit_cast(bf16x8, w);
}
__device__ __forceinline__ bf16x8 ldsB_tr(const LAS unsigned char* base, int stride, int k0, int n0, int r, int q) {
    const LAS unsigned char* a0 = base + (k0 + 8 * q + (r >> 2)) * stride + (n0 + 4 * (r & 3)) * 2;
    const s16x4 lo = __builtin_amdgcn_ds_read_tr16_b64_v4i16((LAS s16x4*)a0);
    const s16x4 hi = __builtin_amdgcn_ds_read_tr16_b64_v4i16((LAS s16x4*)(a0 + 4 * stride));
    bf16x8 o; o[0] = lo[0]; o[1] = lo[1]; o[2] = lo[2]; o[3] = lo[3]; o[4] = hi[0]; o[5] = hi[1]; o[6] = hi[2]; o[7] = hi[3];
    return o;
}

constexpr int AT_KS = 272, AT_VS = 288, AT_BUF = 256 * 288;

template <bool F32>
__device__ __forceinline__ void at_stage_half(const void* src, int hh, LAS unsigned char* buf, int stride) {
    const int tid = threadIdx.x;
#pragma unroll
    for (int pass = 0; pass < 8; ++pass) {
        const int row = pass * 32 + (tid >> 4), c = tid & 15;
        u32x4 w;
        if (F32) {
            const float* s = (const float*)src + (size_t)row * 1024 + hh * 128 + c * 8;
            const float4 a = *(const float4*)s, b = *(const float4*)(s + 4);
            w.x = pack2(a.x, a.y); w.y = pack2(a.z, a.w); w.z = pack2(b.x, b.y); w.w = pack2(b.z, b.w);
        } else {
            w = *(const u32x4*)((const bf16*)src + (size_t)row * 1024 + hh * 128 + c * 8);
        }
        *(LAS u32x4*)(buf + row * stride + c * 16) = w;
    }
}

__device__ __forceinline__ void attn_phase(const Params& p, LAS unsigned char* lds) {
    unsigned char* ws = p.ws;
    const bf16* QB = (const bf16*)(ws + WS_QB);
    bf16* OB = (bf16*)(ws + WS_OB);
    const int tid = threadIdx.x, lane = tid & 63, wv = tid >> 6, r = lane & 15, q = lane >> 4;
    LAS unsigned char* buf0 = lds;
    LAS unsigned char* buf1 = lds + AT_BUF;
    const int nunits = 256 + 512;
    for (int u = blockIdx.x; u < nunits; u += gridDim.x) {
        int t0, ntok, h; const void* Ksrc; const void* Vsrc; bool f32src;
        if (u < 256) { const int b = u >> 5; h = (u >> 3) & 3; const int tt = u & 7; t0 = b * SEQ + tt * 256; ntok = 256; f32src = false;
            Ksrc = (const bf16*)(ws + WS_MKB) + (size_t)b * 256 * 1024 + h * 256; Vsrc = (const bf16*)(ws + WS_MVB) + (size_t)b * 256 * 1024 + h * 256; }
        else { const int su = u - 256; const int b = su >> 2; h = su & 3; t0 = TP + b * DECS; ntok = DECS; f32src = true;
            Ksrc = p.in[6] + (size_t)b * 256 * 1024 + h * 256; Vsrc = p.in[7] + (size_t)b * 256 * 1024 + h * 256; }
        const int ntiles = (ntok == 256) ? 2 : (wv == 0 ? 1 : 0);
        __syncthreads();
        if (f32src) { at_stage_half<true>(Ksrc, 0, buf0, AT_KS); at_stage_half<true>(Ksrc, 1, buf1, AT_KS); }
        else { at_stage_half<false>(Ksrc, 0, buf0, AT_KS); at_stage_half<false>(Ksrc, 1, buf1, AT_KS); }
        __syncthreads();
        bf16x8 pf[2][8];
#pragma unroll
        for (int tile = 0; tile < 2; ++tile) {
#pragma unroll
            for (int s = 0; s < 8; ++s) pf[tile][s] = (bf16x8){0, 0, 0, 0, 0, 0, 0, 0};
            if (tile < ntiles) {
                const int tl = (ntok == 256 ? wv * 32 : 0) + tile * 16 + r;
                const int tq = t0 + (tl < ntok ? tl : ntok - 1);
                bf16x8 qf[8];
#pragma unroll
                for (int ks = 0; ks < 8; ++ks) qf[ks] = *(const bf16x8*)(QB + (size_t)tq * 1024 + h * 256 + 32 * ks + 8 * q);
                f32x4 acc[16];
#pragma unroll
                for (int mt = 0; mt < 16; ++mt) acc[mt] = (f32x4){0.f, 0.f, 0.f, 0.f};
#pragma unroll
                for (int ks = 0; ks < 8; ++ks) {
                    const LAS unsigned char* kb = (ks < 4 ? buf0 : buf1) + (32 * (ks & 3) + 8 * q) * 2;
#pragma unroll
                    for (int mt = 0; mt < 16; ++mt) {
                        const bf16x8 a = *(const LAS bf16x8*)(kb + (16 * mt + r) * AT_KS);
                        acc[mt] = __builtin_amdgcn_mfma_f32_16x16x32_bf16(a, qf[ks], acc[mt], 0, 0, 0);
                    }
                }
                float mx = -3.0e38f;
#pragma unroll
                for (int mt = 0; mt < 16; ++mt) mx = fmaxf(fmaxf(fmaxf(acc[mt][0], acc[mt][1]), fmaxf(acc[mt][2], acc[mt][3])), mx);
                mx = fmaxf(mx, __shfl_xor(mx, 16)); mx = fmaxf(mx, __shfl_xor(mx, 32));
                float sum = 0.f;
#pragma unroll
                for (int mt = 0; mt < 16; ++mt)
#pragma unroll
                    for (int j = 0; j < 4; ++j) { const float e = __expf(acc[mt][j] - mx); acc[mt][j] = e; sum += e; }
                sum += __shfl_xor(sum, 16); sum += __shfl_xor(sum, 32);
                const float inv = 1.0f / sum;
#pragma unroll
                for (int s = 0; s < 8; ++s) pf[tile][s] = pack8(acc[2 * s] * inv, acc[2 * s + 1] * inv);
            }
        }
        __syncthreads();
        if (f32src) { at_stage_half<true>(Vsrc, 0, buf0, AT_VS); at_stage_half<true>(Vsrc, 1, buf1, AT_VS); }
        else { at_stage_half<false>(Vsrc, 0, buf0, AT_VS); at_stage_half<false>(Vsrc, 1, buf1, AT_VS); }
        __syncthreads();
#pragma unroll
        for (int tile = 0; tile < 2; ++tile) {
            if (tile < ntiles) {
                const int tl0 = (ntok == 256 ? wv * 32 : 0) + tile * 16;
#pragma unroll
                for (int half = 0; half < 2; ++half) {
                    f32x4 o[8];
#pragma unroll
                    for (int dt = 0; dt < 8; ++dt) o[dt] = (f32x4){0.f, 0.f, 0.f, 0.f};
                    const LAS unsigned char* vb = half ? buf1 : buf0;
#pragma unroll
                    for (int s = 0; s < 8; ++s) {
#pragma unroll
                        for (int dt = 0; dt < 8; ++dt) {
                            const LAS unsigned char* a0 = vb + (32 * s + 4 * q + (r >> 2)) * AT_VS + (16 * dt + 4 * (r & 3)) * 2;
                            const s16x4 lo = __builtin_amdgcn_ds_read_tr16_b64_v4i16((LAS s16x4*)a0);
                            const s16x4 hi = __builtin_amdgcn_ds_read_tr16_b64_v4i16((LAS s16x4*)(a0 + 16 * AT_VS));
                            bf16x8 bfr; bfr[0] = lo[0]; bfr[1] = lo[1]; bfr[2] = lo[2]; bfr[3] = lo[3]; bfr[4] = hi[0]; bfr[5] = hi[1]; bfr[6] = hi[2]; bfr[7] = hi[3];
                            o[dt] = __builtin_amdgcn_mfma_f32_16x16x32_bf16(pf[tile][s], bfr, o[dt], 0, 0, 0);
                        }
                    }
#pragma unroll
                    for (int dt = 0; dt < 8; ++dt)
#pragma unroll
                        for (int j = 0; j < 4; ++j) {
                            const int tl = tl0 + 4 * q + j;
                            if (tl < ntok) OB[(size_t)(t0 + tl) * 1024 + h * 256 + half * 128 + 16 * dt + r] = f2bf(o[dt][j]);
                        }
                }
            }
        }
    }
}

constexpr int PE_TOK = 68;
constexpr int PE_KSTR = 272;
constexpr int PE_SUBK = 0;
constexpr int PE_SELI = 0, PE_SELG = PE_TOK * 128 * 4;
constexpr int PE_TOP = 69632;
constexpr int PE_PT = PE_TOP + PE_TOK * 8 * 33 * 4;

template <int CTRL> __device__ __forceinline__ float dppf(float v) { return __int_as_float(__builtin_amdgcn_update_dpp(0, __float_as_int(v), CTRL, 0xF, 0xF, true)); }
__device__ __forceinline__ float wave_sum_u(float v) {
    v += dppf<0xB1>(v); v += dppf<0x4E>(v); v += dppf<0x141>(v); v += dppf<0x140>(v);
    const float a = __int_as_float(__builtin_amdgcn_readlane(__float_as_int(v), 0)), b = __int_as_float(__builtin_amdgcn_readlane(__float_as_int(v), 16));
    const float c = __int_as_float(__builtin_amdgcn_readlane(__float_as_int(v), 32)), d = __int_as_float(__builtin_amdgcn_readlane(__float_as_int(v), 48));
    return (a + b) + (c + d);
}
typedef __bf16 bf16x2v __attribute__((ext_vector_type(2)));
__device__ __forceinline__ float dot2bf(unsigned a, unsigned b, float acc) {
    return __builtin_amdgcn_fdot2_f32_bf16(__builtin_bit_cast(bf16x2v, a), __builtin_bit_cast(bf16x2v, b), acc, false);
}
__device__ __forceinline__ float gelu_erf(float x) { return 0.5f * x * (1.0f + erff(x * 0.70710678118654752f)); }

__device__ __forceinline__ void peer_phase(const Params& p, LAS unsigned char* lds) {
    unsigned char* ws = p.ws;
    const bf16* PQB = (const bf16*)(ws + WS_PQB);
    const bf16* SUBK = (const bf16*)(ws + WS_SUBK);
    const bf16* PU = (const bf16*)(ws + WS_PU);
    const bf16* PVt = (const bf16*)(ws + WS_PV);
    const float* H = (const float*)(ws + WS_H);
    const float* SS2 = (const float*)(ws + WS_CTL + CTL_SS2);
    const float* gffn = p.in[27]; const float* gfin = p.in[32];
    float* Y = p.out + O_Y;
    const int tid = threadIdx.x, lane = tid & 63, wv = tid >> 6, r = lane & 15, q = lane >> 4;
    LAS float* TOP = (LAS float*)(lds + PE_TOP);
    LAS unsigned* SELI = (LAS unsigned*)(lds + PE_SELI);
    LAS float* SELG = (LAS float*)(lds + PE_SELG);
    LAS unsigned char* PT = lds + PE_PT;

    for (int chunk = blockIdx.x; chunk < T / PE_TOK; chunk += gridDim.x) {
        const int tok0 = chunk * PE_TOK;
        __syncthreads();
#pragma unroll
        for (int i = 0; i < 8; ++i) {
            const int e = tid + i * NT, row = e >> 4, c16 = e & 15;
            *(LAS u32x4*)(lds + PE_SUBK + row * PE_KSTR + c16 * 16) = *(const u32x4*)(SUBK + (size_t)row * 128 + c16 * 8);
        }
        if (tid < 64) {
            int i = 0, base = 0, k = tid;
            if (k < 50) { while (k - base >= 16 / (i + 1)) { base += 16 / (i + 1); ++i; } PT[k] = (unsigned char)((i << 4) | (k - base)); }
            else PT[k] = 0;
        }
        __syncthreads();
        {
            const int h = wv;
            for (int nt = 0; nt < 5; ++nt) {
                const int tl = nt * 16 + r;
                const int t = tok0 + (tl < PE_TOK ? tl : PE_TOK - 1);
#pragma unroll
                for (int c = 0; c < 2; ++c) {
                    bf16x8 qf[4];
#pragma unroll
                    for (int ks = 0; ks < 4; ++ks) qf[ks] = *(const bf16x8*)(PQB + (size_t)t * 2048 + h * 256 + c * 128 + 32 * ks + 8 * q);
                    f32x4 acc[8];
#pragma unroll
                    for (int mt = 0; mt < 8; ++mt) acc[mt] = (f32x4){0.f, 0.f, 0.f, 0.f};
#pragma unroll
                    for (int ks = 0; ks < 4; ++ks)
#pragma unroll
                        for (int mt = 0; mt < 8; ++mt) {
                            const bf16x8 a = *(const LAS bf16x8*)(lds + PE_SUBK + (c * 128 + 16 * mt + r) * PE_KSTR + (32 * ks + 8 * q) * 2);
                            acc[mt] = __builtin_amdgcn_mfma_f32_16x16x32_bf16(a, qf[ks], acc[mt], 0, 0, 0);
                        }
                    float v[32];
#pragma unroll
                    for (int mt = 0; mt < 8; ++mt)
#pragma unroll
                        for (int j = 0; j < 4; ++j) v[mt * 4 + j] = __uint_as_float((__float_as_uint(acc[mt][j]) & ~127u) | (unsigned)(16 * mt + 4 * q + j));
                    float top[16];
#pragma unroll
                    for (int rd = 0; rd < 16; ++rd) {
                        float m = v[0];
#pragma unroll
                        for (int i = 1; i < 32; ++i) m = fmaxf(m, v[i]);
                        m = fmaxf(m, __shfl_xor(m, 16)); m = fmaxf(m, __shfl_xor(m, 32));
                        top[rd] = m;
#pragma unroll
                        for (int i = 0; i < 32; ++i) v[i] = (v[i] == m) ? -3.0e38f : v[i];
                    }
                    if (q == 0 && tl < PE_TOK) {
                        LAS float* dst = TOP + (tl * 8 + h) * 33 + c * 16;
#pragma unroll
                        for (int i = 0; i < 16; ++i) dst[i] = top[i];
                    }
                }
            }
        }
        __syncthreads();
        for (int pr = tid; pr < PE_TOK * 8; pr += NT) {
            const LAS float* tp = TOP + pr * 33;
            float A[16], B[16];
#pragma unroll
            for (int i = 0; i < 16; ++i) { A[i] = tp[i]; B[i] = tp[16 + i]; }
            float cd[50];
            {
                int k = 0;
#pragma unroll
                for (int i = 0; i < 16; ++i)
#pragma unroll
                    for (int j = 0; j < 16; ++j)
                        if ((i + 1) * (j + 1) <= 16) { cd[k] = __uint_as_float((__float_as_uint(A[i] + B[j]) & ~63u) | (unsigned)k); ++k; }
            }
            float win[16];
#pragma unroll
            for (int rd = 0; rd < 16; ++rd) {
                float m = cd[0];
#pragma unroll
                for (int i = 1; i < 50; ++i) m = fmaxf(m, cd[i]);
                win[rd] = m;
#pragma unroll
                for (int i = 0; i < 50; ++i) cd[i] = (cd[i] == m) ? -3.0e38f : cd[i];
            }
            float e[16], sum = 0.f;
#pragma unroll
            for (int rd = 0; rd < 16; ++rd) { e[rd] = __expf(win[rd] - win[0]); sum += e[rd]; }
            const float inv = 1.0f / sum;
            const int tl = pr >> 3, h = pr & 7;
#pragma unroll
            for (int rd = 0; rd < 16; ++rd) {
                const unsigned k = __float_as_uint(win[rd]) & 63u;
                const unsigned ij = PT[k];
                const unsigned ka = __float_as_uint(tp[ij >> 4]) & 127u, kb = __float_as_uint(tp[16 + (ij & 15)]) & 127u;
                SELI[tl * 128 + h * 16 + rd] = ka * 128u + kb;
                SELG[tl * 128 + h * 16 + rd] = e[rd] * inv;
            }
        }
        __syncthreads();
        for (int tl = wv; tl < PE_TOK; tl += 8) {
            const size_t t = (size_t)(tok0 + tl);
            const float rstd2 = rsqrtf(SS2[t] * (1.0f / 1024.0f) + 1e-6f);
            float hrow[16]; unsigned xp[8];
#pragma unroll
            for (int i = 0; i < 4; ++i) {
                const float4 hv = *(const float4*)(H + t * 1024 + 16 * lane + 4 * i);
                const float4 gv = *(const float4*)(gffn + 16 * lane + 4 * i);
                hrow[4 * i] = hv.x; hrow[4 * i + 1] = hv.y; hrow[4 * i + 2] = hv.z; hrow[4 * i + 3] = hv.w;
                xp[2 * i] = pack2(hv.x * rstd2 * gv.x, hv.y * rstd2 * gv.y); xp[2 * i + 1] = pack2(hv.z * rstd2 * gv.z, hv.w * rstd2 * gv.w);
            }
            float dsel[2] = {0.f, 0.f};
#pragma unroll
            for (int half = 0; half < 2; ++half) {
                for (int p0 = 0; p0 < 64; p0 += 8) {
                    u32x4 ua[8], ub[8];
#pragma unroll
                    for (int u = 0; u < 8; ++u) {
                        const unsigned e = (unsigned)__builtin_amdgcn_readfirstlane((int)SELI[tl * 128 + half * 64 + p0 + u]);
                        const bf16* row = PU + (size_t)e * 1024 + 16 * lane;
                        ua[u] = *(const u32x4*)row; ub[u] = *(const u32x4*)(row + 8);
                    }
#pragma unroll
                    for (int u = 0; u < 8; ++u) {
                        float d = 0.f;
                        d = dot2bf(ua[u].x, xp[0], d); d = dot2bf(ua[u].y, xp[1], d); d = dot2bf(ua[u].z, xp[2], d); d = dot2bf(ua[u].w, xp[3], d);
                        d = dot2bf(ub[u].x, xp[4], d); d = dot2bf(ub[u].y, xp[5], d); d = dot2bf(ub[u].z, xp[6], d); d = dot2bf(ub[u].w, xp[7], d);
                        const float tot = wave_sum_u(d);
                        dsel[half] = (lane == p0 + u) ? tot : dsel[half];
                    }
                }
            }
            float cf[2];
            cf[0] = SELG[tl * 128 + lane] * gelu_erf(dsel[0]);
            cf[1] = SELG[tl * 128 + 64 + lane] * gelu_erf(dsel[1]);
            float out[16];
#pragma unroll
            for (int i = 0; i < 16; ++i) out[i] = 0.f;
#pragma unroll
            for (int half = 0; half < 2; ++half) {
                for (int p0 = 0; p0 < 64; p0 += 8) {
                    u32x4 va[8], vb[8];
#pragma unroll
                    for (int u = 0; u < 8; ++u) {
                        const unsigned e = (unsigned)__builtin_amdgcn_readfirstlane((int)SELI[tl * 128 + half * 64 + p0 + u]);
                        const bf16* row = PVt + (size_t)e * 1024 + 16 * lane;
                        va[u] = *(const u32x4*)row; vb[u] = *(const u32x4*)(row + 8);
                    }
#pragma unroll
                    for (int u = 0; u < 8; ++u) {
                        const float c = __shfl(cf[half], p0 + u);
                        const unsigned w[8] = {va[u].x, va[u].y, va[u].z, va[u].w, vb[u].x, vb[u].y, vb[u].z, vb[u].w};
#pragma unroll
                        for (int i = 0; i < 8; ++i) {
                            out[2 * i] += c * __uint_as_float(w[i] << 16);
                            out[2 * i + 1] += c * __uint_as_float(w[i] & 0xffff0000u);
                        }
                    }
                }
            }
            float ss = 0.f;
#pragma unroll
            for (int i = 0; i < 16; ++i) { out[i] += hrow[i]; ss += out[i] * out[i]; }
            ss = wave_sum_u(ss);
            const float rs = rsqrtf(ss * (1.0f / 1024.0f) + 1e-6f);
#pragma unroll
            for (int i = 0; i < 4; ++i) {
                const float4 gv = *(const float4*)(gfin + 16 * lane + 4 * i);
                float4 o; o.x = out[4 * i] * rs * gv.x; o.y = out[4 * i + 1] * rs * gv.y; o.z = out[4 * i + 2] * rs * gv.z; o.w = out[4 * i + 3] * rs * gv.w;
                *(float4*)(Y + t * 1024 + 16 * lane + 4 * i) = o;
            }
        }
    }
}


__device__ __forceinline__ bf16x8 frag_tr(const LAS unsigned char* base, int stride, int k0, int n0, int r, int q) {
    const LAS unsigned char* a0 = base + (k0 + 4 * q + (r >> 2)) * stride + (n0 + 4 * (r & 3)) * 2;
    const s16x4 lo = __builtin_amdgcn_ds_read_tr16_b64_v4i16((LAS s16x4*)a0);
    const s16x4 hi = __builtin_amdgcn_ds_read_tr16_b64_v4i16((LAS s16x4*)(a0 + 16 * stride));
    bf16x8 o; o[0] = lo[0]; o[1] = lo[1]; o[2] = lo[2]; o[3] = lo[3]; o[4] = hi[0]; o[5] = hi[1]; o[6] = hi[2]; o[7] = hi[3];
    return o;
}
__device__ __forceinline__ bf16x8 frag_kc_pk(const LAS unsigned char* base, int stride, int m0, int k0, int r, int q) {
    const LAS unsigned char* a0 = base + (m0 + r) * stride + (k0 + 4 * q) * 2;
    const u32x2 lo = *(const LAS u32x2*)a0, hi = *(const LAS u32x2*)(a0 + 32);
    u32x4 w; w.x = lo.x; w.y = lo.y; w.z = hi.x; w.w = hi.y;
    return __builtin_bit_cast(bf16x8, w);
}
__device__ __forceinline__ bf16x8 frag_kc(const LAS unsigned char* base, int stride, int m0, int k0, int r, int q) {
    return *(const LAS bf16x8*)(base + (m0 + r) * stride + (k0 + 8 * q) * 2);
}
__device__ __forceinline__ float softplus_f(float x) { return x > 20.f ? x : log1pf(__expf(x)); }
__device__ __forceinline__ float silu_f(float x) { return x / (1.0f + __expf(-x)); }

constexpr int SD_RAW = 0, SD_RAWS = 656;
constexpr int SD_XN = 44032, SD_XS = 160;
constexpr int SD_XW = SD_XN + 64 * 160;
constexpr int SD_BN = SD_XW + 64 * 160, SD_BS = 288;
constexpr int SD_CN = SD_BN + 64 * 288, SD_CS = 272;
constexpr int SD_ST = SD_CN + 64 * 272, SD_SS = 160;
constexpr int SD_SC = SD_ST + 128 * 160;
constexpr int SD_END = SD_SC + 1024;

__device__ __forceinline__ void ssd_load_raw(const Params& p, u32x4 (&raw)[6], int c, bool prompt, int b, int head, int g, int t0, int nvalid) {
    const bf16* PROJB = (const bf16*)(p.ws + WS_PROJB);
    const int tid = threadIdx.x;
#pragma unroll
    for (int i = 0; i < 6; ++i) {
        const int e = tid + NT * i, row = e / 40, pc = e - row * 40, l = row - 3;
        u32x4 v = (u32x4){0u, 0u, 0u, 0u};
        if (row < 67) {
            const int col = pc < 8 ? head * 64 + pc * 8 : (pc < 24 ? 1024 + g * 128 + (pc - 8) * 8 : 1280 + g * 128 + (pc - 24) * 8);
            const int ls = c * 64 + l;
            if (ls >= 0) { if (l < nvalid) v = *(const u32x4*)(PROJB + (size_t)(t0 + ls) * PROJW + 3072 + col); }
            else if (!prompt) {
                const float* s = p.in[4] + ((size_t)b * 3 + (3 + ls)) * SSM_XBC + col;
                const float4 a = *(const float4*)s, bb = *(const float4*)(s + 4);
                v.x = pack2(a.x, a.y); v.y = pack2(a.z, a.w); v.z = pack2(bb.x, bb.y); v.w = pack2(bb.z, bb.w);
            }
        }
        raw[i] = v;
    }
}

template <bool YGF32>
__device__ __forceinline__ void ssd_stream(const Params& p, LAS unsigned char* lds, bool prompt, int b, int head, void* YG) {
    unsigned char* ws = p.ws;
    const bf16* PROJB = (const bf16*)(ws + WS_PROJB);
    const float* SMALL = (const float*)(ws + WS_SMALL);
    const float* conv_w = p.in[15]; const float* conv_b = p.in[16];
    const int tid = threadIdx.x, lane = tid & 63, wv = tid >> 6, r = lane & 15, q = lane >> 4;
    const int g = head >> 3;
    const int nchunks = prompt ? 32 : 1, nvalid = prompt ? 64 : DECS, t0 = prompt ? b * SEQ : TP + b * DECS;
    const float Ah = -__expf(p.in[17][head]), dtb = p.in[18][head], Dh = p.in[19][head];
    LAS float* SC = (LAS float*)(lds + SD_SC);

    const int pt_s = wv & 3, nh = wv >> 2;
    f32x4 Sacc[4];
#pragma unroll
    for (int i = 0; i < 4; ++i) {
        if (prompt) Sacc[i] = (f32x4){0.f, 0.f, 0.f, 0.f};
        else {
            const float* s0 = p.in[5] + (((size_t)b * 16 + head) * 64 + 16 * pt_s + 4 * q) * 128 + 16 * (4 * nh + i) + r;
            Sacc[i] = (f32x4){s0[0], s0[128], s0[256], s0[384]};
        }
    }
    __syncthreads();
#pragma unroll
    for (int i = 0; i < 4; ++i) {
        u32x2 w; w.x = pack2(Sacc[i][0], Sacc[i][1]); w.y = pack2(Sacc[i][2], Sacc[i][3]);
        *(LAS u32x2*)(lds + SD_ST + (16 * (4 * nh + i) + r) * SD_SS + (16 * pt_s + 4 * q) * 2) = w;
    }

    u32x4 raw[6];
    ssd_load_raw(p, raw, 0, prompt, b, head, g, t0, nvalid);
    for (int c = 0; c < nchunks; ++c) {
        __syncthreads();
#pragma unroll
        for (int i = 0; i < 6; ++i) { const int e = tid + NT * i, row = e / 40, pc = e - row * 40; if (row < 67) *(LAS u32x4*)(lds + SD_RAW + row * SD_RAWS + pc * 16) = raw[i]; }
        if (c + 1 < nchunks) ssd_load_raw(p, raw, c + 1, prompt, b, head, g, t0, nvalid);
        if (wv == 0) {
            const int l = lane; const bool valid = l < nvalid;
            const size_t t = (size_t)(t0 + c * 64 + (valid ? l : 0));
            const float dt = valid ? softplus_f(SMALL[t * 32 + 16 + head] + dtb) : 0.f;
            float acs = dt * Ah;
#pragma unroll
            for (int o = 1; o < 64; o <<= 1) { const float up = __shfl_up(acs, o); if (lane >= o) acs += up; }
            const float last = __shfl(acs, 63);
            SC[l] = dt; SC[64 + l] = acs; SC[128 + l] = dt * __expf(last - acs); SC[192 + l] = __expf(acs);
        }
        __syncthreads();
#pragma unroll 1
        for (int i = 0; i < 5; ++i) {
            const int e = tid + NT * i, l = e / 40, pc = e - l * 40;
            const int col = pc < 8 ? head * 64 + pc * 8 : (pc < 24 ? 1024 + g * 128 + (pc - 8) * 8 : 1280 + g * 128 + (pc - 24) * 8);
            float acc[8];
            { const float4 b0 = *(const float4*)(conv_b + col), b1 = *(const float4*)(conv_b + col + 4);
              acc[0] = b0.x; acc[1] = b0.y; acc[2] = b0.z; acc[3] = b0.w; acc[4] = b1.x; acc[5] = b1.y; acc[6] = b1.z; acc[7] = b1.w; }
#pragma unroll
            for (int tp = 0; tp < 4; ++tp) {
                const u32x4 rv = *(const LAS u32x4*)(lds + SD_RAW + (l + tp) * SD_RAWS + pc * 16);
                const float4 w0 = *(const float4*)(conv_w + tp * SSM_XBC + col), w1 = *(const float4*)(conv_w + tp * SSM_XBC + col + 4);
                acc[0] += w0.x * __uint_as_float(rv.x << 16); acc[1] += w0.y * __uint_as_float(rv.x & 0xffff0000u);
                acc[2] += w0.z * __uint_as_float(rv.y << 16); acc[3] += w0.w * __uint_as_float(rv.y & 0xffff0000u);
                acc[4] += w1.x * __uint_as_float(rv.z << 16); acc[5] += w1.y * __uint_as_float(rv.z & 0xffff0000u);
                acc[6] += w1.z * __uint_as_float(rv.w << 16); acc[7] += w1.w * __uint_as_float(rv.w & 0xffff0000u);
            }
            const bool valid = l < nvalid;
#pragma unroll
            for (int k = 0; k < 8; ++k) acc[k] = valid ? silu_f(acc[k]) : 0.f;
            u32x4 o; o.x = pack2(acc[0], acc[1]); o.y = pack2(acc[2], acc[3]); o.z = pack2(acc[4], acc[5]); o.w = pack2(acc[6], acc[7]);
            if (pc < 8) {
                *(LAS u32x4*)(lds + SD_XN + l * SD_XS + pc * 16) = o;
                const float wl = SC[128 + l];
                u32x4 o2; o2.x = pack2(acc[0] * wl, acc[1] * wl); o2.y = pack2(acc[2] * wl, acc[3] * wl); o2.z = pack2(acc[4] * wl, acc[5] * wl); o2.w = pack2(acc[6] * wl, acc[7] * wl);
                *(LAS u32x4*)(lds + SD_XW + l * SD_XS + pc * 16) = o2;
            } else if (pc < 24) *(LAS u32x4*)(lds + SD_BN + l * SD_BS + (pc - 8) * 16) = o;
            else *(LAS u32x4*)(lds + SD_CN + l * SD_CS + (pc - 24) * 16) = o;
        }
        __syncthreads();
        {
            const int lt = wv & 3, ph = wv >> 2;
            f32x4 Y[2] = {(f32x4){0.f, 0.f, 0.f, 0.f}, (f32x4){0.f, 0.f, 0.f, 0.f}};
#pragma unroll
            for (int ks = 0; ks < 4; ++ks) {
                const bf16x8 a = frag_kc_pk(lds + SD_CN, SD_CS, 16 * lt, 32 * ks, r, q);
#pragma unroll
                for (int pi = 0; pi < 2; ++pi) {
                    const bf16x8 bb = frag_tr(lds + SD_ST, SD_SS, 32 * ks, 16 * (2 * ph + pi), r, q);
                    Y[pi] = __builtin_amdgcn_mfma_f32_16x16x32_bf16(a, bb, Y[pi], 0, 0, 0);
                }
            }
#pragma unroll
            for (int j = 0; j < 4; ++j) { const float ea = SC[192 + 16 * lt + 4 * q + j]; Y[0][j] *= ea; Y[1][j] *= ea; }
            f32x4 G[4];
            const float acs_l = SC[64 + 16 * lt + r];
#pragma unroll
            for (int mt = 0; mt < 4; ++mt) {
                G[mt] = (f32x4){0.f, 0.f, 0.f, 0.f};
                if (mt <= lt) {
#pragma unroll
                    for (int ks = 0; ks < 4; ++ks) {
                        const bf16x8 a = frag_kc(lds + SD_BN, SD_BS, 16 * mt, 32 * ks, r, q);
                        const bf16x8 bb = frag_kc(lds + SD_CN, SD_CS, 16 * lt, 32 * ks, r, q);
                        G[mt] = __builtin_amdgcn_mfma_f32_16x16x32_bf16(a, bb, G[mt], 0, 0, 0);
                    }
#pragma unroll
                    for (int j = 0; j < 4; ++j) {
                        const int lp = 16 * mt + 4 * q + j, l = 16 * lt + r;
                        G[mt][j] = (lp <= l) ? G[mt][j] * __expf(acs_l - SC[64 + lp]) * SC[lp] : 0.f;
                    }
                }
            }
#pragma unroll
            for (int s = 0; s < 2; ++s) {
                if (2 * s <= lt) {
                    const bf16x8 a = pack8(G[2 * s], G[2 * s + 1]);
#pragma unroll
                    for (int pi = 0; pi < 2; ++pi) {
                        const bf16x8 bb = frag_tr(lds + SD_XN, SD_XS, 32 * s, 16 * (2 * ph + pi), r, q);
                        Y[pi] = __builtin_amdgcn_mfma_f32_16x16x32_bf16(a, bb, Y[pi], 0, 0, 0);
                    }
                }
            }
#pragma unroll
            for (int pi = 0; pi < 2; ++pi)
#pragma unroll
                for (int j = 0; j < 4; ++j) {
                    const int l = 16 * lt + 4 * q + j, pp = 16 * (2 * ph + pi) + r;
                    if (l < nvalid) {
                        const size_t t = (size_t)(t0 + c * 64 + l);
                        const float x = bf2f(*(const LAS bf16*)(lds + SD_XN + l * SD_XS + pp * 2));
                        const float z = bf2f(PROJB[t * PROJW + 5632 + head * 64 + pp]);
                        const float yv = (Y[pi][j] + Dh * x) * silu_f(z);
                        if (YGF32) ((float*)YG)[t * 1024 + head * 64 + pp] = yv; else ((bf16*)YG)[t * 1024 + head * 64 + pp] = f2bf(yv);
                    }
                }
        }
        __syncthreads();
        {
            const float dec = SC[192 + 63];
#pragma unroll
            for (int i = 0; i < 4; ++i) {
                f32x4 acc = Sacc[i] * dec;
#pragma unroll
                for (int s = 0; s < 2; ++s) {
                    const bf16x8 a = frag_tr(lds + SD_XW, SD_XS, 32 * s, 16 * pt_s, r, q);
                    const bf16x8 bb = frag_tr(lds + SD_BN, SD_BS, 32 * s, 16 * (4 * nh + i), r, q);
                    acc = __builtin_amdgcn_mfma_f32_16x16x32_bf16(a, bb, acc, 0, 0, 0);
                }
                Sacc[i] = acc;
                u32x2 w; w.x = pack2(acc[0], acc[1]); w.y = pack2(acc[2], acc[3]);
                *(LAS u32x2*)(lds + SD_ST + (16 * (4 * nh + i) + r) * SD_SS + (16 * pt_s + 4 * q) * 2) = w;
            }
        }
    }
    float* so = p.out + (prompt ? O_P_SS : O_S_SS) + (((size_t)b * 16 + head) * 64) * 128;
#pragma unroll
    for (int i = 0; i < 4; ++i)
#pragma unroll
        for (int j = 0; j < 4; ++j) so[(size_t)(16 * pt_s + 4 * q + j) * 128 + 16 * (4 * nh + i) + r] = Sacc[i][j];
}

constexpr size_t DN_ITEM_BYTES = 73728;
constexpr int DN_NITEMS = 2048 + 1024;
constexpr size_t WS_DNI = WS_MIX;
constexpr size_t WS_DNGT = WS_DNI + (size_t)DN_NITEMS * DN_ITEM_BYTES;

constexpr int DP_RAW = 0, DP_RAWS = 784;
constexpr int DP_QN = 52736, DP_TS = 272;
constexpr int DP_KN = DP_QN + 64 * 272;
constexpr int DP_KB = DP_KN + 64 * 272;
constexpr int DP_VN = DP_KB + 64 * 272;
constexpr int DP_LB = DP_VN + 64 * 272, DP_LS = 144;
constexpr int DP_LF = DP_LB + 64 * 144;
constexpr int DP_TD = DP_LF + 4 * 16 * 17 * 4, DP_TDS = 80;
constexpr int DP_SC = DP_TD + 64 * 80;
constexpr int DP_END = DP_SC + 1024;

__device__ __forceinline__ float sigmoid_f(float x) { return 1.0f / (1.0f + __expf(-x)); }

__device__ __forceinline__ void dn_prep_item(const Params& p, LAS unsigned char* lds, int item) {
    unsigned char* ws = p.ws;
    const bf16* PROJB = (const bf16*)(ws + WS_PROJB);
    const float* SMALL = (const float*)(ws + WS_SMALL);
    const float* conv_w = p.in[11];
    const int tid = threadIdx.x, lane = tid & 63, wv = tid >> 6, r = lane & 15, q = lane >> 4;
    const bool prompt = item < 2048;
    int b, h, c;
    if (prompt) { b = item >> 8; h = (item >> 5) & 7; c = item & 31; } else { b = (item - 2048) >> 3; h = (item - 2048) & 7; c = 0; }
    const int nvalid = prompt ? 64 : DECS, t0 = prompt ? b * SEQ : TP + b * DECS;
    unsigned char* ib = ws + WS_DNI + (size_t)item * DN_ITEM_BYTES;
    bf16* UT = (bf16*)ib; bf16* WT = (bf16*)(ib + 16384); bf16* QD = (bf16*)(ib + 32768); bf16* KDT = (bf16*)(ib + 49152); bf16* ATT = (bf16*)(ib + 65536);
    LAS float* SC = (LAS float*)(lds + DP_SC);
    LAS float* LF = (LAS float*)(lds + DP_LF);
    const float Ah = -__expf(p.in[12][h]), dtb = p.in[13][h];

    __syncthreads();
#pragma unroll 1
    for (int i = 0; i < 7; ++i) {
        const int e = tid + NT * i, row = e / 48, pc = e - row * 48, l = row - 3;
        if (row < 67) {
            u32x4 v = (u32x4){0u, 0u, 0u, 0u};
            const int col = (pc >> 4) * 1024 + h * 128 + (pc & 15) * 8;
            const int ls = c * 64 + l;
            if (ls >= 0) { if (l < nvalid) v = *(const u32x4*)(PROJB + (size_t)(t0 + ls) * PROJW + col); }
            else if (!prompt) {
                const float* s = p.in[2] + ((size_t)b * 3 + (3 + ls)) * DN_QKV + col;
                const float4 a = *(const float4*)s, bb = *(const float4*)(s + 4);
                v.x = pack2(a.x, a.y); v.y = pack2(a.z, a.w); v.z = pack2(bb.x, bb.y); v.w = pack2(bb.z, bb.w);
            }
            *(LAS u32x4*)(lds + DP_RAW + row * DP_RAWS + pc * 16) = v;
        }
    }
    for (int i = tid; i < (64 * 144 + 4 * 16 * 17 * 4 + 64 * 80) / 4; i += NT) ((LAS unsigned*)(lds + DP_LB))[i] = 0u;
    if (wv == 0) {
        const int l = lane; const bool valid = l < nvalid;
        const size_t t = (size_t)(t0 + c * 64 + (valid ? l : 0));
        const float beta = valid ? sigmoid_f(SMALL[t * 32 + h]) : 0.f;
        float gc = valid ? Ah * softplus_f(SMALL[t * 32 + 8 + h] + dtb) : 0.f;
#pragma unroll
        for (int o = 1; o < 64; o <<= 1) { const float up = __shfl_up(gc, o); if (lane >= o) gc += up; }
        const float last = __shfl(gc, 63);
        SC[l] = beta; SC[64 + l] = gc; SC[128 + l] = __expf(gc); SC[192 + l] = __expf(last - gc);
        if (lane == 0) ((float*)(ws + WS_DNGT))[item] = __expf(last);
    }
    __syncthreads();
    {
        const int l = tid >> 3, ch = tid & 7;
        const bool valid = l < nvalid;
        const float beta = SC[l], egc = SC[128 + l];
#pragma unroll 1
        for (int part = 2; part >= 0; --part) {
            float acc[16];
#pragma unroll
            for (int k = 0; k < 16; ++k) acc[k] = 0.f;
            const int col = part * 1024 + h * 128 + ch * 16;
#pragma unroll
            for (int tp = 0; tp < 4; ++tp) {
                const LAS unsigned char* rp = lds + DP_RAW + (l + tp) * DP_RAWS + (part * 16 + ch * 2) * 16;
                const u32x4 r0 = *(const LAS u32x4*)rp, r1 = *(const LAS u32x4*)(rp + 16);
                const float* wp = conv_w + tp * DN_QKV + col;
                const float4 w0 = *(const float4*)wp, w1 = *(const float4*)(wp + 4), w2 = *(const float4*)(wp + 8), w3 = *(const float4*)(wp + 12);
                acc[0] += w0.x * __uint_as_float(r0.x << 16); acc[1] += w0.y * __uint_as_float(r0.x & 0xffff0000u);
                acc[2] += w0.z * __uint_as_float(r0.y << 16); acc[3] += w0.w * __uint_as_float(r0.y & 0xffff0000u);
                acc[4] += w1.x * __uint_as_float(r0.z << 16); acc[5] += w1.y * __uint_as_float(r0.z & 0xffff0000u);
                acc[6] += w1.z * __uint_as_float(r0.w << 16); acc[7] += w1.w * __uint_as_float(r0.w & 0xffff0000u);
                acc[8] += w2.x * __uint_as_float(r1.x << 16); acc[9] += w2.y * __uint_as_float(r1.x & 0xffff0000u);
                acc[10] += w2.z * __uint_as_float(r1.y << 16); acc[11] += w2.w * __uint_as_float(r1.y & 0xffff0000u);
                acc[12] += w3.x * __uint_as_float(r1.z << 16); acc[13] += w3.y * __uint_as_float(r1.z & 0xffff0000u);
                acc[14] += w3.z * __uint_as_float(r1.w << 16); acc[15] += w3.w * __uint_as_float(r1.w & 0xffff0000u);
            }
            float ss = 0.f;
#pragma unroll
            for (int k = 0; k < 16; ++k) { acc[k] = valid ? silu_f(acc[k]) : 0.f; ss += acc[k] * acc[k]; }
            ss += __shfl_xor(ss, 1); ss += __shfl_xor(ss, 2); ss += __shfl_xor(ss, 4);
            const float sc = part == 2 ? 1.0f : (part == 1 ? rsqrtf(ss + 1e-6f) : rsqrtf(ss + 1e-6f) * 0.08838834764831845f);
            const float sc2 = part == 1 ? beta : egc;
            const int off = l * DP_TS + ch * 32;
#pragma unroll
            for (int hh = 0; hh < 2; ++hh) {
                unsigned w1[4], w2[4];
#pragma unroll
                for (int k = 0; k < 4; ++k) {
                    const float a0 = acc[hh * 8 + 2 * k] * sc, a1 = acc[hh * 8 + 2 * k + 1] * sc;
                    w1[k] = pack2(a0, a1); w2[k] = pack2(a0 * sc2, a1 * sc2);
                }
                const u32x4 o1 = (u32x4){w1[0], w1[1], w1[2], w1[3]}, o2 = (u32x4){w2[0], w2[1], w2[2], w2[3]};
                if (part == 2) *(LAS u32x4*)(lds + DP_VN + off + hh * 16) = o1;
                else if (part == 1) { *(LAS u32x4*)(lds + DP_KN + off + hh * 16) = o1; *(LAS u32x4*)(lds + DP_KB + off + hh * 16) = o2; }
                else { *(LAS u32x4*)(lds + DP_QN + off + hh * 16) = o1; *(u32x4*)(QD + l * 128 + ch * 16 + hh * 8) = o2; }
            }
        }
    }
    __syncthreads();
    for (int tile = wv; tile < 20; tile += 8) {
        const int id = tile % 10, isqk = tile / 10;
        int it = 0, jt = id; while (jt > it) { jt -= it + 1; ++it; }
        f32x4 acc = (f32x4){0.f, 0.f, 0.f, 0.f};
#pragma unroll
        for (int ks = 0; ks < 4; ++ks) {
            const bf16x8 a = frag_kc(lds + (isqk ? DP_QN : DP_KB), DP_TS, 16 * it, 32 * ks, r, q);
            const bf16x8 bb = frag_kc(lds + DP_KN, DP_TS, 16 * jt, 32 * ks, r, q);
            acc = __builtin_amdgcn_mfma_f32_16x16x32_bf16(a, bb, acc, 0, 0, 0);
        }
        const int j = 16 * jt + r;
        const float gcj = SC[64 + j];
#pragma unroll
        for (int jj = 0; jj < 4; ++jj) {
            const int i = 16 * it + 4 * q + jj;
            const float dec = __expf(SC[64 + i] - gcj);
            if (isqk) { ATT[i * 64 + j] = f2bf(j <= i ? acc[jj] * dec : 0.f); }
            else {
                const float lv = (j < i) ? acc[jj] * dec : 0.f;
                *(LAS bf16*)(lds + DP_LB + i * DP_LS + j * 2) = f2bf(-lv);
                if (it == jt) LF[(it * 16 + (4 * q + jj)) * 17 + r] = lv;
            }
        }
    }
    if (wv >= 4) {
        for (int e = tid - 256; e < 6 * 256; e += 256) {
            const int tix = e >> 8, w = e & 255; const int it = tix < 3 ? 0 : (tix < 5 ? 1 : 2), jt = tix < 3 ? tix + 1 : (tix < 5 ? tix - 1 : 3);
            ATT[(16 * it + (w >> 4)) * 64 + 16 * jt + (w & 15)] = 0;
        }
    }
    __syncthreads();
    if (wv == 0) {
        const int blk = lane >> 4, col = lane & 15;
        const LAS float* Lb = LF + blk * 16 * 17;
        float x[16];
#pragma unroll
        for (int k = 0; k < 16; ++k) {
            float s = (k == col) ? 1.f : 0.f;
#pragma unroll
            for (int m = 0; m < k; ++m) s -= Lb[k * 17 + m] * x[m];
            x[k] = s;
        }
#pragma unroll
        for (int k = 0; k < 16; ++k) *(LAS bf16*)(lds + DP_TD + (16 * blk + k) * DP_TDS + col * 2) = f2bf(x[k]);
    }
    {
        const int d = tid >> 2, lq = tid & 3;
        unsigned w[8];
#pragma unroll
        for (int k = 0; k < 8; ++k) {
            const int l0 = 16 * lq + 2 * k;
            const float a = bf2f(*(const LAS bf16*)(lds + DP_KN + l0 * DP_TS + d * 2)) * SC[192 + l0];
            const float bb = bf2f(*(const LAS bf16*)(lds + DP_KN + (l0 + 1) * DP_TS + d * 2)) * SC[192 + l0 + 1];
            w[k] = pack2(a, bb);
        }
        *(u32x4*)(KDT + d * 64 + 16 * lq) = (u32x4){w[0], w[1], w[2], w[3]};
        *(u32x4*)(KDT + d * 64 + 16 * lq + 8) = (u32x4){w[4], w[5], w[6], w[7]};
    }
    __syncthreads();
    const f32x4 zero4 = (f32x4){0.f, 0.f, 0.f, 0.f};
#pragma unroll
    for (int cc = 0; cc < 2; ++cc) {
        const int ct = 2 * wv + cc;
        const bool isw = ct >= 8;
        const int colb = (ct & 7) * 16 + r;
        f32x4 R[4];
#pragma unroll
        for (int I = 0; I < 4; ++I)
#pragma unroll
            for (int jj = 0; jj < 4; ++jj) {
                const int row = 16 * I + 4 * q + jj;
                R[I][jj] = isw ? bf2f(*(const LAS bf16*)(lds + DP_KB + row * DP_TS + colb * 2)) * SC[128 + row]
                               : bf2f(*(const LAS bf16*)(lds + DP_VN + row * DP_TS + colb * 2)) * SC[row];
            }
        f32x4 X[4];
        X[0] = __builtin_amdgcn_mfma_f32_16x16x32_bf16(frag_kc_pk(lds + DP_TD, DP_TDS, 0, 0, r, q), pack8(R[0], zero4), zero4, 0, 0, 0);
        f32x4 a1 = __builtin_amdgcn_mfma_f32_16x16x32_bf16(frag_kc_pk(lds + DP_LB, DP_LS, 16, 0, r, q), pack8(X[0], zero4), R[1], 0, 0, 0);
        X[1] = __builtin_amdgcn_mfma_f32_16x16x32_bf16(frag_kc_pk(lds + DP_TD, DP_TDS, 16, 0, r, q), pack8(a1, zero4), zero4, 0, 0, 0);
        f32x4 a2 = __builtin_amdgcn_mfma_f32_16x16x32_bf16(frag_kc_pk(lds + DP_LB, DP_LS, 32, 0, r, q), pack8(X[0], X[1]), R[2], 0, 0, 0);
        X[2] = __builtin_amdgcn_mfma_f32_16x16x32_bf16(frag_kc_pk(lds + DP_TD, DP_TDS, 32, 0, r, q), pack8(a2, zero4), zero4, 0, 0, 0);
        f32x4 a3 = __builtin_amdgcn_mfma_f32_16x16x32_bf16(frag_kc_pk(lds + DP_LB, DP_LS, 48, 0, r, q), pack8(X[0], X[1]), R[3], 0, 0, 0);
        a3 = __builtin_amdgcn_mfma_f32_16x16x32_bf16(frag_kc_pk(lds + DP_LB, DP_LS, 48, 32, r, q), pack8(X[2], zero4), a3, 0, 0, 0);
        X[3] = __builtin_amdgcn_mfma_f32_16x16x32_bf16(frag_kc_pk(lds + DP_TD, DP_TDS, 48, 0, r, q), pack8(a3, zero4), zero4, 0, 0, 0);
        bf16* dst = (isw ? WT : UT) + colb * 64;
#pragma unroll
        for (int I = 0; I < 4; ++I) { u32x2 w; w.x = pack2(X[I][0], X[I][1]); w.y = pack2(X[I][2], X[I][3]); *(u32x2*)(dst + 16 * I + 4 * q) = w; }
    }
}

constexpr int DS_ST = 0, DS_STS = 272;
constexpr int DS_WT = DS_ST + 64 * 272, DS_WTS = 160;
constexpr int DS_QD = DS_WT + 128 * 160, DS_QDS = 272;
constexpr int DS_AT = DS_QD + 64 * 272, DS_ATS = 144;
constexpr int DS_KD = DS_AT + 64 * 144, DS_KDS = 144;
constexpr int DS_UT = DS_KD + 128 * 144, DS_UTS = 144;
constexpr int DS_END = DS_UT + 64 * 144;

__device__ __forceinline__ void dn_load_item(const unsigned char* ib, int half, u32x4 (&rg)[8]) {
    const int tid = threadIdx.x;
#pragma unroll
    for (int i = 0; i < 2; ++i) rg[i] = *(const u32x4*)(ib + 16384 + (size_t)(tid + NT * i) * 16);
#pragma unroll
    for (int i = 0; i < 2; ++i) rg[2 + i] = *(const u32x4*)(ib + 32768 + (size_t)(tid + NT * i) * 16);
#pragma unroll
    for (int i = 0; i < 2; ++i) rg[4 + i] = *(const u32x4*)(ib + 49152 + (size_t)(tid + NT * i) * 16);
    rg[6] = *(const u32x4*)(ib + 65536 + (size_t)tid * 16);
    rg[7] = *(const u32x4*)(ib + (size_t)half * 8192 + (size_t)tid * 16);
}
__device__ __forceinline__ void dn_store_item_lds(LAS unsigned char* lds, const u32x4 (&rg)[8]) {
    const int tid = threadIdx.x;
#pragma unroll
    for (int i = 0; i < 2; ++i) { const int e = tid + NT * i; *(LAS u32x4*)(lds + DS_WT + (e >> 3) * DS_WTS + (e & 7) * 16) = rg[i]; }
#pragma unroll
    for (int i = 0; i < 2; ++i) { const int e = tid + NT * i; *(LAS u32x4*)(lds + DS_QD + (e >> 4) * DS_QDS + (e & 15) * 16) = rg[2 + i]; }
#pragma unroll
    for (int i = 0; i < 2; ++i) { const int e = tid + NT * i; *(LAS u32x4*)(lds + DS_KD + (e >> 3) * DS_KDS + (e & 7) * 16) = rg[4 + i]; }
    *(LAS u32x4*)(lds + DS_AT + (tid >> 3) * DS_ATS + (tid & 7) * 16) = rg[6];
    *(LAS u32x4*)(lds + DS_UT + (tid >> 3) * DS_UTS + (tid & 7) * 16) = rg[7];
}

__device__ __forceinline__ void dn_scan_stream(const Params& p, LAS unsigned char* lds, bool prompt, int b, int h, int half, bf16* ODN) {
    unsigned char* ws = p.ws;
    const int tid = threadIdx.x, lane = tid & 63, wv = tid >> 6, r = lane & 15, q = lane >> 4;
    const int nchunks = prompt ? 32 : 1, nvalid = prompt ? 64 : DECS, t0 = prompt ? b * SEQ : TP + b * DECS;
    const int item0 = prompt ? ((b * 8 + h) * 32) : (2048 + b * 8 + h);
    const float* GT = (const float*)(ws + WS_DNGT);
    const int et = wv & 3, hf = wv >> 2;
    f32x4 Sacc[4];
#pragma unroll
    for (int i = 0; i < 4; ++i) {
        if (prompt) Sacc[i] = (f32x4){0.f, 0.f, 0.f, 0.f};
        else {
            const float* s0 = p.in[3] + (((size_t)b * 8 + h) * 128 + 16 * (4 * hf + i) + 4 * q) * 128 + 64 * half + 16 * et + r;
            Sacc[i] = (f32x4){s0[0], s0[128], s0[256], s0[384]};
        }
    }
    __syncthreads();
#pragma unroll
    for (int i = 0; i < 4; ++i) {
        u32x2 w; w.x = pack2(Sacc[i][0], Sacc[i][1]); w.y = pack2(Sacc[i][2], Sacc[i][3]);
        *(LAS u32x2*)(lds + DS_ST + (16 * et + r) * DS_STS + (16 * (4 * hf + i) + 4 * q) * 2) = w;
    }
    u32x4 rg[8];
    dn_load_item(ws + WS_DNI + (size_t)item0 * DN_ITEM_BYTES, half, rg);
    for (int c = 0; c < nchunks; ++c) {
        __syncthreads();
        dn_store_item_lds(lds, rg);
        const float gtot = GT[item0 + c];
        if (c + 1 < nchunks) dn_load_item(ws + WS_DNI + (size_t)(item0 + c + 1) * DN_ITEM_BYTES, half, rg);
        __syncthreads();
        f32x4 vn[4];
#pragma unroll
        for (int lt = 0; lt < 4; ++lt) vn[lt] = (f32x4){0.f, 0.f, 0.f, 0.f};
        bf16x8 sB[4];
#pragma unroll
        for (int ks = 0; ks < 4; ++ks) sB[ks] = frag_kc_pk(lds + DS_ST, DS_STS, 16 * et, 32 * ks, r, q);
#pragma unroll
        for (int ks = 0; ks < 4; ++ks)
#pragma unroll
            for (int lt = 0; lt < 4; ++lt) {
                const bf16x8 a = frag_tr(lds + DS_WT, DS_WTS, 32 * ks, 16 * lt, r, q);
                vn[lt] = __builtin_amdgcn_mfma_f32_16x16x32_bf16(a, sB[ks], vn[lt], 0, 0, 0);
            }
#pragma unroll
        for (int lt = 0; lt < 4; ++lt) {
            const u32x2 uu = *(const LAS u32x2*)(lds + DS_UT + (16 * et + r) * DS_UTS + (16 * lt + 4 * q) * 2);
            vn[lt][0] = __uint_as_float(uu.x << 16) - vn[lt][0]; vn[lt][1] = __uint_as_float(uu.x & 0xffff0000u) - vn[lt][1];
            vn[lt][2] = __uint_as_float(uu.y << 16) - vn[lt][2]; vn[lt][3] = __uint_as_float(uu.y & 0xffff0000u) - vn[lt][3];
        }
        const bf16x8 vB0 = pack8(vn[0], vn[1]), vB1 = pack8(vn[2], vn[3]);
#pragma unroll
        for (int li = 0; li < 2; ++li) {
            const int lt = 2 * hf + li;
            f32x4 o = (f32x4){0.f, 0.f, 0.f, 0.f};
#pragma unroll
            for (int ks = 0; ks < 4; ++ks) o = __builtin_amdgcn_mfma_f32_16x16x32_bf16(frag_kc_pk(lds + DS_QD, DS_QDS, 16 * lt, 32 * ks, r, q), sB[ks], o, 0, 0, 0);
            o = __builtin_amdgcn_mfma_f32_16x16x32_bf16(frag_kc_pk(lds + DS_AT, DS_ATS, 16 * lt, 0, r, q), vB0, o, 0, 0, 0);
            o = __builtin_amdgcn_mfma_f32_16x16x32_bf16(frag_kc_pk(lds + DS_AT, DS_ATS, 16 * lt, 32, r, q), vB1, o, 0, 0, 0);
#pragma unroll
            for (int j = 0; j < 4; ++j) {
                const int l = 16 * lt + 4 * q + j;
                if (l < nvalid) ODN[(size_t)(t0 + c * 64 + l) * 1024 + h * 128 + 64 * half + 16 * et + r] = f2bf(o[j]);
            }
        }
        __syncthreads();
#pragma unroll
        for (int i = 0; i < 4; ++i) {
            const int dt = 4 * hf + i;
            f32x4 acc = Sacc[i] * gtot;
            acc = __builtin_amdgcn_mfma_f32_16x16x32_bf16(frag_kc_pk(lds + DS_KD, DS_KDS, 16 * dt, 0, r, q), vB0, acc, 0, 0, 0);
            acc = __builtin_amdgcn_mfma_f32_16x16x32_bf16(frag_kc_pk(lds + DS_KD, DS_KDS, 16 * dt, 32, r, q), vB1, acc, 0, 0, 0);
            Sacc[i] = acc;
            u32x2 w; w.x = pack2(acc[0], acc[1]); w.y = pack2(acc[2], acc[3]);
            *(LAS u32x2*)(lds + DS_ST + (16 * et + r) * DS_STS + (16 * dt + 4 * q) * 2) = w;
        }
    }
    float* so = p.out + (prompt ? O_P_DN : O_S_DN) + (((size_t)b * 8 + h) * 128) * 128;
#pragma unroll
    for (int i = 0; i < 4; ++i)
#pragma unroll
        for (int j = 0; j < 4; ++j) so[(size_t)(16 * (4 * hf + i) + 4 * q + j) * 128 + 64 * half + 16 * et + r] = Sacc[i][j];
}

__device__ __forceinline__ void mix_norm_phase(const Params& p, const bf16* ODN, const bf16* YGB) {
    unsigned char* ws = p.ws;
    const bf16* PROJB = (const bf16*)(ws + WS_PROJB);
    bf16* OCATB = (bf16*)(ws + WS_OCATB);
    const int lane = threadIdx.x & 63, wv = threadIdx.x >> 6;
    const float* dnw = p.in[14]; const float* ssw = p.in[20];
    for (int t = blockIdx.x * 8 + wv; t < T; t += gridDim.x * 8) {
        {
            const u32x4 a = *(const u32x4*)(ODN + (size_t)t * 1024 + 16 * lane), bq = *(const u32x4*)(ODN + (size_t)t * 1024 + 16 * lane + 8);
            const u32x4 za = *(const u32x4*)(PROJB + (size_t)t * PROJW + 4608 + 16 * lane), zb = *(const u32x4*)(PROJB + (size_t)t * PROJW + 4608 + 16 * lane + 8);
            const unsigned w[8] = {a.x, a.y, a.z, a.w, bq.x, bq.y, bq.z, bq.w}, zw[8] = {za.x, za.y, za.z, za.w, zb.x, zb.y, zb.z, zb.w};
            float v[16]; float ss = 0.f;
#pragma unroll
            for (int i = 0; i < 8; ++i) { v[2 * i] = __uint_as_float(w[i] << 16); v[2 * i + 1] = __uint_as_float(w[i] & 0xffff0000u); ss += v[2 * i] * v[2 * i] + v[2 * i + 1] * v[2 * i + 1]; }
            ss += __shfl_xor(ss, 1); ss += __shfl_xor(ss, 2); ss += __shfl_xor(ss, 4);
            const float rstd = rsqrtf(ss * (1.0f / 128.0f) + 1e-6f);
            unsigned o[8];
#pragma unroll
            for (int i = 0; i < 8; ++i) {
                const int cw = (16 * lane + 2 * i) & 127;
                const float z0 = __uint_as_float(zw[i] << 16), z1 = __uint_as_float(zw[i] & 0xffff0000u);
                o[i] = pack2(v[2 * i] * rstd * dnw[cw] * silu_f(z0), v[2 * i + 1] * rstd * dnw[cw + 1] * silu_f(z1));
            }
            *(u32x4*)(OCATB + (size_t)t * 2048 + 16 * lane) = (u32x4){o[0], o[1], o[2], o[3]};
            *(u32x4*)(OCATB + (size_t)t * 2048 + 16 * lane + 8) = (u32x4){o[4], o[5], o[6], o[7]};
        }
        {
            const u32x4 a = *(const u32x4*)(YGB + (size_t)t * 1024 + 16 * lane), bq = *(const u32x4*)(YGB + (size_t)t * 1024 + 16 * lane + 8);
            const unsigned w[8] = {a.x, a.y, a.z, a.w, bq.x, bq.y, bq.z, bq.w};
            float v[16]; float ss = 0.f;
#pragma unroll
            for (int i = 0; i < 8; ++i) { v[2 * i] = __uint_as_float(w[i] << 16); v[2 * i + 1] = __uint_as_float(w[i] & 0xffff0000u); ss += v[2 * i] * v[2 * i] + v[2 * i + 1] * v[2 * i + 1]; }
            ss += __shfl_xor(ss, 1); ss += __shfl_xor(ss, 2); ss += __shfl_xor(ss, 4); ss += __shfl_xor(ss, 8); ss += __shfl_xor(ss, 16);
            const float rstd = rsqrtf(ss * (1.0f / 512.0f) + 1e-6f);
            unsigned o[8];
#pragma unroll
            for (int i = 0; i < 8; ++i) { const int cw = 16 * lane + 2 * i; o[i] = pack2(v[2 * i] * rstd * ssw[cw], v[2 * i + 1] * rstd * ssw[cw + 1]); }
            *(u32x4*)(OCATB + (size_t)t * 2048 + 1024 + 16 * lane) = (u32x4){o[0], o[1], o[2], o[3]};
            *(u32x4*)(OCATB + (size_t)t * 2048 + 1024 + 16 * lane + 8) = (u32x4){o[4], o[5], o[6], o[7]};
        }
    }
    for (int s = blockIdx.x; s < 8 + 128; s += gridDim.x) {
        const bool prompt = s < 8; const int b = prompt ? s : s - 8;
        const int tlast = prompt ? (b * SEQ + SEQ - 3) : (TP + b * DECS + DECS - 3);
        float* dnc = p.out + (prompt ? O_P_DNC : O_S_DNC) + (size_t)b * 3 * DN_QKV;
        float* sc = p.out + (prompt ? O_P_SC : O_S_SC) + (size_t)b * 3 * SSM_XBC;
        for (int i = threadIdx.x; i < 3 * (DN_QKV + SSM_XBC); i += NT) {
            const int rr = i / (DN_QKV + SSM_XBC), cc = i - rr * (DN_QKV + SSM_XBC);
            const float v = bf2f(PROJB[(size_t)(tlast + rr) * PROJW + cc]);
            if (cc < DN_QKV) dnc[rr * DN_QKV + cc] = v; else sc[rr * SSM_XBC + (cc - DN_QKV)] = v;
        }
    }
}

#ifndef MIX_YGF32
#define MIX_YGF32 false
#endif
constexpr size_t WS_YGB = WS_XN;
enum { PH_PROLOGUE = 0, PH_INPROJ = 1, PH_MIX_PREP = 2, PH_MIX_SCAN = 3, PH_MIX_NORM = 4, PH_WOUT = 5, PH_QKV = 6, PH_ATTN = 7, PH_WXO = 8, PH_PQ = 9, PH_PEER = 10, PH_END = 11 };

__global__ void __launch_bounds__(NT, 2) mega(Params p) {
    extern __shared__ __attribute__((aligned(16))) unsigned char lds_raw[];
    LAS unsigned char* lds = (LAS unsigned char*)lds_raw;
    volatile LAS unsigned* misc = (volatile LAS unsigned*)(lds + LDS_MISC);
    if (threadIdx.x < 4) misc[threadIdx.x] = 0u;
    __syncthreads();
    unsigned char* ws = p.ws;
    XcdBarrier bar; bar.bar = (unsigned*)(ws + WS_CTL); bar.x = 0; bar.st = misc;
    if (p.use_bar) bar = xcd_barrier_post((unsigned*)(ws + WS_CTL), misc);
    float* SS1 = (float*)(ws + WS_CTL + CTL_SS1);
    float* SS2 = (float*)(ws + WS_CTL + CTL_SS2);
#define IN(k) (p.ph_lo <= (k) && (k) < p.ph_hi)
#define SEAM(k) do { if (p.use_bar && IN((k) + 1)) xcd_barrier(bar); } while (0)
    if (IN(PH_PROLOGUE)) { p0_prologue(p, lds); SEAM(PH_PROLOGUE); }
    if (IN(PH_INPROJ)) {
        EpiProj E{(bf16*)(ws + WS_PROJB), (float*)(ws + WS_SMALL)};
        run_gemm(lds, (const bf16*)(ws + WS_XN), (const bf16*)(ws + WS_WIN), T, NPAD, 1024, E);
        SEAM(PH_INPROJ);
    }
    bf16* ODN = (bf16*)(p.out + O_Y);
    bf16* YGB = ODN + (size_t)T * 1024;
    if (IN(PH_MIX_PREP)) {
        for (int item = blockIdx.x; item < DN_NITEMS; item += gridDim.x) dn_prep_item(p, lds, item);
        SEAM(PH_MIX_PREP);
    }
    if (IN(PH_MIX_SCAN)) {
        const int G = gridDim.x, hg = G >> 1;
        if ((int)blockIdx.x < hg) {
            for (int it = blockIdx.x; it < 128 + 2048; it += hg) {
                if (it < 128) dn_scan_stream(p, lds, true, it >> 4, (it >> 1) & 7, it & 1, ODN);
                else { const int s = it - 128; dn_scan_stream(p, lds, false, s >> 4, (s >> 1) & 7, s & 1, ODN); }
            }
        } else {
            for (int it = blockIdx.x - hg; it < 128 + 2048; it += G - hg) {
                if (it < 128) ssd_stream<false>(p, lds, true, it >> 4, it & 15, (void*)YGB);
                else ssd_stream<false>(p, lds, false, (it - 128) >> 4, (it - 128) & 15, (void*)YGB);
            }
        }
        SEAM(PH_MIX_SCAN);
    }
    if (IN(PH_MIX_NORM)) { mix_norm_phase(p, ODN, YGB); SEAM(PH_MIX_NORM); }
    if (IN(PH_WOUT)) {
        EpiRes E{p.in[0], p.in[1], (float*)(ws + WS_H), (bf16*)(ws + WS_HB), SS1};
        run_gemm(lds, (const bf16*)(ws + WS_OCATB), (const bf16*)(ws + WS_WOUT), T, 1024, 2048, E);
        SEAM(PH_WOUT);
    }
    if (IN(PH_QKV)) {
        EpiScale E{(bf16*)(ws + WS_QB), 1024, SS1, 0.0625f};
        run_gemm(lds, (const bf16*)(ws + WS_HB), (const bf16*)(ws + WS_WXQ), T, 1024, 1024, E);
        EpiMkv E2{p.out + O_P_MK, p.out + O_P_MV, (bf16*)(ws + WS_MKB), (bf16*)(ws + WS_MVB)};
        run_gemm(lds, (const bf16*)(ws + WS_MEMN), (const bf16*)(ws + WS_WMKV), 2048, 2048, 1024, E2);
        SEAM(PH_QKV);
    }
    if (IN(PH_ATTN)) { attn_phase(p, lds); SEAM(PH_ATTN); }
    if (IN(PH_WXO)) {
        EpiRes E{(const float*)(ws + WS_H), (const float*)(ws + WS_H) + (size_t)TP * 1024, (float*)(ws + WS_H), (bf16*)(ws + WS_HB), SS2};
        run_gemm(lds, (const bf16*)(ws + WS_OB), (const bf16*)(ws + WS_WXO), T, 1024, 1024, E);
        SEAM(PH_WXO);
    }
    if (IN(PH_PQ)) {
        EpiScale E{(bf16*)(ws + WS_PQB), 2048, SS2, 1.0f};
        run_gemm(lds, (const bf16*)(ws + WS_HB), (const bf16*)(ws + WS_WPQ), T, 2048, 1024, E);
        SEAM(PH_PQ);
    }
    if (IN(PH_PEER)) { peer_phase(p, lds); }
#undef IN
#undef SEAM
}

__global__ void __launch_bounds__(256) cvt_bf16_to_f32(const bf16* __restrict__ s, float* __restrict__ d, size_t n) {
    for (size_t i = (size_t)blockIdx.x * 256 + threadIdx.x; i < n; i += (size_t)gridDim.x * 256) d[i] = bf2f(s[i]);
}
__global__ void __launch_bounds__(256) cvt_f32_to_bf16(const float* __restrict__ s, bf16* __restrict__ d, size_t n) {
    for (size_t i = (size_t)blockIdx.x * 256 + threadIdx.x; i < n; i += (size_t)gridDim.x * 256) d[i] = f2bf(s[i]);
}
}

static int g_grid = 0;
static void mega_setup() {
    if (g_grid) return;
    int dev = 0, cus = 0, per_cu = 0;
    hipGetDevice(&dev);
    hipDeviceGetAttribute(&cus, hipDeviceAttributeMultiprocessorCount, dev);
    hipFuncSetAttribute((const void*)fk::mega, hipFuncAttributeMaxDynamicSharedMemorySize, fk::LDS_BYTES);
    hipOccupancyMaxActiveBlocksPerMultiprocessor(&per_cu, (const void*)fk::mega, fk::NT, fk::LDS_BYTES);
    if (per_cu < 1) { fprintf(stderr, "occupancy query says %d blocks/CU\n", per_cu); per_cu = 1; }
    (void)hipGetLastError();
    g_grid = cus;
}
static void mega_launch(hipStream_t s, const fk::Params& base, int lo, int hi, int use_bar) {
    fk::Params p = base; p.ph_lo = lo; p.ph_hi = hi; p.use_bar = use_bar; p.pad = 0;
    hipLaunchKernelGGL(fk::mega, dim3(g_grid), dim3(fk::NT), fk::LDS_BYTES, s, p);
}
static void cvt_b2f(hipStream_t s, const void* src, float* dst, size_t n) { fk::cvt_bf16_to_f32<<<2048, 256, 0, s>>>((const fk::bf16*)src, dst, n); }
static void cvt_f2b(hipStream_t s, const float* src, void* dst, size_t n) { fk::cvt_f32_to_bf16<<<2048, 256, 0, s>>>(src, (fk::bf16*)dst, n); }

extern "C" void kernel_launch(void* const* d_in, const int* in_sizes, int n_in, void* d_out, int out_size, void* d_ws, size_t ws_size, hipStream_t stream) {
    mega_setup();
    fk::Params P{};
    for (int i = 0; i < 33; ++i) P.in[i] = (const float*)d_in[i];
    P.out = (float*)d_out; P.ws = (unsigned char*)d_ws;
    hipMemsetAsync((unsigned char*)d_ws + fk::WS_CTL, 0, fk::CTL_BYTES, stream);
    for (int ph = 0; ph < fk::PH_END; ++ph) mega_launch(stream, P, ph, ph + 1, 0);
}
```

```cpp
#include <hip/hip_runtime.h>
#include <stdint.h>
#include <stdio.h>

constexpr int D = 1024, BATCH = 8, SEQ = 2048, DECB = 128, DECS = 8;
constexpr int TP = BATCH * SEQ, TS = DECB * DECS, T = TP + TS;
constexpr int DN_QKV = 3072, SSM_XBC = 1536, NPROJ = 6688;
constexpr size_t O_Y = 0;
constexpr size_t O_P_DNC = 17825792, O_P_DN = 17899520, O_P_SC = 18948096, O_P_SS = 18984960, O_P_MK = 20033536, O_P_MV = 22130688;
constexpr size_t O_S_DNC = 24227840, O_S_DN = 25407488, O_S_SC = 42184704, O_S_SS = 42774528;

#define XB_TMO      128
#define XB_XCNT(j)  (256  + 64 * (j))
#define XB_XSUB(j)  (1280 + 64 * (j))
#define XB_XGEN(j)  (2304 + 64 * (j))
#define XB_TOP      3328
#define XB_TOPGEN   3392
#define XCD_BAR_WORDS 3456
#define XB_SPIN_CAP (1u << 18)
#define LAS __attribute__((address_space(3)))

__device__ __forceinline__ unsigned xb_ld(unsigned* p)              { return __hip_atomic_load(p, __ATOMIC_RELAXED, __HIP_MEMORY_SCOPE_AGENT); }
__device__ __forceinline__ unsigned xb_add(unsigned* p, unsigned v) { return __hip_atomic_fetch_add(p, v, __ATOMIC_RELAXED, __HIP_MEMORY_SCOPE_AGENT); }
__device__ __forceinline__ unsigned xb_xcc_id() { return (unsigned)__builtin_amdgcn_s_getreg((3 << 11) | 20) & 0xFu; }
#define XB_SPIN(cond, bar) do { unsigned _sp = 0; while (cond) { __builtin_amdgcn_s_sleep(1); \
    if ((++_sp & 255u) == 0u) { if (xb_ld(&(bar)[XB_TMO])) break; if (_sp > XB_SPIN_CAP) { atomicAdd(&(bar)[XB_TMO], 1u); break; } } } } while (0)

struct XcdBarrier {
    unsigned* bar; unsigned x;
    volatile LAS unsigned* st;
};

__device__ __forceinline__ XcdBarrier xcd_barrier_post(unsigned* bar, volatile LAS unsigned* st) {
    XcdBarrier b; b.bar = bar; b.x = xb_xcc_id(); b.st = st;
    if (threadIdx.x == 0) (void)xb_add(&bar[XB_XCNT(b.x)], 1u);
    return b;
}
__device__ __forceinline__ void xcd_barrier_complete(unsigned* bar, unsigned x, unsigned& nloc, unsigned& nx) {
    const unsigned G = gridDim.x * gridDim.y * gridDim.z;
    unsigned sum, cnt, mine, sp = 0u;
    for (;;) {
        sum = 0u; cnt = 0u; mine = 0u;
#pragma unroll
        for (unsigned j = 0; j < 16; ++j) { const unsigned c = xb_ld(&bar[XB_XCNT(j)]); sum += c; cnt += (c > 0u) ? 1u : 0u; mine = (j == x) ? c : mine; }
        if (sum == G) break;
        __builtin_amdgcn_s_sleep(1);
        if ((++sp & 255u) == 0u) { if (xb_ld(&bar[XB_TMO])) break; if (sp > XB_SPIN_CAP) { atomicAdd(&bar[XB_TMO], 1u); break; } }
    }
    nloc = mine > 0u ? mine : 1u; nx = cnt > 0u ? cnt : 1u;
}

__device__ __forceinline__ void xcd_barrier(const XcdBarrier& b) {
    asm volatile("s_waitcnt vmcnt(0)" ::: "memory");
    __syncthreads();
    if (threadIdx.x == 0) {
        unsigned* bar = b.bar;
        __builtin_amdgcn_s_waitcnt(0);
        unsigned nloc = b.st[0], nx = b.st[1];
        if (nloc == 0u) { xcd_barrier_complete(bar, b.x, nloc, nx); b.st[0] = nloc; b.st[1] = nx; }
        const unsigned old = xb_add(&bar[XB_XSUB(b.x)], 1u);
        const unsigned gen = old / nloc;
        if (old + 1u == (gen + 1u) * nloc) {
            __builtin_amdgcn_fence(__ATOMIC_RELEASE, "agent");
            asm volatile("s_waitcnt vmcnt(0)" ::: "memory");
            const unsigned og = xb_add(&bar[XB_TOP], 1u);
            const unsigned tg = og / nx;
            if (og + 1u == (tg + 1u) * nx) xb_add(&bar[XB_TOPGEN], 1u);
            else XB_SPIN(xb_ld(&bar[XB_TOPGEN]) == tg, bar);
            __builtin_amdgcn_fence(__ATOMIC_ACQUIRE, "agent");
            xb_add(&bar[XB_XGEN(b.x)], 1u);
            asm volatile("s_waitcnt vmcnt(0)" ::: "memory");
        } else {
            XB_SPIN(xb_ld(&bar[XB_XGEN(b.x)]) == gen, bar);
            __builtin_amdgcn_fence(__ATOMIC_ACQUIRE, "agent");
            asm volatile("s_waitcnt vmcnt(0)" ::: "memory");
        }
    }
    __syncthreads();
}

namespace pg8 {
#define PG8_LAS __attribute__((address_space(3)))
typedef unsigned short bf16_t;
typedef short bf16x8 __attribute__((ext_vector_type(8)));
typedef float f32x4 __attribute__((ext_vector_type(4)));
typedef unsigned u32x4 __attribute__((ext_vector_type(4)));
constexpr int BM = 256, BK = 64, HALF = 128, HTB = HALF * BK * 2  , STAGE_BYTES = 8 * HTB, NXCD = 8, WGM = 8;

__host__ __device__ __forceinline__ int lds_byte(int r, int c) { const int st = (r >> 4) * 2 + (c >> 5), rr = r & 15, cc = c & 31, ob = rr * 64 + cc * 2; return st * 1024 + (ob ^ (((ob >> 9) & 1) << 5)); }
__host__ __device__ __forceinline__ void stage_rc(int b, int& R, int& C) { const int st = b / 1024, sb = b % 1024, swz = sb ^ (((sb >> 9) & 1) << 5); R = (st >> 1) * 16 + swz / 64; C = (st & 1) * 32 + (swz % 64) / 2; }
__host__ __device__ __forceinline__ int perm32(int rho) { const int n = rho >> 4, i = rho & 15; return 8 * (i >> 2) + 4 * n + (i & 3); }

struct Unit { int pm, pn; };
struct Gemm { const bf16_t* A; const bf16_t* Bt; int M, N, K; };

struct StaticOrder {
    int nM, nN, nwg, G, c;
    __host__ __device__ void init(int M, int N, int G_, int c_) { nM = M / BM; nN = N / BM; nwg = nM * nN; G = G_; c = c_; }
    __host__ __device__ bool next(int i, Unit& u) const {
        const long L = (long)i * G + c; if (L >= nwg) return false;
        int wgid = (int)L; { const int q = nwg / NXCD, r = nwg % NXCD, xcd = wgid % NXCD, off = wgid / NXCD; wgid = (xcd < r ? xcd * (q + 1) : r * (q + 1) + (xcd - r) * q) + off; }
        const int nig = WGM * nN, gid = wgid / nig, fm = gid * WGM, gsz = (nM - fm) < WGM ? (nM - fm) : WGM;
        u.pm = fm + ((wgid % nig) % gsz); u.pn = (wgid % nig) / gsz; return true;
    }
    __device__ __forceinline__ void a_ready(const Unit&) const {}
    __device__ __forceinline__ void done(const Unit&) const {}
};
__device__ __forceinline__ unsigned cvt_pk_bf16(float lo, float hi) { unsigned r; asm volatile("v_cvt_pk_bf16_f32 %0, %1, %2" : "=v"(r) : "v"(lo), "v"(hi)); return r; }
typedef float f32x2 __attribute__((ext_vector_type(2)));
template <class Epi, class Sched, bool STAMP = false>
__device__ __forceinline__ void gemm_phase(PG8_LAS unsigned char* lds, const Gemm g, const Sched& S, const Epi& E, unsigned long long* stamps) {
    const int tid = threadIdx.x, wid = __builtin_amdgcn_readfirstlane(tid >> 6), lane = tid & 63, wr = wid >> 2, wc = wid & 3, fr = lane & 15, fq = lane >> 4;
    const int K = g.K, nt = K / BK;
    int ts_lo = 0, ts_hi = 0, nts = 0; const unsigned long long rt_entry = STAMP ? (unsigned long long)wall_clock64() : 0ull;
#define PG8_STAMP() do { if (STAMP && wid == 0 && nts < 64) { const unsigned long long _c = (unsigned long long)clock64(); \
        ts_lo = (lane == nts) ? (int)(unsigned)_c : ts_lo; ts_hi = (lane == nts) ? (int)(unsigned)(_c >> 32) : ts_hi; ++nts; } } while (0)
    PG8_STAMP();
    unsigned voffA[2], voffB[2];
#pragma unroll
    for (int i = 0; i < 2; ++i) { int R, C; stage_rc(tid * 16 + i * 8192, R, C); const int Rb = Epi::PERM ? ((R & ~31) + perm32(R & 31)) : R;
        voffA[i] = (unsigned)(R * K + C) * 2u; voffB[i] = (unsigned)(Rb * K + C) * 2u; }
    const size_t kstep = (size_t)(BK * 2);
    const size_t hstep = (size_t)HALF * K * 2;
    const size_t tstep = 2 * hstep;
    const unsigned ldsw = (unsigned)wid * 1024u;
    const int aoff = lds_byte(wr * 64 + fr, fq * 8), boff = lds_byte(wc * 32 + fr, fq * 8);
#define PG8_SA(b, h) (((b) * 2 + (h)) * HTB)
#define PG8_SB(b, h) ((4 + (b) * 2 + (h)) * HTB)
#define PG8_STAGE(bufoff, gbase, voff) do { _Pragma("unroll") for (int _i = 0; _i < 2; ++_i) \
        __builtin_amdgcn_global_load_lds((const unsigned*)((const char*)(gbase) + (voff)[_i]), (PG8_LAS unsigned*)(lds + (bufoff) + ldsw + _i * 8192), 16, 0, 0); } while (0)
#define PG8_LDA(dst, b, h) do { _Pragma("unroll") for (int m = 0; m < 4; ++m) _Pragma("unroll") for (int k = 0; k < 2; ++k) dst[m][k] = *(const PG8_LAS bf16x8*)(lds + PG8_SA(b, h) + aoff + m * 2048 + k * 1024); } while (0)
#define PG8_LDB(dst, b, h) do { _Pragma("unroll") for (int n = 0; n < 2; ++n) _Pragma("unroll") for (int k = 0; k < 2; ++k) dst[n][k] = *(const PG8_LAS bf16x8*)(lds + PG8_SB(b, h) + boff + n * 2048 + k * 1024); } while (0)
#define PG8_MMA(ai, bj, At, Bt) do { __builtin_amdgcn_s_setprio(1); _Pragma("unroll") for (int m = 0; m < 4; ++m) _Pragma("unroll") for (int n = 0; n < 2; ++n) _Pragma("unroll") for (int k = 0; k < 2; ++k) \
        acc[ai][bj][m][n] = __builtin_amdgcn_mfma_f32_16x16x32_bf16(Bt[n][k], At[m][k], acc[ai][bj][m][n], 0, 0, 0); __builtin_amdgcn_s_setprio(0); } while (0)
#define PG8_WAIT_V(n) asm volatile("s_waitcnt vmcnt(" #n ")" ::: "memory")
#define PG8_WAIT_L(n) asm volatile("s_waitcnt lgkmcnt(" #n ")" ::: "memory")
#define PG8_BAR __builtin_amdgcn_s_barrier()
#define PG8_SCHED __builtin_amdgcn_sched_barrier(0)
    Unit cur, nxt; int ui = 0;
    if (!S.next(0, cur)) return;
    f32x4 acc[2][2][4][2];
#pragma unroll
    for (int a = 0; a < 2; ++a)
#pragma unroll
        for (int b = 0; b < 2; ++b)
#pragma unroll
            for (int m = 0; m < 4; ++m)
#pragma unroll
                for (int n = 0; n < 2; ++n) acc[a][b][m][n] = (f32x4){0.f, 0.f, 0.f, 0.f};
    bf16x8 At[4][2], B0[2][2], B1[2][2];
    const char* cA = (const char*)g.A + (size_t)cur.pm * tstep; const char* cB = (const char*)g.Bt + (size_t)cur.pn * tstep;
    S.a_ready(cur);
    PG8_STAGE(PG8_SB(0, 0), cB, voffB); PG8_STAGE(PG8_SA(0, 0), cA, voffA); PG8_STAGE(PG8_SB(0, 1), cB + hstep, voffB); PG8_STAGE(PG8_SA(0, 1), cA + hstep, voffA);
    if (wr == 1) PG8_BAR;
    PG8_WAIT_V(4); PG8_BAR;
    PG8_STAGE(PG8_SB(1, 0), cB + kstep, voffB); PG8_STAGE(PG8_SA(1, 0), cA + kstep, voffA); PG8_STAGE(PG8_SB(1, 1), cB + hstep + kstep, voffB);
    PG8_WAIT_V(6); PG8_BAR;
    PG8_STAMP();
    for (;;) {
        const bool has_next = S.next(ui + 1, nxt);
        const char* nA = has_next ? (const char*)g.A + (size_t)nxt.pm * tstep : cA; const char* nB = has_next ? (const char*)g.Bt + (size_t)nxt.pn * tstep : cB;
        for (int t = 0; t < nt; t += 2) {
            const bool last = (t == nt - 2);
            const char* a1 = cA + (size_t)(t + 1) * kstep;
            const char* a2 = last ? nA : cA + (size_t)(t + 2) * kstep; const char* b2 = last ? nB : cB + (size_t)(t + 2) * kstep;
            const char* a3 = a2 + kstep; const char* b3 = b2 + kstep;
            if (last && has_next) S.a_ready(nxt);
            PG8_LDB(B0, 0, 0); PG8_SCHED; PG8_LDA(At, 0, 0); PG8_STAGE(PG8_SA(1, 1), a1 + hstep, voffA);
            PG8_WAIT_L(8); PG8_BAR; PG8_WAIT_L(0); PG8_MMA(0, 0, At, B0); PG8_BAR; PG8_SCHED;
            PG8_LDB(B1, 0, 1); PG8_STAGE(PG8_SB(0, 0), b2, voffB);
            PG8_BAR; PG8_WAIT_L(0); PG8_MMA(0, 1, At, B1); PG8_BAR;
            PG8_LDA(At, 0, 1); PG8_STAGE(PG8_SA(0, 0), a2, voffA);
            PG8_BAR; PG8_WAIT_L(0); PG8_MMA(1, 0, At, B0); PG8_BAR; PG8_SCHED;
            PG8_STAGE(PG8_SB(0, 1), b2 + hstep, voffB);
            PG8_WAIT_V(6); PG8_BAR; PG8_MMA(1, 1, At, B1); PG8_BAR;
            PG8_LDB(B0, 1, 0); PG8_SCHED; PG8_LDA(At, 1, 0); PG8_STAGE(PG8_SA(0, 1), a2 + hstep, voffA);
            PG8_WAIT_L(8); PG8_BAR; PG8_WAIT_L(0); PG8_MMA(0, 0, At, B0); PG8_BAR; PG8_SCHED;
            PG8_LDB(B1, 1, 1); PG8_STAGE(PG8_SB(1, 0), b3, voffB);
            PG8_BAR; PG8_WAIT_L(0); PG8_MMA(0, 1, At, B1); PG8_BAR;
            PG8_LDA(At, 1, 1); PG8_STAGE(PG8_SA(1, 0), a3, voffA);
            PG8_BAR; PG8_WAIT_L(0); PG8_MMA(1, 0, At, B0); PG8_BAR; PG8_SCHED;
            PG8_STAGE(PG8_SB(1, 1), b3 + hstep, voffB);
            PG8_WAIT_V(6); PG8_BAR; PG8_MMA(1, 1, At, B1); PG8_BAR;
        }
        PG8_STAMP();
        if constexpr (!Epi::AFTER_DRAIN) { E(acc, cur, wr, wc, fr, fq); S.done(cur); }
        PG8_STAMP();
        if (!has_next) break;
#pragma unroll
        for (int a = 0; a < 2; ++a)
#pragma unroll
            for (int b = 0; b < 2; ++b)
#pragma unroll
                for (int m = 0; m < 4; ++m)
#pragma unroll
                    for (int n = 0; n < 2; ++n) acc[a][b][m][n] = (f32x4){0.f, 0.f, 0.f, 0.f};
        cur = nxt; cA = nA; cB = nB; ++ui;
    }
    PG8_WAIT_V(0);
    if (wr == 0) PG8_BAR;
    PG8_BAR;
    if constexpr (Epi::AFTER_DRAIN) { E.fused(acc, cur, wr, wc, fr, fq, lds, wid, lane); S.done(cur); }
    PG8_STAMP();
    if (STAMP && wid == 0) { stamps[lane] = lane < nts ? (((unsigned long long)(unsigned)ts_hi << 32) | (unsigned)ts_lo) : 0ull;
        if (lane == 62) stamps[62] = rt_entry; if (lane == 63) stamps[63] = (unsigned long long)wall_clock64(); }
#undef PG8_STAMP
#undef PG8_SA
#undef PG8_SB
#undef PG8_STAGE
#undef PG8_LDA
#undef PG8_LDB
#undef PG8_MMA
#undef PG8_WAIT_V
#undef PG8_WAIT_L
#undef PG8_BAR
#undef PG8_SCHED
}
}

namespace fk {
typedef unsigned short bf16;
typedef float f32x4 __attribute__((ext_vector_type(4)));
typedef unsigned u32x4 __attribute__((ext_vector_type(4)));
typedef unsigned u32x2 __attribute__((ext_vector_type(2)));

__device__ __forceinline__ bf16 f2bf(float f) { unsigned u = __float_as_uint(f); u += 0x7FFFu + ((u >> 16) & 1u); return (bf16)(u >> 16); }
__device__ __forceinline__ float bf2f(bf16 b) { return __uint_as_float(((unsigned)b) << 16); }
__device__ __forceinline__ unsigned pack2(float lo, float hi) { return (unsigned)f2bf(lo) | ((unsigned)f2bf(hi) << 16); }

constexpr int NT = 512;
constexpr int LDS_BYTES = 163840, LDS_MISC = LDS_BYTES - 1024;
constexpr int NPAD = 6912;
constexpr int PROJW = 6656;

constexpr size_t al256(size_t x) { return (x + 255) & ~(size_t)255; }
constexpr size_t WS_CTL = 0, CTL_BYTES = 262144;
constexpr size_t CTL_SS1 = 65536, CTL_SS2 = 163840;
constexpr size_t WS_WIN = WS_CTL + CTL_BYTES;
constexpr size_t WS_WOUT = WS_WIN + (size_t)NPAD * 1024 * 2;
constexpr size_t WS_WXQ = WS_WOUT + (size_t)1024 * 2048 * 2;
constexpr size_t WS_WMKV = WS_WXQ + (size_t)1024 * 1024 * 2;
constexpr size_t WS_WXO = WS_WMKV + (size_t)2048 * 1024 * 2;
constexpr size_t WS_WPQ = WS_WXO + (size_t)1024 * 1024 * 2;
constexpr size_t WS_SUBK = WS_WPQ + (size_t)2048 * 1024 * 2;
constexpr size_t WS_PU = WS_SUBK + (size_t)2 * 128 * 128 * 2;
constexpr size_t WS_PV = WS_PU + (size_t)16384 * 1024 * 2;
constexpr size_t WS_XN = WS_PV + (size_t)16384 * 1024 * 2;
constexpr size_t WS_MEMN = WS_XN + (size_t)T * 1024 * 2;
constexpr size_t WS_MKB = WS_MEMN + (size_t)2048 * 1024 * 2;
constexpr size_t WS_MVB = WS_MKB + (size_t)2048 * 1024 * 2;
constexpr size_t WS_SMALL = WS_MVB + (size_t)2048 * 1024 * 2;
constexpr size_t WS_OCATB = WS_SMALL + (size_t)T * 32 * 4;
constexpr size_t WS_PROJB = WS_OCATB + (size_t)T * 2048 * 2;
constexpr size_t WS_MIX = WS_PROJB + (size_t)T * PROJW * 2;
constexpr size_t WS_H = WS_PROJB;
constexpr size_t WS_HB = WS_H + (size_t)T * 1024 * 4;
constexpr size_t WS_QB = WS_HB + (size_t)T * 1024 * 2;
constexpr size_t WS_OB = WS_QB + (size_t)T * 1024 * 2;
constexpr size_t WS_PQB = WS_OCATB;

struct Params {
    const float* in[33];
    float* out;
    unsigned char* ws;
    int ph_lo, ph_hi;
    int use_bar;
    int pad;
};

__device__ __forceinline__ void transpose_cvt(const float* __restrict__ W, int K, int N, int Npad, const float* __restrict__ gain, bf16* __restrict__ Wt,
                                              float* ft  , int vb, int nvb) {
    const int tid = threadIdx.x;
    const int ntk = K / 64, ntn = Npad / 64, ntiles = ntk * ntn;
    for (int tile = vb; tile < ntiles; tile += nvb) {
        const int k0 = (tile % ntk) * 64, n0 = (tile / ntk) * 64;
        __syncthreads();
#pragma unroll
        for (int i = 0; i < 2; ++i) {
            const int e = tid + i * NT;
            const int kr = e >> 4, c4 = e & 15;
            const int n = n0 + c4 * 4;
            float4 v = make_float4(0.f, 0.f, 0.f, 0.f);
            if (n + 3 < N) v = *(const float4*)(W + (size_t)(k0 + kr) * N + n);
            else { const float* wr = W + (size_t)(k0 + kr) * N; if (n < N) v.x = wr[n]; if (n + 1 < N) v.y = wr[n + 1]; if (n + 2 < N) v.z = wr[n + 2]; }
            const float g = gain ? gain[k0 + kr] : 1.0f;
            float* d = ft + kr * 65 + c4 * 4;
            d[0] = v.x * g; d[1] = v.y * g; d[2] = v.z * g; d[3] = v.w * g;
        }
        __syncthreads();
        const int kc8 = tid & 7, nr = tid >> 3;
        u32x4 w;
        w.x = pack2(ft[(kc8 * 8 + 0) * 65 + nr], ft[(kc8 * 8 + 1) * 65 + nr]);
        w.y = pack2(ft[(kc8 * 8 + 2) * 65 + nr], ft[(kc8 * 8 + 3) * 65 + nr]);
        w.z = pack2(ft[(kc8 * 8 + 4) * 65 + nr], ft[(kc8 * 8 + 5) * 65 + nr]);
        w.w = pack2(ft[(kc8 * 8 + 6) * 65 + nr], ft[(kc8 * 8 + 7) * 65 + nr]);
        *(u32x4*)(Wt + (size_t)(n0 + nr) * K + k0 + kc8 * 8) = w;
    }
}
__device__ __forceinline__ void cvt_stream(const float* __restrict__ src, bf16* __restrict__ dst, size_t n, int vb, int nvb) {
    const size_t n8 = n / 8;
    for (size_t i = (size_t)vb * NT + threadIdx.x; i < n8; i += (size_t)nvb * NT) {
        const float4 a = ((const float4*)src)[2 * i], b = ((const float4*)src)[2 * i + 1];
        u32x4 w; w.x = pack2(a.x, a.y); w.y = pack2(a.z, a.w); w.z = pack2(b.x, b.y); w.w = pack2(b.z, b.w);
        ((u32x4*)dst)[i] = w;
    }
}
__device__ __forceinline__ void norm_rows_bf16(const Params& p, bf16* __restrict__ XN, bf16* __restrict__ MEMN, int vb, int nvb) {
    const int lane = threadIdx.x & 63, wv = threadIdx.x >> 6;
    const int nrows = T + 2048;
    for (int r = vb * 8 + wv; r < nrows; r += nvb * 8) {
        const float* src; bf16* dst;
        if (r < TP) { src = p.in[0] + (size_t)r * 1024; dst = XN + (size_t)r * 1024; }
        else if (r < T) { src = p.in[1] + (size_t)(r - TP) * 1024; dst = XN + (size_t)r * 1024; }
        else { src = p.in[8] + (size_t)(r - T) * 1024; dst = MEMN + (size_t)(r - T) * 1024; }
        float4 v[4]; float ss = 0.f;
#pragma unroll
        for (int i = 0; i < 4; ++i) { v[i] = ((const float4*)src)[lane + 64 * i]; ss += v[i].x * v[i].x + v[i].y * v[i].y + v[i].z * v[i].z + v[i].w * v[i].w; }
#pragma unroll
        for (int o = 32; o > 0; o >>= 1) ss += __shfl_xor(ss, o);
        const float rstd = rsqrtf(ss * (1.0f / 1024.0f) + 1e-6f);
#pragma unroll
        for (int i = 0; i < 4; ++i) { u32x2 w; w.x = pack2(v[i].x * rstd, v[i].y * rstd); w.y = pack2(v[i].z * rstd, v[i].w * rstd); ((u32x2*)dst)[lane + 64 * i] = w; }
    }
}
__device__ __forceinline__ void p0_prologue(const Params& p, LAS unsigned char* lds) {
    float* ft = (float*)(unsigned char*)lds;
    unsigned char* ws = p.ws;
    const int vb = blockIdx.x, nvb = gridDim.x;
    transpose_cvt(p.in[10], 1024, NPROJ, NPAD, p.in[9], (bf16*)(ws + WS_WIN), ft, vb, nvb);
    transpose_cvt(p.in[21], 2048, 1024, 1024, nullptr, (bf16*)(ws + WS_WOUT), ft, vb, nvb);
    transpose_cvt(p.in[24], 1024, 1024, 1024, p.in[22], (bf16*)(ws + WS_WXQ), ft, vb, nvb);
    transpose_cvt(p.in[25], 1024, 2048, 2048, p.in[23], (bf16*)(ws + WS_WMKV), ft, vb, nvb);
    transpose_cvt(p.in[26], 1024, 1024, 1024, nullptr, (bf16*)(ws + WS_WXO), ft, vb, nvb);
    transpose_cvt(p.in[28], 1024, 2048, 2048, p.in[27], (bf16*)(ws + WS_WPQ), ft, vb, nvb);
    cvt_stream(p.in[29], (bf16*)(ws + WS_SUBK), (size_t)2 * 128 * 128, vb, nvb);
    cvt_stream(p.in[30], (bf16*)(ws + WS_PU), (size_t)16384 * 1024, vb, nvb);
    cvt_stream(p.in[31], (bf16*)(ws + WS_PV), (size_t)16384 * 1024, vb, nvb);
    norm_rows_bf16(p, (bf16*)(ws + WS_XN), (bf16*)(ws + WS_MEMN), vb, nvb);
}

using pg8::Unit;
struct EpiProj {
    static constexpr bool PERM = true, AFTER_DRAIN = false;
    bf16* O; float* SM;
    __device__ __forceinline__ void operator()(const f32x4 (&acc)[2][2][4][2], const Unit& u, int wr, int wc, int fr, int fq) const {
        const int row0 = u.pm * 256 + wr * 64 + fr;
        if (u.pn < 26) {
            const int col0 = u.pn * 256 + wc * 32 + 8 * fq;
#pragma unroll
            for (int ai = 0; ai < 2; ++ai)
#pragma unroll
                for (int m = 0; m < 4; ++m) {
                    bf16* rowp = O + (size_t)(row0 + ai * 128 + m * 16) * PROJW + col0;
#pragma unroll
                    for (int bj = 0; bj < 2; ++bj) {
                        const f32x4 v0 = acc[ai][bj][m][0], v1 = acc[ai][bj][m][1];
                        u32x4 w; w.x = pack2(v0[0], v0[1]); w.y = pack2(v0[2], v0[3]); w.z = pack2(v1[0], v1[1]); w.w = pack2(v1[2], v1[3]);
                        *(u32x4*)(rowp + bj * 128) = w;
                    }
                }
        } else if (wc == 0) {
#pragma unroll
            for (int ai = 0; ai < 2; ++ai)
#pragma unroll
                for (int m = 0; m < 4; ++m) {
                    float* rowp = SM + (size_t)(row0 + ai * 128 + m * 16) * 32 + 8 * fq;
                    *(f32x4*)(rowp) = acc[ai][0][m][0];
                    *(f32x4*)(rowp + 4) = acc[ai][0][m][1];
                }
        }
    }
};
struct EpiRes {
    static constexpr bool PERM = false, AFTER_DRAIN = false;
    const float* res_p; const float* res_s;
    float* H; bf16* HB; float* SS;
    __device__ __forceinline__ void operator()(const f32x4 (&acc)[2][2][4][2], const Unit& u, int wr, int wc, int fr, int fq) const {
        const int row0 = u.pm * 256 + wr * 64 + fr, col0 = u.pn * 256 + wc * 32 + 4 * fq;
        const float* rbase = (u.pm < TP / 256) ? res_p : res_s - (size_t)TP * 1024;
#pragma unroll
        for (int ai = 0; ai < 2; ++ai)
#pragma unroll
            for (int m = 0; m < 4; ++m) {
                const int row = row0 + ai * 128 + m * 16;
                float ssq = 0.f;
#pragma unroll
                for (int bj = 0; bj < 2; ++bj)
#pragma unroll
                    for (int n = 0; n < 2; ++n) {
                        const size_t off = (size_t)row * 1024 + col0 + bj * 128 + n * 16;
                        const f32x4 r = *(const f32x4*)(rbase + off);
                        const f32x4 v = acc[ai][bj][m][n] + r;
                        *(f32x4*)(H + off) = v;
                        u32x2 w; w.x = pack2(v[0], v[1]); w.y = pack2(v[2], v[3]);
                        *(u32x2*)(HB + off) = w;
                        ssq += v[0] * v[0] + v[1] * v[1] + v[2] * v[2] + v[3] * v[3];
                    }
                ssq += __shfl_xor(ssq, 16); ssq += __shfl_xor(ssq, 32);
                if (fq == 0) atomicAdd(SS + row, ssq);
            }
    }
};
struct EpiScale {
    static constexpr bool PERM = true, AFTER_DRAIN = false;
    bf16* O; int ldc; const float* SS; float extra;
    __device__ __forceinline__ void operator()(const f32x4 (&acc)[2][2][4][2], const Unit& u, int wr, int wc, int fr, int fq) const {
        const int row0 = u.pm * 256 + wr * 64 + fr, col0 = u.pn * 256 + wc * 32 + 8 * fq;
#pragma unroll
        for (int ai = 0; ai < 2; ++ai)
#pragma unroll
            for (int m = 0; m < 4; ++m) {
                const int row = row0 + ai * 128 + m * 16;
                const float s = rsqrtf(SS[row] * (1.0f / 1024.0f) + 1e-6f) * extra;
                bf16* rowp = O + (size_t)row * ldc + col0;
#pragma unroll
                for (int bj = 0; bj < 2; ++bj) {
                    const f32x4 v0 = acc[ai][bj][m][0] * s, v1 = acc[ai][bj][m][1] * s;
                    u32x4 w; w.x = pack2(v0[0], v0[1]); w.y = pack2(v0[2], v0[3]); w.z = pack2(v1[0], v1[1]); w.w = pack2(v1[2], v1[3]);
                    *(u32x4*)(rowp + bj * 128) = w;
                }
            }
    }
};
struct EpiMkv {
    static constexpr bool PERM = false, AFTER_DRAIN = false;
    float* OK; float* OV; bf16* KB; bf16* VB;
    __device__ __forceinline__ void operator()(const f32x4 (&acc)[2][2][4][2], const Unit& u, int wr, int wc, int fr, int fq) const {
        const int row0 = u.pm * 256 + wr * 64 + fr;
        const bool isv = u.pn >= 4;
        const int col0 = (u.pn & 3) * 256 + wc * 32 + 4 * fq;
        float* Of = isv ? OV : OK; bf16* Ob = isv ? VB : KB;
#pragma unroll
        for (int ai = 0; ai < 2; ++ai)
#pragma unroll
            for (int m = 0; m < 4; ++m) {
                const int row = row0 + ai * 128 + m * 16;
#pragma unroll
                for (int bj = 0; bj < 2; ++bj)
#pragma unroll
                    for (int n = 0; n < 2; ++n) {
                        const size_t off = (size_t)row * 1024 + col0 + bj * 128 + n * 16;
                        const f32x4 v = acc[ai][bj][m][n];
                        *(f32x4*)(Of + off) = v;
                        u32x2 w; w.x = pack2(v[0], v[1]); w.y = pack2(v[2], v[3]);
                        *(u32x2*)(Ob + off) = w;
                    }
            }
    }
};

template <class Epi>
__device__ __forceinline__ void run_gemm(LAS unsigned char* lds, const bf16* A, const bf16* Bt, int M, int N, int K, const Epi& E) {
    pg8::Gemm g{A, Bt, M, N, K};
    pg8::StaticOrder S; S.init(M, N, (int)gridDim.x, (int)blockIdx.x);
    pg8::gemm_phase<Epi, pg8::StaticOrder, false>(lds, g, S, E, nullptr);
}


typedef short bf16x8 __attribute__((ext_vector_type(8)));
typedef short s16x4 __attribute__((ext_vector_type(4)));

__device__ __forceinline__ bf16x8 pack8(const f32x4& a, const f32x4& b) {
    u32x4 w; w.x = pack2(a[0], a[1]); w.y = pack2(a[2], a[3]); w.z = pack2(b[0], b[1]); w.w = pack2(b[2], b[3]);
    return __builtin_bit_cast(bf16x8, w);
}
__device__ __forceinline__ bf16x8 ldsB_tr(const LAS unsigned char* base, int stride, int k0, int n0, int r, int q) {
    const LAS unsigned char* a0 = base + (k0 + 8 * q + (r >> 2)) * stride + (n0 + 4 * (r & 3)) * 2;
    const s16x4 lo = __builtin_amdgcn_ds_read_tr16_b64_v4i16((LAS s16x4*)a0);
    const s16x4 hi = __builtin_amdgcn_ds_read_tr16_b64_v4i16((LAS s16x4*)(a0 + 4 * stride));
    bf16x8 o; o[0] = lo[0]; o[1] = lo[1]; o[2] = lo[2]; o[3] = lo[3]; o[4] = hi[0]; o[5] = hi[1]; o[6] = hi[2]; o[7] = hi[3];
    return o;
}

constexpr int AT_KS = 272, AT_VS = 288, AT_BUF = 256 * 288;

template <bool F32>
__device__ __forceinline__ void at_stage_half(const void* src, int hh, LAS unsigned char* buf, int stride) {
    const int tid = threadIdx.x;
#pragma unroll
    for (int pass = 0; pass < 8; ++pass) {
        const int row = pass * 32 + (tid >> 4), c = tid & 15;
        u32x4 w;
        if (F32) {
            const float* s = (const float*)src + (size_t)row * 1024 + hh * 128 + c * 8;
            const float4 a = *(const float4*)s, b = *(const float4*)(s + 4);
            w.x = pack2(a.x, a.y); w.y = pack2(a.z, a.w); w.z = pack2(b.x, b.y); w.w = pack2(b.z, b.w);
        } else {
            w = *(const u32x4*)((const bf16*)src + (size_t)row * 1024 + hh * 128 + c * 8);
        }
        *(LAS u32x4*)(buf + row * stride + c * 16) = w;
    }
}

__device__ __forceinline__ void attn_phase(const Params& p, LAS unsigned char* lds) {
    unsigned char* ws = p.ws;
    const bf16* QB = (const bf16*)(ws + WS_QB);
    bf16* OB = (bf16*)(ws + WS_OB);
    const int tid = threadIdx.x, lane = tid & 63, wv = tid >> 6, r = lane & 15, q = lane >> 4;
    LAS unsigned char* buf0 = lds;
    LAS unsigned char* buf1 = lds + AT_BUF;
    const int nunits = 256 + 512;
    for (int u = blockIdx.x; u < nunits; u += gridDim.x) {
        int t0, ntok, h; const void* Ksrc; const void* Vsrc; bool f32src;
        if (u < 256) { const int b = u >> 5; h = (u >> 3) & 3; const int tt = u & 7; t0 = b * SEQ + tt * 256; ntok = 256; f32src = false;
            Ksrc = (const bf16*)(ws + WS_MKB) + (size_t)b * 256 * 1024 + h * 256; Vsrc = (const bf16*)(ws + WS_MVB) + (size_t)b * 256 * 1024 + h * 256; }
        else { const int su = u - 256; const int b = su >> 2; h = su & 3; t0 = TP + b * DECS; ntok = DECS; f32src = true;
            Ksrc = p.in[6] + (size_t)b * 256 * 1024 + h * 256; Vsrc = p.in[7] + (size_t)b * 256 * 1024 + h * 256; }
        const int ntiles = (ntok == 256) ? 2 : (wv == 0 ? 1 : 0);
        __syncthreads();
        if (f32src) { at_stage_half<true>(Ksrc, 0, buf0, AT_KS); at_stage_half<true>(Ksrc, 1, buf1, AT_KS); }
        else { at_stage_half<false>(Ksrc, 0, buf0, AT_KS); at_stage_half<false>(Ksrc, 1, buf1, AT_KS); }
        __syncthreads();
        bf16x8 pf[2][8];
#pragma unroll
        for (int tile = 0; tile < 2; ++tile) {
#pragma unroll
            for (int s = 0; s < 8; ++s) pf[tile][s] = (bf16x8){0, 0, 0, 0, 0, 0, 0, 0};
            if (tile < ntiles) {
                const int tl = (ntok == 256 ? wv * 32 : 0) + tile * 16 + r;
                const int tq = t0 + (tl < ntok ? tl : ntok - 1);
                bf16x8 qf[8];
#pragma unroll
                for (int ks = 0; ks < 8; ++ks) qf[ks] = *(const bf16x8*)(QB + (size_t)tq * 1024 + h * 256 + 32 * ks + 8 * q);
                f32x4 acc[16];
#pragma unroll
                for (int mt = 0; mt < 16; ++mt) acc[mt] = (f32x4){0.f, 0.f, 0.f, 0.f};
#pragma unroll
                for (int ks = 0; ks < 8; ++ks) {
                    const LAS unsigned char* kb = (ks < 4 ? buf0 : buf1) + (32 * (ks & 3) + 8 * q) * 2;
#pragma unroll
                    for (int mt = 0; mt < 16; ++mt) {
                        const bf16x8 a = *(const LAS bf16x8*)(kb + (16 * mt + r) * AT_KS);
                        acc[mt] = __builtin_amdgcn_mfma_f32_16x16x32_bf16(a, qf[ks], acc[mt], 0, 0, 0);
                    }
                }
                float mx = -3.0e38f;
#pragma unroll
                for (int mt = 0; mt < 16; ++mt) mx = fmaxf(fmaxf(fmaxf(acc[mt][0], acc[mt][1]), fmaxf(acc[mt][2], acc[mt][3])), mx);
                mx = fmaxf(mx, __shfl_xor(mx, 16)); mx = fmaxf(mx, __shfl_xor(mx, 32));
                float sum = 0.f;
#pragma unroll
                for (int mt = 0; mt < 16; ++mt)
#pragma unroll
                    for (int j = 0; j < 4; ++j) { const float e = __expf(acc[mt][j] - mx); acc[mt][j] = e; sum += e; }
                sum += __shfl_xor(sum, 16); sum += __shfl_xor(sum, 32);
                const float inv = 1.0f / sum;
#pragma unroll
                for (int s = 0; s < 8; ++s) pf[tile][s] = pack8(acc[2 * s] * inv, acc[2 * s + 1] * inv);
            }
        }
        __syncthreads();
        if (f32src) { at_stage_half<true>(Vsrc, 0, buf0, AT_VS); at_stage_half<true>(Vsrc, 1, buf1, AT_VS); }
        else { at_stage_half<false>(Vsrc, 0, buf0, AT_VS); at_stage_half<false>(Vsrc, 1, buf1, AT_VS); }
        __syncthreads();
#pragma unroll
        for (int tile = 0; tile < 2; ++tile) {
            if (tile < ntiles) {
                const int tl0 = (ntok == 256 ? wv * 32 : 0) + tile * 16;
#pragma unroll
                for (int half = 0; half < 2; ++half) {
                    f32x4 o[8];
#pragma unroll
                    for (int dt = 0; dt < 8; ++dt) o[dt] = (f32x4){0.f, 0.f, 0.f, 0.f};
                    const LAS unsigned char* vb = half ? buf1 : buf0;
#pragma unroll
                    for (int s = 0; s < 8; ++s) {
#pragma unroll
                        for (int dt = 0; dt < 8; ++dt) {
                            const LAS unsigned char* a0 = vb + (32 * s + 4 * q + (r >> 2)) * AT_VS + (16 * dt + 4 * (r & 3)) * 2;
                            const s16x4 lo = __builtin_amdgcn_ds_read_tr16_b64_v4i16((LAS s16x4*)a0);
                            const s16x4 hi = __builtin_amdgcn_ds_read_tr16_b64_v4i16((LAS s16x4*)(a0 + 16 * AT_VS));
                            bf16x8 bfr; bfr[0] = lo[0]; bfr[1] = lo[1]; bfr[2] = lo[2]; bfr[3] = lo[3]; bfr[4] = hi[0]; bfr[5] = hi[1]; bfr[6] = hi[2]; bfr[7] = hi[3];
                            o[dt] = __builtin_amdgcn_mfma_f32_16x16x32_bf16(pf[tile][s], bfr, o[dt], 0, 0, 0);
                        }
                    }
#pragma unroll
                    for (int dt = 0; dt < 8; ++dt)
#pragma unroll
                        for (int j = 0; j < 4; ++j) {
                            const int tl = tl0 + 4 * q + j;
                            if (tl < ntok) OB[(size_t)(t0 + tl) * 1024 + h * 256 + half * 128 + 16 * dt + r] = f2bf(o[dt][j]);
                        }
                }
            }
        }
    }
}

constexpr int PE_TOK = 68;
constexpr int PE_KSTR = 272;
constexpr int PE_SUBK = 0;
constexpr int PE_SELI = 0, PE_SELG = PE_TOK * 128 * 4;
constexpr int PE_TOP = 69632;
constexpr int PE_PT = PE_TOP + PE_TOK * 8 * 33 * 4;

template <int CTRL> __device__ __forceinline__ float dppf(float v) { return __int_as_float(__builtin_amdgcn_update_dpp(0, __float_as_int(v), CTRL, 0xF, 0xF, true)); }
__device__ __forceinline__ float wave_sum_u(float v) {
    v += dppf<0xB1>(v); v += dppf<0x4E>(v); v += dppf<0x141>(v); v += dppf<0x140>(v);
    const float a = __int_as_float(__builtin_amdgcn_readlane(__float_as_int(v), 0)), b = __int_as_float(__builtin_amdgcn_readlane(__float_as_int(v), 16));
    const float c = __int_as_float(__builtin_amdgcn_readlane(__float_as_int(v), 32)), d = __int_as_float(__builtin_amdgcn_readlane(__float_as_int(v), 48));
    return (a + b) + (c + d);
}
typedef __bf16 bf16x2v __attribute__((ext_vector_type(2)));
__device__ __forceinline__ float dot2bf(unsigned a, unsigned b, float acc) {
    return __builtin_amdgcn_fdot2_f32_bf16(__builtin_bit_cast(bf16x2v, a), __builtin_bit_cast(bf16x2v, b), acc, false);
}
__device__ __forceinline__ float gelu_erf(float x) { return 0.5f * x * (1.0f + erff(x * 0.70710678118654752f)); }

__device__ __forceinline__ void peer_phase(const Params& p, LAS unsigned char* lds) {
    unsigned char* ws = p.ws;
    const bf16* PQB = (const bf16*)(ws + WS_PQB);
    const bf16* SUBK = (const bf16*)(ws + WS_SUBK);
    const bf16* PU = (const bf16*)(ws + WS_PU);
    const bf16* PVt = (const bf16*)(ws + WS_PV);
    const float* H = (const float*)(ws + WS_H);
    const float* SS2 = (const float*)(ws + WS_CTL + CTL_SS2);
    const float* gffn = p.in[27]; const float* gfin = p.in[32];
    float* Y = p.out + O_Y;
    const int tid = threadIdx.x, lane = tid & 63, wv = tid >> 6, r = lane & 15, q = lane >> 4;
    LAS float* TOP = (LAS float*)(lds + PE_TOP);
    LAS unsigned* SELI = (LAS unsigned*)(lds + PE_SELI);
    LAS float* SELG = (LAS float*)(lds + PE_SELG);
    LAS unsigned char* PT = lds + PE_PT;

    for (int chunk = blockIdx.x; chunk < T / PE_TOK; chunk += gridDim.x) {
        const int tok0 = chunk * PE_TOK;
        __syncthreads();
#pragma unroll
        for (int i = 0; i < 8; ++i) {
            const int e = tid + i * NT, row = e >> 4, c16 = e & 15;
            *(LAS u32x4*)(lds + PE_SUBK + row * PE_KSTR + c16 * 16) = *(const u32x4*)(SUBK + (size_t)row * 128 + c16 * 8);
        }
        if (tid < 64) {
            int i = 0, base = 0, k = tid;
            if (k < 50) { while (k - base >= 16 / (i + 1)) { base += 16 / (i + 1); ++i; } PT[k] = (unsigned char)((i << 4) | (k - base)); }
            else PT[k] = 0;
        }
        __syncthreads();
        {
            const int h = wv;
            for (int nt = 0; nt < 5; ++nt) {
                const int tl = nt * 16 + r;
                const int t = tok0 + (tl < PE_TOK ? tl : PE_TOK - 1);
#pragma unroll
                for (int c = 0; c < 2; ++c) {
                    bf16x8 qf[4];
#pragma unroll
                    for (int ks = 0; ks < 4; ++ks) qf[ks] = *(const bf16x8*)(PQB + (size_t)t * 2048 + h * 256 + c * 128 + 32 * ks + 8 * q);
                    f32x4 acc[8];
#pragma unroll
                    for (int mt = 0; mt < 8; ++mt) acc[mt] = (f32x4){0.f, 0.f, 0.f, 0.f};
#pragma unroll
                    for (int ks = 0; ks < 4; ++ks)
#pragma unroll
                        for (int mt = 0; mt < 8; ++mt) {
                            const bf16x8 a = *(const LAS bf16x8*)(lds + PE_SUBK + (c * 128 + 16 * mt + r) * PE_KSTR + (32 * ks + 8 * q) * 2);
                            acc[mt] = __builtin_amdgcn_mfma_f32_16x16x32_bf16(a, qf[ks], acc[mt], 0, 0, 0);
                        }
                    float v[32];
#pragma unroll
                    for (int mt = 0; mt < 8; ++mt)
#pragma unroll
                        for (int j = 0; j < 4; ++j) v[mt * 4 + j] = __uint_as_float((__float_as_uint(acc[mt][j]) & ~127u) | (unsigned)(16 * mt + 4 * q + j));
                    float top[16];
#pragma unroll
                    for (int rd = 0; rd < 16; ++rd) {
                        float m = v[0];
#pragma unroll
                        for (int i = 1; i < 32; ++i) m = fmaxf(m, v[i]);
                        m = fmaxf(m, __shfl_xor(m, 16)); m = fmaxf(m, __shfl_xor(m, 32));
                        top[rd] = m;
#pragma unroll
                        for (int i = 0; i < 32; ++i) v[i] = (v[i] == m) ? -3.0e38f : v[i];
                    }
                    if (q == 0 && tl < PE_TOK) {
                        LAS float* dst = TOP + (tl * 8 + h) * 33 + c * 16;
#pragma unroll
                        for (int i = 0; i < 16; ++i) dst[i] = top[i];
                    }
                }
            }
        }
        __syncthreads();
        for (int pr = tid; pr < PE_TOK * 8; pr += NT) {
            const LAS float* tp = TOP + pr * 33;
            float A[16], B[16];
#pragma unroll
            for (int i = 0; i < 16; ++i) { A[i] = tp[i]; B[i] = tp[16 + i]; }
            float cd[50];
            {
                int k = 0;
#pragma unroll
                for (int i = 0; i < 16; ++i)
#pragma unroll
                    for (int j = 0; j < 16; ++j)
                        if ((i + 1) * (j + 1) <= 16) { cd[k] = __uint_as_float((__float_as_uint(A[i] + B[j]) & ~63u) | (unsigned)k); ++k; }
            }
            float win[16];
#pragma unroll
            for (int rd = 0; rd < 16; ++rd) {
                float m = cd[0];
#pragma unroll
                for (int i = 1; i < 50; ++i) m = fmaxf(m, cd[i]);
                win[rd] = m;
#pragma unroll
                for (int i = 0; i < 50; ++i) cd[i] = (cd[i] == m) ? -3.0e38f : cd[i];
            }
            float e[16], sum = 0.f;
#pragma unroll
            for (int rd = 0; rd < 16; ++rd) { e[rd] = __expf(win[rd] - win[0]); sum += e[rd]; }
            const float inv = 1.0f / sum;
            const int tl = pr >> 3, h = pr & 7;
#pragma unroll
            for (int rd = 0; rd < 16; ++rd) {
                const unsigned k = __float_as_uint(win[rd]) & 63u;
                const unsigned ij = PT[k];
                const unsigned ka = __float_as_uint(tp[ij >> 4]) & 127u, kb = __float_as_uint(tp[16 + (ij & 15)]) & 127u;
                SELI[tl * 128 + h * 16 + rd] = ka * 128u + kb;
                SELG[tl * 128 + h * 16 + rd] = e[rd] * inv;
            }
        }
        __syncthreads();
        for (int tl = wv; tl < PE_TOK; tl += 8) {
            const size_t t = (size_t)(tok0 + tl);
            const float rstd2 = rsqrtf(SS2[t] * (1.0f / 1024.0f) + 1e-6f);
            float hrow[16]; unsigned xp[8];
#pragma unroll
            for (int i = 0; i < 4; ++i) {
                const float4 hv = *(const float4*)(H + t * 1024 + 16 * lane + 4 * i);
                const float4 gv = *(const float4*)(gffn + 16 * lane + 4 * i);
                hrow[4 * i] = hv.x; hrow[4 * i + 1] = hv.y; hrow[4 * i + 2] = hv.z; hrow[4 * i + 3] = hv.w;
                xp[2 * i] = pack2(hv.x * rstd2 * gv.x, hv.y * rstd2 * gv.y); xp[2 * i + 1] = pack2(hv.z * rstd2 * gv.z, hv.w * rstd2 * gv.w);
            }
            float dsel[2] = {0.f, 0.f};
#pragma unroll
            for (int half = 0; half < 2; ++half) {
                for (int p0 = 0; p0 < 64; p0 += 8) {
                    u32x4 ua[8], ub[8];
#pragma unroll
                    for (int u = 0; u < 8; ++u) {
                        const unsigned e = (unsigned)__builtin_amdgcn_readfirstlane((int)SELI[tl * 128 + half * 64 + p0 + u]);
                        const bf16* row = PU + (size_t)e * 1024 + 16 * lane;
                        ua[u] = *(const u32x4*)row; ub[u] = *(const u32x4*)(row + 8);
                    }
#pragma unroll
                    for (int u = 0; u < 8; ++u) {
                        float d = 0.f;
                        d = dot2bf(ua[u].x, xp[0], d); d = dot2bf(ua[u].y, xp[1], d); d = dot2bf(ua[u].z, xp[2], d); d = dot2bf(ua[u].w, xp[3], d);
                        d = dot2bf(ub[u].x, xp[4], d); d = dot2bf(ub[u].y, xp[5], d); d = dot2bf(ub[u].z, xp[6], d); d = dot2bf(ub[u].w, xp[7], d);
                        const float tot = wave_sum_u(d);
                        dsel[half] = (lane == p0 + u) ? tot : dsel[half];
                    }
                }
            }
            float cf[2];
            cf[0] = SELG[tl * 128 + lane] * gelu_erf(dsel[0]);
            cf[1] = SELG[tl * 128 + 64 + lane] * gelu_erf(dsel[1]);
            float out[16];
#pragma unroll
            for (int i = 0; i < 16; ++i) out[i] = 0.f;
#pragma unroll
            for (int half = 0; half < 2; ++half) {
                for (int p0 = 0; p0 < 64; p0 += 8) {
                    u32x4 va[8], vb[8];
#pragma unroll
                    for (int u = 0; u < 8; ++u) {
                        const unsigned e = (unsigned)__builtin_amdgcn_readfirstlane((int)SELI[tl * 128 + half * 64 + p0 + u]);
                        const bf16* row = PVt + (size_t)e * 1024 + 16 * lane;
                        va[u] = *(const u32x4*)row; vb[u] = *(const u32x4*)(row + 8);
                    }
#pragma unroll
                    for (int u = 0; u < 8; ++u) {
                        const float c = __shfl(cf[half], p0 + u);
                        const unsigned w[8] = {va[u].x, va[u].y, va[u].z, va[u].w, vb[u].x, vb[u].y, vb[u].z, vb[u].w};
#pragma unroll
                        for (int i = 0; i < 8; ++i) {
                            out[2 * i] += c * __uint_as_float(w[i] << 16);
                            out[2 * i + 1] += c * __uint_as_float(w[i] & 0xffff0000u);
                        }
                    }
                }
            }
            float ss = 0.f;
#pragma unroll
            for (int i = 0; i < 16; ++i) { out[i] += hrow[i]; ss += out[i] * out[i]; }
            ss = wave_sum_u(ss);
            const float rs = rsqrtf(ss * (1.0f / 1024.0f) + 1e-6f);
#pragma unroll
            for (int i = 0; i < 4; ++i) {
                const float4 gv = *(const float4*)(gfin + 16 * lane + 4 * i);
                float4 o; o.x = out[4 * i] * rs * gv.x; o.y = out[4 * i + 1] * rs * gv.y; o.z = out[4 * i + 2] * rs * gv.z; o.w = out[4 * i + 3] * rs * gv.w;
                *(float4*)(Y + t * 1024 + 16 * lane + 4 * i) = o;
            }
        }
    }
}


__device__ __forceinline__ bf16x8 frag_tr(const LAS unsigned char* base, int stride, int k0, int n0, int r, int q) {
    const LAS unsigned char* a0 = base + (k0 + 4 * q + (r >> 2)) * stride + (n0 + 4 * (r & 3)) * 2;
    const s16x4 lo = __builtin_amdgcn_ds_read_tr16_b64_v4i16((LAS s16x4*)a0);
    const s16x4 hi = __builtin_amdgcn_ds_read_tr16_b64_v4i16((LAS s16x4*)(a0 + 16 * stride));
    bf16x8 o; o[0] = lo[0]; o[1] = lo[1]; o[2] = lo[2]; o[3] = lo[3]; o[4] = hi[0]; o[5] = hi[1]; o[6] = hi[2]; o[7] = hi[3];
    return o;
}
__device__ __forceinline__ bf16x8 frag_kc_pk(const LAS unsigned char* base, int stride, int m0, int k0, int r, int q) {
    const LAS unsigned char* a0 = base + (m0 + r) * stride + (k0 + 4 * q) * 2;
    const u32x2 lo = *(const LAS u32x2*)a0, hi = *(const LAS u32x2*)(a0 + 32);
    u32x4 w; w.x = lo.x; w.y = lo.y; w.z = hi.x; w.w = hi.y;
    return __builtin_bit_cast(bf16x8, w);
}
__device__ __forceinline__ bf16x8 frag_kc(const LAS unsigned char* base, int stride, int m0, int k0, int r, int q) {
    return *(const LAS bf16x8*)(base + (m0 + r) * stride + (k0 + 8 * q) * 2);
}
__device__ __forceinline__ float softplus_f(float x) { return x > 20.f ? x : log1pf(__expf(x)); }
__device__ __forceinline__ float silu_f(float x) { return x / (1.0f + __expf(-x)); }

constexpr int SD_RAW = 0, SD_RAWS = 656;
constexpr int SD_XN = 44032, SD_XS = 160;
constexpr int SD_XW = SD_XN + 64 * 160;
constexpr int SD_BN = SD_XW + 64 * 160, SD_BS = 288;
constexpr int SD_CN = SD_BN + 64 * 288, SD_CS = 272;
constexpr int SD_ST = SD_CN + 64 * 272, SD_SS = 160;
constexpr int SD_SC = SD_ST + 128 * 160;
constexpr int SD_END = SD_SC + 1024;

__device__ __forceinline__ void ssd_load_raw(const Params& p, u32x4 (&raw)[6], int c, bool prompt, int b, int head, int g, int t0, int nvalid) {
    const bf16* PROJB = (const bf16*)(p.ws + WS_PROJB);
    const int tid = threadIdx.x;
#pragma unroll
    for (int i = 0; i < 6; ++i) {
        const int e = tid + NT * i, row = e / 40, pc = e - row * 40, l = row - 3;
        u32x4 v = (u32x4){0u, 0u, 0u, 0u};
        if (row < 67) {
            const int col = pc < 8 ? head * 64 + pc * 8 : (pc < 24 ? 1024 + g * 128 + (pc - 8) * 8 : 1280 + g * 128 + (pc - 24) * 8);
            const int ls = c * 64 + l;
            if (ls >= 0) { if (l < nvalid) v = *(const u32x4*)(PROJB + (size_t)(t0 + ls) * PROJW + 3072 + col); }
            else if (!prompt) {
                const float* s = p.in[4] + ((size_t)b * 3 + (3 + ls)) * SSM_XBC + col;
                const float4 a = *(const float4*)s, bb = *(const float4*)(s + 4);
                v.x = pack2(a.x, a.y); v.y = pack2(a.z, a.w); v.z = pack2(bb.x, bb.y); v.w = pack2(bb.z, bb.w);
            }
        }
        raw[i] = v;
    }
}

template <bool YGF32>
__device__ __forceinline__ void ssd_stream(const Params& p, LAS unsigned char* lds, bool prompt, int b, int head, void* YG) {
    unsigned char* ws = p.ws;
    const bf16* PROJB = (const bf16*)(ws + WS_PROJB);
    const float* SMALL = (const float*)(ws + WS_SMALL);
    const float* conv_w = p.in[15]; const float* conv_b = p.in[16];
    const int tid = threadIdx.x, lane = tid & 63, wv = tid >> 6, r = lane & 15, q = lane >> 4;
    const int g = head >> 3;
    const int nchunks = prompt ? 32 : 1, nvalid = prompt ? 64 : DECS, t0 = prompt ? b * SEQ : TP + b * DECS;
    const float Ah = -__expf(p.in[17][head]), dtb = p.in[18][head], Dh = p.in[19][head];
    LAS float* SC = (LAS float*)(lds + SD_SC);

    const int pt_s = wv & 3, nh = wv >> 2;
    f32x4 Sacc[4];
#pragma unroll
    for (int i = 0; i < 4; ++i) {
        if (prompt) Sacc[i] = (f32x4){0.f, 0.f, 0.f, 0.f};
        else {
            const float* s0 = p.in[5] + (((size_t)b * 16 + head) * 64 + 16 * pt_s + 4 * q) * 128 + 16 * (4 * nh + i) + r;
            Sacc[i] = (f32x4){s0[0], s0[128], s0[256], s0[384]};
        }
    }
    __syncthreads();
#pragma unroll
    for (int i = 0; i < 4; ++i) {
        u32x2 w; w.x = pack2(Sacc[i][0], Sacc[i][1]); w.y = pack2(Sacc[i][2], Sacc[i][3]);
        *(LAS u32x2*)(lds + SD_ST + (16 * (4 * nh + i) + r) * SD_SS + (16 * pt_s + 4 * q) * 2) = w;
    }

    u32x4 raw[6];
    ssd_load_raw(p, raw, 0, prompt, b, head, g, t0, nvalid);
    for (int c = 0; c < nchunks; ++c) {
        __syncthreads();
#pragma unroll
        for (int i = 0; i < 6; ++i) { const int e = tid + NT * i, row = e / 40, pc = e - row * 40; if (row < 67) *(LAS u32x4*)(lds + SD_RAW + row * SD_RAWS + pc * 16) = raw[i]; }
        if (c + 1 < nchunks) ssd_load_raw(p, raw, c + 1, prompt, b, head, g, t0, nvalid);
        if (wv == 0) {
            const int l = lane; const bool valid = l < nvalid;
            const size_t t = (size_t)(t0 + c * 64 + (valid ? l : 0));
            const float dt = valid ? softplus_f(SMALL[t * 32 + 16 + head] + dtb) : 0.f;
            float acs = dt * Ah;
#pragma unroll
            for (int o = 1; o < 64; o <<= 1) { const float up = __shfl_up(acs, o); if (lane >= o) acs += up; }
            const float last = __shfl(acs, 63);
            SC[l] = dt; SC[64 + l] = acs; SC[128 + l] = dt * __expf(last - acs); SC[192 + l] = __expf(acs);
        }
        __syncthreads();
#pragma unroll 1
        for (int i = 0; i < 5; ++i) {
            const int e = tid + NT * i, l = e / 40, pc = e - l * 40;
            const int col = pc < 8 ? head * 64 + pc * 8 : (pc < 24 ? 1024 + g * 128 + (pc - 8) * 8 : 1280 + g * 128 + (pc - 24) * 8);
            float acc[8];
            { const float4 b0 = *(const float4*)(conv_b + col), b1 = *(const float4*)(conv_b + col + 4);
              acc[0] = b0.x; acc[1] = b0.y; acc[2] = b0.z; acc[3] = b0.w; acc[4] = b1.x; acc[5] = b1.y; acc[6] = b1.z; acc[7] = b1.w; }
#pragma unroll
            for (int tp = 0; tp < 4; ++tp) {
                const u32x4 rv = *(const LAS u32x4*)(lds + SD_RAW + (l + tp) * SD_RAWS + pc * 16);
                const float4 w0 = *(const float4*)(conv_w + tp * SSM_XBC + col), w1 = *(const float4*)(conv_w + tp * SSM_XBC + col + 4);
                acc[0] += w0.x * __uint_as_float(rv.x << 16); acc[1] += w0.y * __uint_as_float(rv.x & 0xffff0000u);
                acc[2] += w0.z * __uint_as_float(rv.y << 16); acc[3] += w0.w * __uint_as_float(rv.y & 0xffff0000u);
                acc[4] += w1.x * __uint_as_float(rv.z << 16); acc[5] += w1.y * __uint_as_float(rv.z & 0xffff0000u);
                acc[6] += w1.z * __uint_as_float(rv.w << 16); acc[7] += w1.w * __uint_as_float(rv.w & 0xffff0000u);
            }
            const bool valid = l < nvalid;
#pragma unroll
            for (int k = 0; k < 8; ++k) acc[k] = valid ? silu_f(acc[k]) : 0.f;
            u32x4 o; o.x = pack2(acc[0], acc[1]); o.y = pack2(acc[2], acc[3]); o.z = pack2(acc[4], acc[5]); o.w = pack2(acc[6], acc[7]);
            if (pc < 8) {
                *(LAS u32x4*)(lds + SD_XN + l * SD_XS + pc * 16) = o;
                const float wl = SC[128 + l];
                u32x4 o2; o2.x = pack2(acc[0] * wl, acc[1] * wl); o2.y = pack2(acc[2] * wl, acc[3] * wl); o2.z = pack2(acc[4] * wl, acc[5] * wl); o2.w = pack2(acc[6] * wl, acc[7] * wl);
                *(LAS u32x4*)(lds + SD_XW + l * SD_XS + pc * 16) = o2;
            } else if (pc < 24) *(LAS u32x4*)(lds + SD_BN + l * SD_BS + (pc - 8) * 16) = o;
            else *(LAS u32x4*)(lds + SD_CN + l * SD_CS + (pc - 24) * 16) = o;
        }
        __syncthreads();
        {
            const int lt = wv & 3, ph = wv >> 2;
            f32x4 Y[2] = {(f32x4){0.f, 0.f, 0.f, 0.f}, (f32x4){0.f, 0.f, 0.f, 0.f}};
#pragma unroll
            for (int ks = 0; ks < 4; ++ks) {
                const bf16x8 a = frag_kc_pk(lds + SD_CN, SD_CS, 16 * lt, 32 * ks, r, q);
#pragma unroll
                for (int pi = 0; pi < 2; ++pi) {
                    const bf16x8 bb = frag_tr(lds + SD_ST, SD_SS, 32 * ks, 16 * (2 * ph + pi), r, q);
                    Y[pi] = __builtin_amdgcn_mfma_f32_16x16x32_bf16(a, bb, Y[pi], 0, 0, 0);
                }
            }
#pragma unroll
            for (int j = 0; j < 4; ++j) { const float ea = SC[192 + 16 * lt + 4 * q + j]; Y[0][j] *= ea; Y[1][j] *= ea; }
            f32x4 G[4];
            const float acs_l = SC[64 + 16 * lt + r];
#pragma unroll
            for (int mt = 0; mt < 4; ++mt) {
                G[mt] = (f32x4){0.f, 0.f, 0.f, 0.f};
                if (mt <= lt) {
#pragma unroll
                    for (int ks = 0; ks < 4; ++ks) {
                        const bf16x8 a = frag_kc(lds + SD_BN, SD_BS, 16 * mt, 32 * ks, r, q);
                        const bf16x8 bb = frag_kc(lds + SD_CN, SD_CS, 16 * lt, 32 * ks, r, q);
                        G[mt] = __builtin_amdgcn_mfma_f32_16x16x32_bf16(a, bb, G[mt], 0, 0, 0);
                    }
#pragma unroll
                    for (int j = 0; j < 4; ++j) {
                        const int lp = 16 * mt + 4 * q + j, l = 16 * lt + r;
                        G[mt][j] = (lp <= l) ? G[mt][j] * __expf(acs_l - SC[64 + lp]) * SC[lp] : 0.f;
                    }
                }
            }
#pragma unroll
            for (int s = 0; s < 2; ++s) {
                if (2 * s <= lt) {
                    const bf16x8 a = pack8(G[2 * s], G[2 * s + 1]);
#pragma unroll
                    for (int pi = 0; pi < 2; ++pi) {
                        const bf16x8 bb = frag_tr(lds + SD_XN, SD_XS, 32 * s, 16 * (2 * ph + pi), r, q);
                        Y[pi] = __builtin_amdgcn_mfma_f32_16x16x32_bf16(a, bb, Y[pi], 0, 0, 0);
                    }
                }
            }
#pragma unroll
            for (int pi = 0; pi < 2; ++pi)
#pragma unroll
                for (int j = 0; j < 4; ++j) {
                    const int l = 16 * lt + 4 * q + j, pp = 16 * (2 * ph + pi) + r;
                    if (l < nvalid) {
                        const size_t t = (size_t)(t0 + c * 64 + l);
                        const float x = bf2f(*(const LAS bf16*)(lds + SD_XN + l * SD_XS + pp * 2));
                        const float z = bf2f(PROJB[t * PROJW + 5632 + head * 64 + pp]);
                        const float yv = (Y[pi][j] + Dh * x) * silu_f(z);
                        if (YGF32) ((float*)YG)[t * 1024 + head * 64 + pp] = yv; else ((bf16*)YG)[t * 1024 + head * 64 + pp] = f2bf(yv);
                    }
                }
        }
        __syncthreads();
        {
            const float dec = SC[192 + 63];
#pragma unroll
            for (int i = 0; i < 4; ++i) {
                f32x4 acc = Sacc[i] * dec;
#pragma unroll
                for (int s = 0; s < 2; ++s) {
                    const bf16x8 a = frag_tr(lds + SD_XW, SD_XS, 32 * s, 16 * pt_s, r, q);
                    const bf16x8 bb = frag_tr(lds + SD_BN, SD_BS, 32 * s, 16 * (4 * nh + i), r, q);
                    acc = __builtin_amdgcn_mfma_f32_16x16x32_bf16(a, bb, acc, 0, 0, 0);
                }
                Sacc[i] = acc;
                u32x2 w; w.x = pack2(acc[0], acc[1]); w.y = pack2(acc[2], acc[3]);
                *(LAS u32x2*)(lds + SD_ST + (16 * (4 * nh + i) + r) * SD_SS + (16 * pt_s + 4 * q) * 2) = w;
            }
        }
    }
    float* so = p.out + (prompt ? O_P_SS : O_S_SS) + (((size_t)b * 16 + head) * 64) * 128;
#pragma unroll
    for (int i = 0; i < 4; ++i)
#pragma unroll
        for (int j = 0; j < 4; ++j) so[(size_t)(16 * pt_s + 4 * q + j) * 128 + 16 * (4 * nh + i) + r] = Sacc[i][j];
}

constexpr size_t DN_ITEM_BYTES = 73728;
constexpr int DN_NITEMS = 2048 + 1024;
constexpr size_t WS_DNI = WS_MIX;
constexpr size_t WS_DNGT = WS_DNI + (size_t)DN_NITEMS * DN_ITEM_BYTES;

constexpr int DP_RAW = 0, DP_RAWS = 784;
constexpr int DP_QN = 52736, DP_TS = 272;
constexpr int DP_KN = DP_QN + 64 * 272;
constexpr int DP_KB = DP_KN + 64 * 272;
constexpr int DP_VN = DP_KB + 64 * 272;
constexpr int DP_LB = DP_VN + 64 * 272, DP_LS = 144;
constexpr int DP_LF = DP_LB + 64 * 144;
constexpr int DP_TD = DP_LF + 4 * 16 * 17 * 4, DP_TDS = 80;
constexpr int DP_SC = DP_TD + 64 * 80;
constexpr int DP_END = DP_SC + 1024;

__device__ __forceinline__ float sigmoid_f(float x) { return 1.0f / (1.0f + __expf(-x)); }

__device__ __forceinline__ void dn_prep_item(const Params& p, LAS unsigned char* lds, int item) {
    unsigned char* ws = p.ws;
    const bf16* PROJB = (const bf16*)(ws + WS_PROJB);
    const float* SMALL = (const float*)(ws + WS_SMALL);
    const float* conv_w = p.in[11];
    const int tid = threadIdx.x, lane = tid & 63, wv = tid >> 6, r = lane & 15, q = lane >> 4;
    const bool prompt = item < 2048;
    int b, h, c;
    if (prompt) { b = item >> 8; h = (item >> 5) & 7; c = item & 31; } else { b = (item - 2048) >> 3; h = (item - 2048) & 7; c = 0; }
    const int nvalid = prompt ? 64 : DECS, t0 = prompt ? b * SEQ : TP + b * DECS;
    unsigned char* ib = ws + WS_DNI + (size_t)item * DN_ITEM_BYTES;
    bf16* UT = (bf16*)ib; bf16* WT = (bf16*)(ib + 16384); bf16* QD = (bf16*)(ib + 32768); bf16* KDT = (bf16*)(ib + 49152); bf16* ATT = (bf16*)(ib + 65536);
    LAS float* SC = (LAS float*)(lds + DP_SC);
    LAS float* LF = (LAS float*)(lds + DP_LF);
    const float Ah = -__expf(p.in[12][h]), dtb = p.in[13][h];

    __syncthreads();
#pragma unroll 1
    for (int i = 0; i < 7; ++i) {
        const int e = tid + NT * i, row = e / 48, pc = e - row * 48, l = row - 3;
        if (row < 67) {
            u32x4 v = (u32x4){0u, 0u, 0u, 0u};
            const int col = (pc >> 4) * 1024 + h * 128 + (pc & 15) * 8;
            const int ls = c * 64 + l;
            if (ls >= 0) { if (l < nvalid) v = *(const u32x4*)(PROJB + (size_t)(t0 + ls) * PROJW + col); }
            else if (!prompt) {
                const float* s = p.in[2] + ((size_t)b * 3 + (3 + ls)) * DN_QKV + col;
                const float4 a = *(const float4*)s, bb = *(const float4*)(s + 4);
                v.x = pack2(a.x, a.y); v.y = pack2(a.z, a.w); v.z = pack2(bb.x, bb.y); v.w = pack2(bb.z, bb.w);
            }
            *(LAS u32x4*)(lds + DP_RAW + row * DP_RAWS + pc * 16) = v;
        }
    }
    for (int i = tid; i < (64 * 144 + 4 * 16 * 17 * 4 + 64 * 80) / 4; i += NT) ((LAS unsigned*)(lds + DP_LB))[i] = 0u;
    if (wv == 0) {
        const int l = lane; const bool valid = l < nvalid;
        const size_t t = (size_t)(t0 + c * 64 + (valid ? l : 0));
        const float beta = valid ? sigmoid_f(SMALL[t * 32 + h]) : 0.f;
        float gc = valid ? Ah * softplus_f(SMALL[t * 32 + 8 + h] + dtb) : 0.f;
#pragma unroll
        for (int o = 1; o < 64; o <<= 1) { const float up = __shfl_up(gc, o); if (lane >= o) gc += up; }
        const float last = __shfl(gc, 63);
        SC[l] = beta; SC[64 + l] = gc; SC[128 + l] = __expf(gc); SC[192 + l] = __expf(last - gc);
        if (lane == 0) ((float*)(ws + WS_DNGT))[item] = __expf(last);
    }
    __syncthreads();
    {
        const int l = tid >> 3, ch = tid & 7;
        const bool valid = l < nvalid;
        const float beta = SC[l], egc = SC[128 + l];
#pragma unroll 1
        for (int part = 2; part >= 0; --part) {
            float acc[16];
#pragma unroll
            for (int k = 0; k < 16; ++k) acc[k] = 0.f;
            const int col = part * 1024 + h * 128 + ch * 16;
#pragma unroll
            for (int tp = 0; tp < 4; ++tp) {
                const LAS unsigned char* rp = lds + DP_RAW + (l + tp) * DP_RAWS + (part * 16 + ch * 2) * 16;
                const u32x4 r0 = *(const LAS u32x4*)rp, r1 = *(const LAS u32x4*)(rp + 16);
                const float* wp = conv_w + tp * DN_QKV + col;
                const float4 w0 = *(const float4*)wp, w1 = *(const float4*)(wp + 4), w2 = *(const float4*)(wp + 8), w3 = *(const float4*)(wp + 12);
                acc[0] += w0.x * __uint_as_float(r0.x << 16); acc[1] += w0.y * __uint_as_float(r0.x & 0xffff0000u);
                acc[2] += w0.z * __uint_as_float(r0.y << 16); acc[3] += w0.w * __uint_as_float(r0.y & 0xffff0000u);
                acc[4] += w1.x * __uint_as_float(r0.z << 16); acc[5] += w1.y * __uint_as_float(r0.z & 0xffff0000u);
                acc[6] += w1.z * __uint_as_float(r0.w << 16); acc[7] += w1.w * __uint_as_float(r0.w & 0xffff0000u);
                acc[8] += w2.x * __uint_as_float(r1.x << 16); acc[9] += w2.y * __uint_as_float(r1.x & 0xffff0000u);
                acc[10] += w2.z * __uint_as_float(r1.y << 16); acc[11] += w2.w * __uint_as_float(r1.y & 0xffff0000u);
                acc[12] += w3.x * __uint_as_float(r1.z << 16); acc[13] += w3.y * __uint_as_float(r1.z & 0xffff0000u);
                acc[14] += w3.z * __uint_as_float(r1.w << 16); acc[15] += w3.w * __uint_as_float(r1.w & 0xffff0000u);
            }
            float ss = 0.f;
#pragma unroll
            for (int k = 0; k < 16; ++k) { acc[k] = valid ? silu_f(acc[k]) : 0.f; ss += acc[k] * acc[k]; }
            ss += __shfl_xor(ss, 1); ss += __shfl_xor(ss, 2); ss += __shfl_xor(ss, 4);
            const float sc = part == 2 ? 1.0f : (part == 1 ? rsqrtf(ss + 1e-6f) : rsqrtf(ss + 1e-6f) * 0.08838834764831845f);
            const float sc2 = part == 1 ? beta : egc;
            const int off = l * DP_TS + ch * 32;
#pragma unroll
            for (int hh = 0; hh < 2; ++hh) {
                unsigned w1[4], w2[4];
#pragma unroll
                for (int k = 0; k < 4; ++k) {
                    const float a0 = acc[hh * 8 + 2 * k] * sc, a1 = acc[hh * 8 + 2 * k + 1] * sc;
                    w1[k] = pack2(a0, a1); w2[k] = pack2(a0 * sc2, a1 * sc2);
                }
                const u32x4 o1 = (u32x4){w1[0], w1[1], w1[2], w1[3]}, o2 = (u32x4){w2[0], w2[1], w2[2], w2[3]};
                if (part == 2) *(LAS u32x4*)(lds + DP_VN + off + hh * 16) = o1;
                else if (part == 1) { *(LAS u32x4*)(lds + DP_KN + off + hh * 16) = o1; *(LAS u32x4*)(lds + DP_KB + off + hh * 16) = o2; }
                else { *(LAS u32x4*)(lds + DP_QN + off + hh * 16) = o1; *(u32x4*)(QD + l * 128 + ch * 16 + hh * 8) = o2; }
            }
        }
    }
    __syncthreads();
    for (int tile = wv; tile < 20; tile += 8) {
        const int id = tile % 10, isqk = tile / 10;
        int it = 0, jt = id; while (jt > it) { jt -= it + 1; ++it; }
        f32x4 acc = (f32x4){0.f, 0.f, 0.f, 0.f};
#pragma unroll
        for (int ks = 0; ks < 4; ++ks) {
            const bf16x8 a = frag_kc(lds + (isqk ? DP_QN : DP_KB), DP_TS, 16 * it, 32 * ks, r, q);
            const bf16x8 bb = frag_kc(lds + DP_KN, DP_TS, 16 * jt, 32 * ks, r, q);
            acc = __builtin_amdgcn_mfma_f32_16x16x32_bf16(a, bb, acc, 0, 0, 0);
        }
        const int j = 16 * jt + r;
        const float gcj = SC[64 + j];
#pragma unroll
        for (int jj = 0; jj < 4; ++jj) {
            const int i = 16 * it + 4 * q + jj;
            const float dec = __expf(SC[64 + i] - gcj);
            if (isqk) { ATT[i * 64 + j] = f2bf(j <= i ? acc[jj] * dec : 0.f); }
            else {
                const float lv = (j < i) ? acc[jj] * dec : 0.f;
                *(LAS bf16*)(lds + DP_LB + i * DP_LS + j * 2) = f2bf(-lv);
                if (it == jt) LF[(it * 16 + (4 * q + jj)) * 17 + r] = lv;
            }
        }
    }
    if (wv >= 4) {
        for (int e = tid - 256; e < 6 * 256; e += 256) {
            const int tix = e >> 8, w = e & 255; const int it = tix < 3 ? 0 : (tix < 5 ? 1 : 2), jt = tix < 3 ? tix + 1 : (tix < 5 ? tix - 1 : 3);
            ATT[(16 * it + (w >> 4)) * 64 + 16 * jt + (w & 15)] = 0;
        }
    }
    __syncthreads();
    if (wv == 0) {
        const int blk = lane >> 4, col = lane & 15;
        const LAS float* Lb = LF + blk * 16 * 17;
        float x[16];
#pragma unroll
        for (int k = 0; k < 16; ++k) {
            float s = (k == col) ? 1.f : 0.f;
#pragma unroll
            for (int m = 0; m < k; ++m) s -= Lb[k * 17 + m] * x[m];
            x[k] = s;
        }
#pragma unroll
        for (int k = 0; k < 16; ++k) *(LAS bf16*)(lds + DP_TD + (16 * blk + k) * DP_TDS + col * 2) = f2bf(x[k]);
    }
    {
        const int d = tid >> 2, lq = tid & 3;
        unsigned w[8];
#pragma unroll
        for (int k = 0; k < 8; ++k) {
            const int l0 = 16 * lq + 2 * k;
            const float a = bf2f(*(const LAS bf16*)(lds + DP_KN + l0 * DP_TS + d * 2)) * SC[192 + l0];
            const float bb = bf2f(*(const LAS bf16*)(lds + DP_KN + (l0 + 1) * DP_TS + d * 2)) * SC[192 + l0 + 1];
            w[k] = pack2(a, bb);
        }
        *(u32x4*)(KDT + d * 64 + 16 * lq) = (u32x4){w[0], w[1], w[2], w[3]};
        *(u32x4*)(KDT + d * 64 + 16 * lq + 8) = (u32x4){w[4], w[5], w[6], w[7]};
    }
    __syncthreads();
    const f32x4 zero4 = (f32x4){0.f, 0.f, 0.f, 0.f};
#pragma unroll
    for (int cc = 0; cc < 2; ++cc) {
        const int ct = 2 * wv + cc;
        const bool isw = ct >= 8;
        const int colb = (ct & 7) * 16 + r;
        f32x4 R[4];
#pragma unroll
        for (int I = 0; I < 4; ++I)
#pragma unroll
            for (int jj = 0; jj < 4; ++jj) {
                const int row = 16 * I + 4 * q + jj;
                R[I][jj] = isw ? bf2f(*(const LAS bf16*)(lds + DP_KB + row * DP_TS + colb * 2)) * SC[128 + row]
                               : bf2f(*(const LAS bf16*)(lds + DP_VN + row * DP_TS + colb * 2)) * SC[row];
            }
        f32x4 X[4];
        X[0] = __builtin_amdgcn_mfma_f32_16x16x32_bf16(frag_kc_pk(lds + DP_TD, DP_TDS, 0, 0, r, q), pack8(R[0], zero4), zero4, 0, 0, 0);
        f32x4 a1 = __builtin_amdgcn_mfma_f32_16x16x32_bf16(frag_kc_pk(lds + DP_LB, DP_LS, 16, 0, r, q), pack8(X[0], zero4), R[1], 0, 0, 0);
        X[1] = __builtin_amdgcn_mfma_f32_16x16x32_bf16(frag_kc_pk(lds + DP_TD, DP_TDS, 16, 0, r, q), pack8(a1, zero4), zero4, 0, 0, 0);
        f32x4 a2 = __builtin_amdgcn_mfma_f32_16x16x32_bf16(frag_kc_pk(lds + DP_LB, DP_LS, 32, 0, r, q), pack8(X[0], X[1]), R[2], 0, 0, 0);
        X[2] = __builtin_amdgcn_mfma_f32_16x16x32_bf16(frag_kc_pk(lds + DP_TD, DP_TDS, 32, 0, r, q), pack8(a2, zero4), zero4, 0, 0, 0);
        f32x4 a3 = __builtin_amdgcn_mfma_f32_16x16x32_bf16(frag_kc_pk(lds + DP_LB, DP_LS, 48, 0, r, q), pack8(X[0], X[1]), R[3], 0, 0, 0);
        a3 = __builtin_amdgcn_mfma_f32_16x16x32_bf16(frag_kc_pk(lds + DP_LB, DP_LS, 48, 32, r, q), pack8(X[2], zero4), a3, 0, 0, 0);
        X[3] = __builtin_amdgcn_mfma_f32_16x16x32_bf16(frag_kc_pk(lds + DP_TD, DP_TDS, 48, 0, r, q), pack8(a3, zero4), zero4, 0, 0, 0);
        bf16* dst = (isw ? WT : UT) + colb * 64;
#pragma unroll
        for (int I = 0; I < 4; ++I) { u32x2 w; w.x = pack2(X[I][0], X[I][1]); w.y = pack2(X[I][2], X[I][3]); *(u32x2*)(dst + 16 * I + 4 * q) = w; }
    }
}

constexpr int DS_ST = 0, DS_STS = 272;
constexpr int DS_WT = DS_ST + 64 * 272, DS_WTS = 160;
constexpr int DS_QD = DS_WT + 128 * 160, DS_QDS = 272;
constexpr int DS_AT = DS_QD + 64 * 272, DS_ATS = 144;
constexpr int DS_KD = DS_AT + 64 * 144, DS_KDS = 144;
constexpr int DS_UT = DS_KD + 128 * 144, DS_UTS = 144;
constexpr int DS_END = DS_UT + 64 * 144;

__device__ __forceinline__ void dn_load_item(const unsigned char* ib, int half, u32x4 (&rg)[8]) {
    const int tid = threadIdx.x;
#pragma unroll
    for (int i = 0; i < 2; ++i) rg[i] = *(const u32x4*)(ib + 16384 + (size_t)(tid + NT * i) * 16);
#pragma unroll
    for (int i = 0; i < 2; ++i) rg[2 + i] = *(const u32x4*)(ib + 32768 + (size_t)(tid + NT * i) * 16);
#pragma unroll
    for (int i = 0; i < 2; ++i) rg[4 + i] = *(const u32x4*)(ib + 49152 + (size_t)(tid + NT * i) * 16);
    rg[6] = *(const u32x4*)(ib + 65536 + (size_t)tid * 16);
    rg[7] = *(const u32x4*)(ib + (size_t)half * 8192 + (size_t)tid * 16);
}
__device__ __forceinline__ void dn_store_item_lds(LAS unsigned char* lds, const u32x4 (&rg)[8]) {
    const int tid = threadIdx.x;
#pragma unroll
    for (int i = 0; i < 2; ++i) { const int e = tid + NT * i; *(LAS u32x4*)(lds + DS_WT + (e >> 3) * DS_WTS + (e & 7) * 16) = rg[i]; }
#pragma unroll
    for (int i = 0; i < 2; ++i) { const int e = tid + NT * i; *(LAS u32x4*)(lds + DS_QD + (e >> 4) * DS_QDS + (e & 15) * 16) = rg[2 + i]; }
#pragma unroll
    for (int i = 0; i < 2; ++i) { const int e = tid + NT * i; *(LAS u32x4*)(lds + DS_KD + (e >> 3) * DS_KDS + (e & 7) * 16) = rg[4 + i]; }
    *(LAS u32x4*)(lds + DS_AT + (tid >> 3) * DS_ATS + (tid & 7) * 16) = rg[6];
    *(LAS u32x4*)(lds + DS_UT + (tid >> 3) * DS_UTS + (tid & 7) * 16) = rg[7];
}

__device__ __forceinline__ void dn_scan_stream(const Params& p, LAS unsigned char* lds, bool prompt, int b, int h, int half, bf16* ODN) {
    unsigned char* ws = p.ws;
    const int tid = threadIdx.x, lane = tid & 63, wv = tid >> 6, r = lane & 15, q = lane >> 4;
    const int nchunks = prompt ? 32 : 1, nvalid = prompt ? 64 : DECS, t0 = prompt ? b * SEQ : TP + b * DECS;
    const int item0 = prompt ? ((b * 8 + h) * 32) : (2048 + b * 8 + h);
    const float* GT = (const float*)(ws + WS_DNGT);
    const int et = wv & 3, hf = wv >> 2;
    f32x4 Sacc[4];
#pragma unroll
    for (int i = 0; i < 4; ++i) {
        if (prompt) Sacc[i] = (f32x4){0.f, 0.f, 0.f, 0.f};
        else {
            const float* s0 = p.in[3] + (((size_t)b * 8 + h) * 128 + 16 * (4 * hf + i) + 4 * q) * 128 + 64 * half + 16 * et + r;
            Sacc[i] = (f32x4){s0[0], s0[128], s0[256], s0[384]};
        }
    }
    __syncthreads();
#pragma unroll
    for (int i = 0; i < 4; ++i) {
        u32x2 w; w.x = pack2(Sacc[i][0], Sacc[i][1]); w.y = pack2(Sacc[i][2], Sacc[i][3]);
        *(LAS u32x2*)(lds + DS_ST + (16 * et + r) * DS_STS + (16 * (4 * hf + i) + 4 * q) * 2) = w;
    }
    u32x4 rg[8];
    dn_load_item(ws + WS_DNI + (size_t)item0 * DN_ITEM_BYTES, half, rg);
    for (int c = 0; c < nchunks; ++c) {
        __syncthreads();
        dn_store_item_lds(lds, rg);
        const float gtot = GT[item0 + c];
        if (c + 1 < nchunks) dn_load_item(ws + WS_DNI + (size_t)(item0 + c + 1) * DN_ITEM_BYTES, half, rg);
        __syncthreads();
        f32x4 vn[4];
#pragma unroll
        for (int lt = 0; lt < 4; ++lt) vn[lt] = (f32x4){0.f, 0.f, 0.f, 0.f};
        bf16x8 sB[4];
#pragma unroll
        for (int ks = 0; ks < 4; ++ks) sB[ks] = frag_kc_pk(lds + DS_ST, DS_STS, 16 * et, 32 * ks, r, q);
#pragma unroll
        for (int ks = 0; ks < 4; ++ks)
#pragma unroll
            for (int lt = 0; lt < 4; ++lt) {
                const bf16x8 a = frag_tr(lds + DS_WT, DS_WTS, 32 * ks, 16 * lt, r, q);
                vn[lt] = __builtin_amdgcn_mfma_f32_16x16x32_bf16(a, sB[ks], vn[lt], 0, 0, 0);
            }
#pragma unroll
        for (int lt = 0; lt < 4; ++lt) {
            const u32x2 uu = *(const LAS u32x2*)(lds + DS_UT + (16 * et + r) * DS_UTS + (16 * lt + 4 * q) * 2);
            vn[lt][0] = __uint_as_float(uu.x << 16) - vn[lt][0]; vn[lt][1] = __uint_as_float(uu.x & 0xffff0000u) - vn[lt][1];
            vn[lt][2] = __uint_as_float(uu.y << 16) - vn[lt][2]; vn[lt][3] = __uint_as_float(uu.y & 0xffff0000u) - vn[lt][3];
        }
        const bf16x8 vB0 = pack8(vn[0], vn[1]), vB1 = pack8(vn[2], vn[3]);
#pragma unroll
        for (int li = 0; li < 2; ++li) {
            const int lt = 2 * hf + li;
            f32x4 o = (f32x4){0.f, 0.f, 0.f, 0.f};
#pragma unroll
            for (int ks = 0; ks < 4; ++ks) o = __builtin_amdgcn_mfma_f32_16x16x32_bf16(frag_kc_pk(lds + DS_QD, DS_QDS, 16 * lt, 32 * ks, r, q), sB[ks], o, 0, 0, 0);
            o = __builtin_amdgcn_mfma_f32_16x16x32_bf16(frag_kc_pk(lds + DS_AT, DS_ATS, 16 * lt, 0, r, q), vB0, o, 0, 0, 0);
            o = __builtin_amdgcn_mfma_f32_16x16x32_bf16(frag_kc_pk(lds + DS_AT, DS_ATS, 16 * lt, 32, r, q), vB1, o, 0, 0, 0);
#pragma unroll
            for (int j = 0; j < 4; ++j) {
                const int l = 16 * lt + 4 * q + j;
                if (l < nvalid) ODN[(size_t)(t0 + c * 64 + l) * 1024 + h * 128 + 64 * half + 16 * et + r] = f2bf(o[j]);
            }
        }
        __syncthreads();
#pragma unroll
        for (int i = 0; i < 4; ++i) {
            const int dt = 4 * hf + i;
            f32x4 acc = Sacc[i] * gtot;
            acc = __builtin_amdgcn_mfma_f32_16x16x32_bf16(frag_kc_pk(lds + DS_KD, DS_KDS, 16 * dt, 0, r, q), vB0, acc, 0, 0, 0);
            acc = __builtin_amdgcn_mfma_f32_16x16x32_bf16(frag_kc_pk(lds + DS_KD, DS_KDS, 16 * dt, 32, r, q), vB1, acc, 0, 0, 0);
            Sacc[i] = acc;
            u32x2 w; w.x = pack2(acc[0], acc[1]); w.y = pack2(acc[2], acc[3]);
            *(LAS u32x2*)(lds + DS_ST + (16 * et + r) * DS_STS + (16 * dt + 4 * q) * 2) = w;
        }
    }
    float* so = p.out + (prompt ? O_P_DN : O_S_DN) + (((size_t)b * 8 + h) * 128) * 128;
#pragma unroll
    for (int i = 0; i < 4; ++i)
#pragma unroll
        for (int j = 0; j < 4; ++j) so[(size_t)(16 * (4 * hf + i) + 4 * q + j) * 128 + 64 * half + 16 * et + r] = Sacc[i][j];
}

__device__ __forceinline__ void mix_norm_phase(const Params& p, const bf16* ODN, const bf16* YGB) {
    unsigned char* ws = p.ws;
    const bf16* PROJB = (const bf16*)(ws + WS_PROJB);
    bf16* OCATB = (bf16*)(ws + WS_OCATB);
    const int lane = threadIdx.x & 63, wv = threadIdx.x >> 6;
    const float* dnw = p.in[14]; const float* ssw = p.in[20];
    for (int t = blockIdx.x * 8 + wv; t < T; t += gridDim.x * 8) {
        {
            const u32x4 a = *(const u32x4*)(ODN + (size_t)t * 1024 + 16 * lane), bq = *(const u32x4*)(ODN + (size_t)t * 1024 + 16 * lane + 8);
            const u32x4 za = *(const u32x4*)(PROJB + (size_t)t * PROJW + 4608 + 16 * lane), zb = *(const u32x4*)(PROJB + (size_t)t * PROJW + 4608 + 16 * lane + 8);
            const unsigned w[8] = {a.x, a.y, a.z, a.w, bq.x, bq.y, bq.z, bq.w}, zw[8] = {za.x, za.y, za.z, za.w, zb.x, zb.y, zb.z, zb.w};
            float v[16]; float ss = 0.f;
#pragma unroll
            for (int i = 0; i < 8; ++i) { v[2 * i] = __uint_as_float(w[i] << 16); v[2 * i + 1] = __uint_as_float(w[i] & 0xffff0000u); ss += v[2 * i] * v[2 * i] + v[2 * i + 1] * v[2 * i + 1]; }
            ss += __shfl_xor(ss, 1); ss += __shfl_xor(ss, 2); ss += __shfl_xor(ss, 4);
            const float rstd = rsqrtf(ss * (1.0f / 128.0f) + 1e-6f);
            unsigned o[8];
#pragma unroll
            for (int i = 0; i < 8; ++i) {
                const int cw = (16 * lane + 2 * i) & 127;
                const float z0 = __uint_as_float(zw[i] << 16), z1 = __uint_as_float(zw[i] & 0xffff0000u);
                o[i] = pack2(v[2 * i] * rstd * dnw[cw] * silu_f(z0), v[2 * i + 1] * rstd * dnw[cw + 1] * silu_f(z1));
            }
            *(u32x4*)(OCATB + (size_t)t * 2048 + 16 * lane) = (u32x4){o[0], o[1], o[2], o[3]};
            *(u32x4*)(OCATB + (size_t)t * 2048 + 16 * lane + 8) = (u32x4){o[4], o[5], o[6], o[7]};
        }
        {
            const u32x4 a = *(const u32x4*)(YGB + (size_t)t * 1024 + 16 * lane), bq = *(const u32x4*)(YGB + (size_t)t * 1024 + 16 * lane + 8);
            const unsigned w[8] = {a.x, a.y, a.z, a.w, bq.x, bq.y, bq.z, bq.w};
            float v[16]; float ss = 0.f;
#pragma unroll
            for (int i = 0; i < 8; ++i) { v[2 * i] = __uint_as_float(w[i] << 16); v[2 * i + 1] = __uint_as_float(w[i] & 0xffff0000u); ss += v[2 * i] * v[2 * i] + v[2 * i + 1] * v[2 * i + 1]; }
            ss += __shfl_xor(ss, 1); ss += __shfl_xor(ss, 2); ss += __shfl_xor(ss, 4); ss += __shfl_xor(ss, 8); ss += __shfl_xor(ss, 16);
            const float rstd = rsqrtf(ss * (1.0f / 512.0f) + 1e-6f);
            unsigned o[8];
#pragma unroll
            for (int i = 0; i < 8; ++i) { const int cw = 16 * lane + 2 * i; o[i] = pack2(v[2 * i] * rstd * ssw[cw], v[2 * i + 1] * rstd * ssw[cw + 1]); }
            *(u32x4*)(OCATB + (size_t)t * 2048 + 1024 + 16 * lane) = (u32x4){o[0], o[1], o[2], o[3]};
            *(u32x4*)(OCATB + (size_t)t * 2048 + 1024 + 16 * lane + 8) = (u32x4){o[4], o[5], o[6], o[7]};
        }
    }
    for (int s = blockIdx.x; s < 8 + 128; s += gridDim.x) {
        const bool prompt = s < 8; const int b = prompt ? s : s - 8;
        const int tlast = prompt ? (b * SEQ + SEQ - 3) : (TP + b * DECS + DECS - 3);
        float* dnc = p.out + (prompt ? O_P_DNC : O_S_DNC) + (size_t)b * 3 * DN_QKV;
        float* sc = p.out + (prompt ? O_P_SC : O_S_SC) + (size_t)b * 3 * SSM_XBC;
        for (int i = threadIdx.x; i < 3 * (DN_QKV + SSM_XBC); i += NT) {
            const int rr = i / (DN_QKV + SSM_XBC), cc = i - rr * (DN_QKV + SSM_XBC);
            const float v = bf2f(PROJB[(size_t)(tlast + rr) * PROJW + cc]);
            if (cc < DN_QKV) dnc[rr * DN_QKV + cc] = v; else sc[rr * SSM_XBC + (cc - DN_QKV)] = v;
        }
    }
}

#ifndef MIX_YGF32
#define MIX_YGF32 false
#endif
constexpr size_t WS_YGB = WS_XN;
enum { PH_PROLOGUE = 0, PH_INPROJ = 1, PH_MIX_PREP = 2, PH_MIX_SCAN = 3, PH_MIX_NORM = 4, PH_WOUT = 5, PH_QKV = 6, PH_ATTN = 7, PH_WXO = 8, PH_PQ = 9, PH_PEER = 10, PH_END = 11 };

__global__ void __launch_bounds__(NT, 2) mega(Params p) {
    extern __shared__ __attribute__((aligned(16))) unsigned char lds_raw[];
    LAS unsigned char* lds = (LAS unsigned char*)lds_raw;
    volatile LAS unsigned* misc = (volatile LAS unsigned*)(lds + LDS_MISC);
    if (threadIdx.x < 4) misc[threadIdx.x] = 0u;
    __syncthreads();
    unsigned char* ws = p.ws;
    XcdBarrier bar; bar.bar = (unsigned*)(ws + WS_CTL); bar.x = 0; bar.st = misc;
    if (p.use_bar) bar = xcd_barrier_post((unsigned*)(ws + WS_CTL), misc);
    float* SS1 = (float*)(ws + WS_CTL + CTL_SS1);
    float* SS2 = (float*)(ws + WS_CTL + CTL_SS2);
#define IN(k) (p.ph_lo <= (k) && (k) < p.ph_hi)
#define SEAM(k) do { if (p.use_bar && IN((k) + 1)) xcd_barrier(bar); } while (0)
    if (IN(PH_PROLOGUE)) { p0_prologue(p, lds); SEAM(PH_PROLOGUE); }
    if (IN(PH_INPROJ)) {
        EpiProj E{(bf16*)(ws + WS_PROJB), (float*)(ws + WS_SMALL)};
        run_gemm(lds, (const bf16*)(ws + WS_XN), (const bf16*)(ws + WS_WIN), T, NPAD, 1024, E);
        SEAM(PH_INPROJ);
    }
    bf16* ODN = (bf16*)(p.out + O_Y);
    bf16* YGB = ODN + (size_t)T * 1024;
    if (IN(PH_MIX_PREP)) {
        for (int item = blockIdx.x; item < DN_NITEMS; item += gridDim.x) dn_prep_item(p, lds, item);
        SEAM(PH_MIX_PREP);
    }
    if (IN(PH_MIX_SCAN)) {
        const int G = gridDim.x, hg = G >> 1;
        if ((int)blockIdx.x < hg) {
            for (int it = blockIdx.x; it < 128 + 2048; it += hg) {
                if (it < 128) dn_scan_stream(p, lds, true, it >> 4, (it >> 1) & 7, it & 1, ODN);
                else { const int s = it - 128; dn_scan_stream(p, lds, false, s >> 4, (s >> 1) & 7, s & 1, ODN); }
            }
        } else {
            for (int it = blockIdx.x - hg; it < 128 + 2048; it += G - hg) {
                if (it < 128) ssd_stream<false>(p, lds, true, it >> 4, it & 15, (void*)YGB);
                else ssd_stream<false>(p, lds, false, (it - 128) >> 4, (it - 128) & 15, (void*)YGB);
            }
        }
        SEAM(PH_MIX_SCAN);
    }
    if (IN(PH_MIX_NORM)) { mix_norm_phase(p, ODN, YGB); SEAM(PH_MIX_NORM); }
    if (IN(PH_WOUT)) {
        EpiRes E{p.in[0], p.in[1], (float*)(ws + WS_H), (bf16*)(ws + WS_HB), SS1};
        run_gemm(lds, (const bf16*)(ws + WS_OCATB), (const bf16*)(ws + WS_WOUT), T, 1024, 2048, E);
        SEAM(PH_WOUT);
    }
    if (IN(PH_QKV)) {
        EpiScale E{(bf16*)(ws + WS_QB), 1024, SS1, 0.0625f};
        run_gemm(lds, (const bf16*)(ws + WS_HB), (const bf16*)(ws + WS_WXQ), T, 1024, 1024, E);
        EpiMkv E2{p.out + O_P_MK, p.out + O_P_MV, (bf16*)(ws + WS_MKB), (bf16*)(ws + WS_MVB)};
        run_gemm(lds, (const bf16*)(ws + WS_MEMN), (const bf16*)(ws + WS_WMKV), 2048, 2048, 1024, E2);
        SEAM(PH_QKV);
    }
    if (IN(PH_ATTN)) { attn_phase(p, lds); SEAM(PH_ATTN); }
    if (IN(PH_WXO)) {
        EpiRes E{(const float*)(ws + WS_H), (const float*)(ws + WS_H) + (size_t)TP * 1024, (float*)(ws + WS_H), (bf16*)(ws + WS_HB), SS2};
        run_gemm(lds, (const bf16*)(ws + WS_OB), (const bf16*)(ws + WS_WXO), T, 1024, 1024, E);
        SEAM(PH_WXO);
    }
    if (IN(PH_PQ)) {
        EpiScale E{(bf16*)(ws + WS_PQB), 2048, SS2, 1.0f};
        run_gemm(lds, (const bf16*)(ws + WS_HB), (const bf16*)(ws + WS_WPQ), T, 2048, 1024, E);
        SEAM(PH_PQ);
    }
    if (IN(PH_PEER)) { peer_phase(p, lds); }
#undef IN
#undef SEAM
}

__global__ void __launch_bounds__(256) cvt_bf16_to_f32(const bf16* __restrict__ s, float* __restrict__ d, size_t n) {
    for (size_t i = (size_t)blockIdx.x * 256 + threadIdx.x; i < n; i += (size_t)gridDim.x * 256) d[i] = bf2f(s[i]);
}
__global__ void __launch_bounds__(256) cvt_f32_to_bf16(const float* __restrict__ s, bf16* __restrict__ d, size_t n) {
    for (size_t i = (size_t)blockIdx.x * 256 + threadIdx.x; i < n; i += (size_t)gridDim.x * 256) d[i] = f2bf(s[i]);
}
}

static int g_grid = 0;
static void mega_setup() {
    if (g_grid) return;
    int dev = 0, cus = 0, per_cu = 0;
    hipGetDevice(&dev);
    hipDeviceGetAttribute(&cus, hipDeviceAttributeMultiprocessorCount, dev);
    hipFuncSetAttribute((const void*)fk::mega, hipFuncAttributeMaxDynamicSharedMemorySize, fk::LDS_BYTES);
    hipOccupancyMaxActiveBlocksPerMultiprocessor(&per_cu, (const void*)fk::mega, fk::NT, fk::LDS_BYTES);
    if (per_cu < 1) { fprintf(stderr, "occupancy query says %d blocks/CU\n", per_cu); per_cu = 1; }
    (void)hipGetLastError();
    g_grid = cus;
}
static void mega_launch(hipStream_t s, const fk::Params& base, int lo, int hi, int use_bar) {
    fk::Params p = base; p.ph_lo = lo; p.ph_hi = hi; p.use_bar = use_bar; p.pad = 0;
    hipLaunchKernelGGL(fk::mega, dim3(g_grid), dim3(fk::NT), fk::LDS_BYTES, s, p);
}
static void cvt_b2f(hipStream_t s, const void* src, float* dst, size_t n) { fk::cvt_bf16_to_f32<<<2048, 256, 0, s>>>((const fk::bf16*)src, dst, n); }
static void cvt_f2b(hipStream_t s, const float* src, void* dst, size_t n) { fk::cvt_f32_to_bf16<<<2048, 256, 0, s>>>(src, (fk::bf16*)dst, n); }

extern "C" void kernel_launch(void* const* d_in, const int* in_sizes, int n_in, void* d_out, int out_size, void* d_ws, size_t ws_size, hipStream_t stream) {
    mega_setup();
    fk::Params P{};
    for (int i = 0; i < 33; ++i) P.in[i] = (const float*)d_in[i];
    P.out = (float*)d_out; P.ws = (unsigned char*)d_ws;
    hipMemsetAsync((unsigned char*)d_ws + fk::WS_CTL, 0, fk::CTL_BYTES, stream);
    mega_launch(stream, P, 0, fk::PH_END, 1);
}
```

```cpp
#include <hip/hip_runtime.h>
#include <stdint.h>
#include <stdio.h>

constexpr int D = 1024, BATCH = 8, SEQ = 2048, DECB = 128, DECS = 8;
constexpr int TP = BATCH * SEQ, TS = DECB * DECS, T = TP + TS;
constexpr int DN_QKV = 3072, SSM_XBC = 1536, NPROJ = 6688;
constexpr size_t O_Y = 0;
constexpr size_t O_P_DNC = 17825792, O_P_DN = 17899520, O_P_SC = 18948096, O_P_SS = 18984960, O_P_MK = 20033536, O_P_MV = 22130688;
constexpr size_t O_S_DNC = 24227840, O_S_DN = 25407488, O_S_SC = 42184704, O_S_SS = 42774528;

#define XB_TMO      128
#define XB_XCNT(j)  (256  + 64 * (j))
#define XB_XSUB(j)  (1280 + 64 * (j))
#define XB_XGEN(j)  (2304 + 64 * (j))
#define XB_TOP      3328
#define XB_TOPGEN   3392
#define XCD_BAR_WORDS 3456
#define XB_SPIN_CAP (1u << 18)
#define LAS __attribute__((address_space(3)))

__device__ __forceinline__ unsigned xb_ld(unsigned* p)              { return __hip_atomic_load(p, __ATOMIC_RELAXED, __HIP_MEMORY_SCOPE_AGENT); }
__device__ __forceinline__ unsigned xb_add(unsigned* p, unsigned v) { return __hip_atomic_fetch_add(p, v, __ATOMIC_RELAXED, __HIP_MEMORY_SCOPE_AGENT); }
__device__ __forceinline__ unsigned xb_xcc_id() { return (unsigned)__builtin_amdgcn_s_getreg((3 << 11) | 20) & 0xFu; }
#define XB_SPIN(cond, bar) do { unsigned _sp = 0; while (cond) { __builtin_amdgcn_s_sleep(1); \
    if ((++_sp & 255u) == 0u) { if (xb_ld(&(bar)[XB_TMO])) break; if (_sp > XB_SPIN_CAP) { atomicAdd(&(bar)[XB_TMO], 1u); break; } } } } while (0)

struct XcdBarrier {
    unsigned* bar; unsigned x;
    volatile LAS unsigned* st;
};

__device__ __forceinline__ XcdBarrier xcd_barrier_post(unsigned* bar, volatile LAS unsigned* st) {
    XcdBarrier b; b.bar = bar; b.x = xb_xcc_id(); b.st = st;
    if (threadIdx.x == 0) (void)xb_add(&bar[XB_XCNT(b.x)], 1u);
    return b;
}
__device__ __forceinline__ void xcd_barrier_complete(unsigned* bar, unsigned x, unsigned& nloc, unsigned& nx) {
    const unsigned G = gridDim.x * gridDim.y * gridDim.z;
    unsigned sum, cnt, mine, sp = 0u;
    for (;;) {
        sum = 0u; cnt = 0u; mine = 0u;
#pragma unroll
        for (unsigned j = 0; j < 16; ++j) { const unsigned c = xb_ld(&bar[XB_XCNT(j)]); sum += c; cnt += (c > 0u) ? 1u : 0u; mine = (j == x) ? c : mine; }
        if (sum == G) break;
        __builtin_amdgcn_s_sleep(1);
        if ((++sp & 255u) == 0u) { if (xb_ld(&bar[XB_TMO])) break; if (sp > XB_SPIN_CAP) { atomicAdd(&bar[XB_TMO], 1u); break; } }
    }
    nloc = mine > 0u ? mine : 1u; nx = cnt > 0u ? cnt : 1u;
}

__device__ __forceinline__ void xcd_barrier(const XcdBarrier& b) {
    asm volatile("s_waitcnt vmcnt(0)" ::: "memory");
    __syncthreads();
    if (threadIdx.x == 0) {
        unsigned* bar = b.bar;
        __builtin_amdgcn_s_waitcnt(0);
        unsigned nloc = b.st[0], nx = b.st[1];
        if (nloc == 0u) { xcd_barrier_complete(bar, b.x, nloc, nx); b.st[0] = nloc; b.st[1] = nx; }
        const unsigned old = xb_add(&bar[XB_XSUB(b.x)], 1u);
        const unsigned gen = old / nloc;
        if (old + 1u == (gen + 1u) * nloc) {
            __builtin_amdgcn_fence(__ATOMIC_RELEASE, "agent");
            asm volatile("s_waitcnt vmcnt(0)" ::: "memory");
            const unsigned og = xb_add(&bar[XB_TOP], 1u);
            const unsigned tg = og / nx;
            if (og + 1u == (tg + 1u) * nx) xb_add(&bar[XB_TOPGEN], 1u);
            else XB_SPIN(xb_ld(&bar[XB_TOPGEN]) == tg, bar);
            __builtin_amdgcn_fence(__ATOMIC_ACQUIRE, "agent");
            xb_add(&bar[XB_XGEN(b.x)], 1u);
            asm volatile("s_waitcnt vmcnt(0)" ::: "memory");
        } else {
            XB_SPIN(xb_ld(&bar[XB_XGEN(b.x)]) == gen, bar);
            __builtin_amdgcn_fence(__ATOMIC_ACQUIRE, "agent");
            asm volatile("s_waitcnt vmcnt(0)" ::: "memory");
        }
    }
    __syncthreads();
}

__device__ __forceinline__ int tidx() { int t = threadIdx.x; asm volatile("" : "+v"(t)); return t; }

namespace pg8 {
#define PG8_LAS __attribute__((address_space(3)))
typedef unsigned short bf16_t;
typedef short bf16x8 __attribute__((ext_vector_type(8)));
typedef float f32x4 __attribute__((ext_vector_type(4)));
typedef unsigned u32x4 __attribute__((ext_vector_type(4)));
constexpr int BM = 256, BK = 64, HALF = 128, HTB = HALF * BK * 2  , STAGE_BYTES = 8 * HTB, NXCD = 8, WGM = 8;

__host__ __device__ __forceinline__ int lds_byte(int r, int c) { const int st = (r >> 4) * 2 + (c >> 5), rr = r & 15, cc = c & 31, ob = rr * 64 + cc * 2; return st * 1024 + (ob ^ (((ob >> 9) & 1) << 5)); }
__host__ __device__ __forceinline__ void stage_rc(int b, int& R, int& C) { const int st = b / 1024, sb = b % 1024, swz = sb ^ (((sb >> 9) & 1) << 5); R = (st >> 1) * 16 + swz / 64; C = (st & 1) * 32 + (swz % 64) / 2; }
__host__ __device__ __forceinline__ int perm32(int rho) { const int n = rho >> 4, i = rho & 15; return 8 * (i >> 2) + 4 * n + (i & 3); }

struct Unit { int pm, pn; };
struct Gemm { const bf16_t* A; const bf16_t* Bt; int M, N, K; };

struct StaticOrder {
    int nM, nN, nwg, G, c;
    __host__ __device__ void init(int M, int N, int G_, int c_) { nM = M / BM; nN = N / BM; nwg = nM * nN; G = G_; c = c_; }
    __host__ __device__ bool next(int i, Unit& u) const {
        const long L = (long)i * G + c; if (L >= nwg) return false;
        int wgid = (int)L; { const int q = nwg / NXCD, r = nwg % NXCD, xcd = wgid % NXCD, off = wgid / NXCD; wgid = (xcd < r ? xcd * (q + 1) : r * (q + 1) + (xcd - r) * q) + off; }
        const int nig = WGM * nN, gid = wgid / nig, fm = gid * WGM, gsz = (nM - fm) < WGM ? (nM - fm) : WGM;
        u.pm = fm + ((wgid % nig) % gsz); u.pn = (wgid % nig) / gsz; return true;
    }
    __device__ __forceinline__ void a_ready(const Unit&) const {}
    __device__ __forceinline__ void done(const Unit&) const {}
};
__device__ __forceinline__ unsigned cvt_pk_bf16(float lo, float hi) { unsigned r; asm volatile("v_cvt_pk_bf16_f32 %0, %1, %2" : "=v"(r) : "v"(lo), "v"(hi)); return r; }
typedef float f32x2 __attribute__((ext_vector_type(2)));
template <class Epi, class Sched, bool STAMP = false>
__device__ __forceinline__ void gemm_phase(PG8_LAS unsigned char* lds, const Gemm g, const Sched& S, const Epi& E, unsigned long long* stamps) {
    const int tid = tidx(), wid = __builtin_amdgcn_readfirstlane(tid >> 6), lane = tid & 63, wr = wid >> 2, wc = wid & 3, fr = lane & 15, fq = lane >> 4;
    const int K = g.K, nt = K / BK;
    int ts_lo = 0, ts_hi = 0, nts = 0; const unsigned long long rt_entry = STAMP ? (unsigned long long)wall_clock64() : 0ull;
#define PG8_STAMP() do { if (STAMP && wid == 0 && nts < 64) { const unsigned long long _c = (unsigned long long)clock64(); \
        ts_lo = (lane == nts) ? (int)(unsigned)_c : ts_lo; ts_hi = (lane == nts) ? (int)(unsigned)(_c >> 32) : ts_hi; ++nts; } } while (0)
    PG8_STAMP();
    unsigned voffA[2], voffB[2];
#pragma unroll
    for (int i = 0; i < 2; ++i) { int R, C; stage_rc(tid * 16 + i * 8192, R, C); const int Rb = Epi::PERM ? ((R & ~31) + perm32(R & 31)) : R;
        voffA[i] = (unsigned)(R * K + C) * 2u; voffB[i] = (unsigned)(Rb * K + C) * 2u; }
    const size_t kstep = (size_t)(BK * 2);
    const size_t hstep = (size_t)HALF * K * 2;
    const size_t tstep = 2 * hstep;
    const unsigned ldsw = (unsigned)wid * 1024u;
    const int aoff = lds_byte(wr * 64 + fr, fq * 8), boff = lds_byte(wc * 32 + fr, fq * 8);
#define PG8_SA(b, h) (((b) * 2 + (h)) * HTB)
#define PG8_SB(b, h) ((4 + (b) * 2 + (h)) * HTB)
#define PG8_STAGE(bufoff, gbase, voff) do { _Pragma("unroll") for (int _i = 0; _i < 2; ++_i) \
        __builtin_amdgcn_global_load_lds((const unsigned*)((const char*)(gbase) + (voff)[_i]), (PG8_LAS unsigned*)(lds + (bufoff) + ldsw + _i * 8192), 16, 0, 0); } while (0)
#define PG8_LDA(dst, b, h) do { _Pragma("unroll") for (int m = 0; m < 4; ++m) _Pragma("unroll") for (int k = 0; k < 2; ++k) dst[m][k] = *(const PG8_LAS bf16x8*)(lds + PG8_SA(b, h) + aoff + m * 2048 + k * 1024); } while (0)
#define PG8_LDB(dst, b, h) do { _Pragma("unroll") for (int n = 0; n < 2; ++n) _Pragma("unroll") for (int k = 0; k < 2; ++k) dst[n][k] = *(const PG8_LAS bf16x8*)(lds + PG8_SB(b, h) + boff + n * 2048 + k * 1024); } while (0)
#define PG8_MMA(ai, bj, At, Bt) do { __builtin_amdgcn_s_setprio(1); _Pragma("unroll") for (int m = 0; m < 4; ++m) _Pragma("unroll") for (int n = 0; n < 2; ++n) _Pragma("unroll") for (int k = 0; k < 2; ++k) \
        acc[ai][bj][m][n] = __builtin_amdgcn_mfma_f32_16x16x32_bf16(Bt[n][k], At[m][k], acc[ai][bj][m][n], 0, 0, 0); __builtin_amdgcn_s_setprio(0); } while (0)
#define PG8_WAIT_V(n) asm volatile("s_waitcnt vmcnt(" #n ")" ::: "memory")
#define PG8_WAIT_L(n) asm volatile("s_waitcnt lgkmcnt(" #n ")" ::: "memory")
#define PG8_BAR __builtin_amdgcn_s_barrier()
#define PG8_SCHED __builtin_amdgcn_sched_barrier(0)
    Unit cur, nxt; int ui = 0;
    if (!S.next(0, cur)) return;
    f32x4 acc[2][2][4][2];
#pragma unroll
    for (int a = 0; a < 2; ++a)
#pragma unroll
        for (int b = 0; b < 2; ++b)
#pragma unroll
            for (int m = 0; m < 4; ++m)
#pragma unroll
                for (int n = 0; n < 2; ++n) acc[a][b][m][n] = (f32x4){0.f, 0.f, 0.f, 0.f};
    bf16x8 At[4][2], B0[2][2], B1[2][2];
    const char* cA = (const char*)g.A + (size_t)cur.pm * tstep; const char* cB = (const char*)g.Bt + (size_t)cur.pn * tstep;
    S.a_ready(cur);
    PG8_STAGE(PG8_SB(0, 0), cB, voffB); PG8_STAGE(PG8_SA(0, 0), cA, voffA); PG8_STAGE(PG8_SB(0, 1), cB + hstep, voffB); PG8_STAGE(PG8_SA(0, 1), cA + hstep, voffA);
    if (wr == 1) PG8_BAR;
    PG8_WAIT_V(4); PG8_BAR;
    PG8_STAGE(PG8_SB(1, 0), cB + kstep, voffB); PG8_STAGE(PG8_SA(1, 0), cA + kstep, voffA); PG8_STAGE(PG8_SB(1, 1), cB + hstep + kstep, voffB);
    PG8_WAIT_V(6); PG8_BAR;
    PG8_STAMP();
    for (;;) {
        const bool has_next = S.next(ui + 1, nxt);
        const char* nA = has_next ? (const char*)g.A + (size_t)nxt.pm * tstep : cA; const char* nB = has_next ? (const char*)g.Bt + (size_t)nxt.pn * tstep : cB;
        for (int t = 0; t < nt; t += 2) {
            const bool last = (t == nt - 2);
            const char* a1 = cA + (size_t)(t + 1) * kstep;
            const char* a2 = last ? nA : cA + (size_t)(t + 2) * kstep; const char* b2 = last ? nB : cB + (size_t)(t + 2) * kstep;
            const char* a3 = a2 + kstep; const char* b3 = b2 + kstep;
            if (last && has_next) S.a_ready(nxt);
            PG8_LDB(B0, 0, 0); PG8_SCHED; PG8_LDA(At, 0, 0); PG8_STAGE(PG8_SA(1, 1), a1 + hstep, voffA);
            PG8_WAIT_L(8); PG8_BAR; PG8_WAIT_L(0); PG8_MMA(0, 0, At, B0); PG8_BAR; PG8_SCHED;
            PG8_LDB(B1, 0, 1); PG8_STAGE(PG8_SB(0, 0), b2, voffB);
            PG8_BAR; PG8_WAIT_L(0); PG8_MMA(0, 1, At, B1); PG8_BAR;
            PG8_LDA(At, 0, 1); PG8_STAGE(PG8_SA(0, 0), a2, voffA);
            PG8_BAR; PG8_WAIT_L(0); PG8_MMA(1, 0, At, B0); PG8_BAR; PG8_SCHED;
            PG8_STAGE(PG8_SB(0, 1), b2 + hstep, voffB);
            PG8_WAIT_V(6); PG8_BAR; PG8_MMA(1, 1, At, B1); PG8_BAR;
            PG8_LDB(B0, 1, 0); PG8_SCHED; PG8_LDA(At, 1, 0); PG8_STAGE(PG8_SA(0, 1), a2 + hstep, voffA);
            PG8_WAIT_L(8); PG8_BAR; PG8_WAIT_L(0); PG8_MMA(0, 0, At, B0); PG8_BAR; PG8_SCHED;
            PG8_LDB(B1, 1, 1); PG8_STAGE(PG8_SB(1, 0), b3, voffB);
            PG8_BAR; PG8_WAIT_L(0); PG8_MMA(0, 1, At, B1); PG8_BAR;
            PG8_LDA(At, 1, 1); PG8_STAGE(PG8_SA(1, 0), a3, voffA);
            PG8_BAR; PG8_WAIT_L(0); PG8_MMA(1, 0, At, B0); PG8_BAR; PG8_SCHED;
            PG8_STAGE(PG8_SB(1, 1), b3 + hstep, voffB);
            PG8_WAIT_V(6); PG8_BAR; PG8_MMA(1, 1, At, B1); PG8_BAR;
        }
        PG8_STAMP();
        if constexpr (!Epi::AFTER_DRAIN) { E(acc, cur, wr, wc, fr, fq); S.done(cur); }
        PG8_STAMP();
        if (!has_next) break;
#pragma unroll
        for (int a = 0; a < 2; ++a)
#pragma unroll
            for (int b = 0; b < 2; ++b)
#pragma unroll
                for (int m = 0; m < 4; ++m)
#pragma unroll
                    for (int n = 0; n < 2; ++n) acc[a][b][m][n] = (f32x4){0.f, 0.f, 0.f, 0.f};
        cur = nxt; cA = nA; cB = nB; ++ui;
    }
    PG8_WAIT_V(0);
    if (wr == 0) PG8_BAR;
    PG8_BAR;
    if constexpr (Epi::AFTER_DRAIN) { E.fused(acc, cur, wr, wc, fr, fq, lds, wid, lane); S.done(cur); }
    PG8_STAMP();
    if (STAMP && wid == 0) { stamps[lane] = lane < nts ? (((unsigned long long)(unsigned)ts_hi << 32) | (unsigned)ts_lo) : 0ull;
        if (lane == 62) stamps[62] = rt_entry; if (lane == 63) stamps[63] = (unsigned long long)wall_clock64(); }
#undef PG8_STAMP
#undef PG8_SA
#undef PG8_SB
#undef PG8_STAGE
#undef PG8_LDA
#undef PG8_LDB
#undef PG8_MMA
#undef PG8_WAIT_V
#undef PG8_WAIT_L
#undef PG8_BAR
#undef PG8_SCHED
}
}

namespace fk {
typedef unsigned short bf16;
typedef float f32x4 __attribute__((ext_vector_type(4)));
typedef unsigned u32x4 __attribute__((ext_vector_type(4)));
typedef unsigned u32x2 __attribute__((ext_vector_type(2)));

typedef __bf16 hwbf16x2 __attribute__((ext_vector_type(2)));
__device__ __forceinline__ bf16 f2bf(float f) { return __builtin_bit_cast(bf16, (__bf16)f); }
__device__ __forceinline__ float bf2f(bf16 b) { return __uint_as_float(((unsigned)b) << 16); }
__device__ __forceinline__ unsigned pack2(float lo, float hi) { hwbf16x2 v; v[0] = (__bf16)lo; v[1] = (__bf16)hi; return __builtin_bit_cast(unsigned, v); }

constexpr int NT = 512;
constexpr int LDS_BYTES = 163840, LDS_MISC = LDS_BYTES - 1024;
constexpr int NPAD = 6912;
constexpr int PROJW = 6656;

constexpr size_t al256(size_t x) { return (x + 255) & ~(size_t)255; }
constexpr size_t WS_CTL = 0, CTL_BYTES = 393216;
constexpr size_t CTL_SS1 = 65536, CTL_SS2 = 163840, CTL_SS3 = 262144, CTL_QUEUE = 32768;
constexpr size_t WS_WIN = WS_CTL + CTL_BYTES;
constexpr size_t WS_WOUT = WS_WIN + (size_t)NPAD * 1024 * 2;
constexpr size_t WS_WXQ = WS_WOUT + (size_t)1024 * 2048 * 2;
constexpr size_t WS_WMKV = WS_WXQ + (size_t)1024 * 1024 * 2;
constexpr size_t WS_WXO = WS_WMKV + (size_t)2048 * 1024 * 2;
constexpr size_t WS_WPQ = WS_WXO + (size_t)1024 * 1024 * 2;
constexpr size_t WS_SUBK = WS_WPQ + (size_t)2048 * 1024 * 2;
constexpr size_t WS_PU = WS_SUBK + (size_t)2 * 128 * 128 * 2;
constexpr size_t WS_PV = WS_PU + (size_t)16384 * 1024 * 2;
constexpr size_t WS_XN = WS_PV + (size_t)16384 * 1024 * 2;
constexpr size_t WS_MEMN = WS_XN + (size_t)T * 1024 * 2;
constexpr size_t WS_MKB = WS_MEMN + (size_t)2048 * 1024 * 2;
constexpr size_t WS_MVB = WS_MKB + (size_t)2048 * 1024 * 2;
constexpr size_t WS_SMALL = WS_MVB + (size_t)2048 * 1024 * 2;
constexpr size_t WS_OCATB = WS_SMALL + (size_t)T * 32 * 4;
constexpr size_t WS_PROJB = WS_OCATB + (size_t)T * 2048 * 2;
constexpr size_t WS_MIX = WS_PROJB + (size_t)T * PROJW * 2;
constexpr size_t WS_H = WS_PROJB;
constexpr size_t WS_HB = WS_H + (size_t)T * 1024 * 4;
constexpr size_t WS_QB = WS_HB + (size_t)T * 1024 * 2;
constexpr size_t WS_OB = WS_QB + (size_t)T * 1024 * 2;
constexpr size_t WS_PQB = WS_OCATB;
constexpr size_t WS_SELI = WS_MIX;
constexpr size_t WS_SELG = WS_SELI + (size_t)T * 128 * 2;
constexpr size_t WS_PART = WS_SELG + (size_t)T * 128 * 4;

struct Params {
    const float* in[33];
    float* out;
    unsigned char* ws;
    int ph_lo, ph_hi;
    int use_bar;
    int pad;
};

__device__ __forceinline__ void transpose_cvt(const float* __restrict__ W, int K, int N, int Npad, const float* __restrict__ gain, bf16* __restrict__ Wt,
                                              float* ft  , int vb, int nvb) {
    const int tid = tidx();
    const int ntk = K / 64, ntn = Npad / 64, ntiles = ntk * ntn;
    for (int tile = vb; tile < ntiles; tile += nvb) {
        const int k0 = (tile % ntk) * 64, n0 = (tile / ntk) * 64;
        __syncthreads();
#pragma unroll
        for (int i = 0; i < 2; ++i) {
            const int e = tid + i * NT;
            const int kr = e >> 4, c4 = e & 15;
            const int n = n0 + c4 * 4;
            float4 v = make_float4(0.f, 0.f, 0.f, 0.f);
            if (n + 3 < N) v = *(const float4*)(W + (size_t)(k0 + kr) * N + n);
            else { const float* wr = W + (size_t)(k0 + kr) * N; if (n < N) v.x = wr[n]; if (n + 1 < N) v.y = wr[n + 1]; if (n + 2 < N) v.z = wr[n + 2]; }
            const float g = gain ? gain[k0 + kr] : 1.0f;
            float* d = ft + kr * 65 + c4 * 4;
            d[0] = v.x * g; d[1] = v.y * g; d[2] = v.z * g; d[3] = v.w * g;
        }
        __syncthreads();
        const int kc8 = tid & 7, nr = tid >> 3;
        u32x4 w;
        w.x = pack2(ft[(kc8 * 8 + 0) * 65 + nr], ft[(kc8 * 8 + 1) * 65 + nr]);
        w.y = pack2(ft[(kc8 * 8 + 2) * 65 + nr], ft[(kc8 * 8 + 3) * 65 + nr]);
        w.z = pack2(ft[(kc8 * 8 + 4) * 65 + nr], ft[(kc8 * 8 + 5) * 65 + nr]);
        w.w = pack2(ft[(kc8 * 8 + 6) * 65 + nr], ft[(kc8 * 8 + 7) * 65 + nr]);
        *(u32x4*)(Wt + (size_t)(n0 + nr) * K + k0 + kc8 * 8) = w;
    }
}
__device__ __forceinline__ void cvt_stream(const float* __restrict__ src, bf16* __restrict__ dst, size_t n, int vb, int nvb) {
    const size_t n8 = n / 8;
    for (size_t i = (size_t)vb * NT + tidx(); i < n8; i += (size_t)nvb * NT) {
        const float4 a = ((const float4*)src)[2 * i], b = ((const float4*)src)[2 * i + 1];
        u32x4 w; w.x = pack2(a.x, a.y); w.y = pack2(a.z, a.w); w.z = pack2(b.x, b.y); w.w = pack2(b.z, b.w);
        ((u32x4*)dst)[i] = w;
    }
}
__device__ __forceinline__ void norm_rows_bf16(const Params& p, bf16* __restrict__ XN, bf16* __restrict__ MEMN, int vb, int nvb) {
    const int lane = tidx() & 63, wv = tidx() >> 6;
    const int nrows = T + 2048;
    for (int r = vb * 8 + wv; r < nrows; r += nvb * 8) {
        const float* src; bf16* dst;
        if (r < TP) { src = p.in[0] + (size_t)r * 1024; dst = XN + (size_t)r * 1024; }
        else if (r < T) { src = p.in[1] + (size_t)(r - TP) * 1024; dst = XN + (size_t)r * 1024; }
        else { src = p.in[8] + (size_t)(r - T) * 1024; dst = MEMN + (size_t)(r - T) * 1024; }
        float4 v[4]; float ss = 0.f;
#pragma unroll
        for (int i = 0; i < 4; ++i) { v[i] = ((const float4*)src)[lane + 64 * i]; ss += v[i].x * v[i].x + v[i].y * v[i].y + v[i].z * v[i].z + v[i].w * v[i].w; }
#pragma unroll
        for (int o = 32; o > 0; o >>= 1) ss += __shfl_xor(ss, o);
        const float rstd = rsqrtf(ss * (1.0f / 1024.0f) + 1e-6f);
#pragma unroll
        for (int i = 0; i < 4; ++i) { u32x2 w; w.x = pack2(v[i].x * rstd, v[i].y * rstd); w.y = pack2(v[i].z * rstd, v[i].w * rstd); ((u32x2*)dst)[lane + 64 * i] = w; }
    }
}
__device__ __forceinline__ void cvt_peer_tables(const float* __restrict__ src, unsigned char* __restrict__ dst, float scale, int vb, int nvb);
__device__ __forceinline__ void p0_prologue(const Params& p, LAS unsigned char* lds) {
    float* ft = (float*)(unsigned char*)lds;
    unsigned char* ws = p.ws;
    const int vb = blockIdx.x, nvb = gridDim.x;
    transpose_cvt(p.in[10], 1024, NPROJ, NPAD, p.in[9], (bf16*)(ws + WS_WIN), ft, vb, nvb);
    transpose_cvt(p.in[21], 2048, 1024, 1024, nullptr, (bf16*)(ws + WS_WOUT), ft, vb, nvb);
    transpose_cvt(p.in[24], 1024, 1024, 1024, p.in[22], (bf16*)(ws + WS_WXQ), ft, vb, nvb);
    transpose_cvt(p.in[25], 1024, 2048, 2048, p.in[23], (bf16*)(ws + WS_WMKV), ft, vb, nvb);
    transpose_cvt(p.in[26], 1024, 1024, 1024, nullptr, (bf16*)(ws + WS_WXO), ft, vb, nvb);
    transpose_cvt(p.in[28], 1024, 2048, 2048, p.in[27], (bf16*)(ws + WS_WPQ), ft, vb, nvb);
    cvt_stream(p.in[29], (bf16*)(ws + WS_SUBK), (size_t)2 * 128 * 128, vb, nvb);
    cvt_peer_tables(p.in[30], ws + WS_PU, 64.0f, vb, nvb);
    cvt_peer_tables(p.in[31], ws + WS_PV, 8.0f, vb, nvb);
    norm_rows_bf16(p, (bf16*)(ws + WS_XN), (bf16*)(ws + WS_MEMN), vb, nvb);
}

using pg8::Unit;
struct EpiProj {
    static constexpr bool PERM = true, AFTER_DRAIN = false;
    bf16* O; float* SM;
    __device__ __forceinline__ void operator()(const f32x4 (&acc)[2][2][4][2], const Unit& u, int wr, int wc, int fr, int fq) const {
        const int row0 = u.pm * 256 + wr * 64 + fr;
        if (u.pn < 26) {
            const int col0 = u.pn * 256 + wc * 32 + 8 * fq;
#pragma unroll
            for (int ai = 0; ai < 2; ++ai)
#pragma unroll
                for (int m = 0; m < 4; ++m) {
                    bf16* rowp = O + (size_t)(row0 + ai * 128 + m * 16) * PROJW + col0;
#pragma unroll
                    for (int bj = 0; bj < 2; ++bj) {
                        const f32x4 v0 = acc[ai][bj][m][0], v1 = acc[ai][bj][m][1];
                        u32x4 w; w.x = pack2(v0[0], v0[1]); w.y = pack2(v0[2], v0[3]); w.z = pack2(v1[0], v1[1]); w.w = pack2(v1[2], v1[3]);
                        *(u32x4*)(rowp + bj * 128) = w;
                    }
                }
        } else if (wc == 0) {
#pragma unroll
            for (int ai = 0; ai < 2; ++ai)
#pragma unroll
                for (int m = 0; m < 4; ++m) {
                    float* rowp = SM + (size_t)(row0 + ai * 128 + m * 16) * 32 + 8 * fq;
                    *(f32x4*)(rowp) = acc[ai][0][m][0];
                    *(f32x4*)(rowp + 4) = acc[ai][0][m][1];
                }
        }
    }
};
struct EpiRes {
    static constexpr bool PERM = false, AFTER_DRAIN = false;
    const float* res_p; const float* res_s;
    float* H; bf16* HB; float* SS;
    __device__ __forceinline__ void operator()(const f32x4 (&acc)[2][2][4][2], const Unit& u, int wr, int wc, int fr, int fq) const {
        const int row0 = u.pm * 256 + wr * 64 + fr, col0 = u.pn * 256 + wc * 32 + 4 * fq;
        const float* rbase = (u.pm < TP / 256) ? res_p : res_s - (size_t)TP * 1024;
#pragma unroll
        for (int ai = 0; ai < 2; ++ai)
#pragma unroll
            for (int m = 0; m < 4; ++m) {
                const int row = row0 + ai * 128 + m * 16;
                float ssq = 0.f;
#pragma unroll
                for (int bj = 0; bj < 2; ++bj)
#pragma unroll
                    for (int n = 0; n < 2; ++n) {
                        const size_t off = (size_t)row * 1024 + col0 + bj * 128 + n * 16;
                        const f32x4 r = *(const f32x4*)(rbase + off);
                        const f32x4 v = acc[ai][bj][m][n] + r;
                        *(f32x4*)(H + off) = v;
                        u32x2 w; w.x = pack2(v[0], v[1]); w.y = pack2(v[2], v[3]);
                        *(u32x2*)(HB + off) = w;
                        ssq += v[0] * v[0] + v[1] * v[1] + v[2] * v[2] + v[3] * v[3];
                    }
                ssq += __shfl_xor(ssq, 16); ssq += __shfl_xor(ssq, 32);
                if (fq == 0) atomicAdd(SS + row, ssq);
            }
    }
};
struct EpiScale {
    static constexpr bool PERM = true, AFTER_DRAIN = false;
    bf16* O; int ldc; const float* SS; float extra;
    __device__ __forceinline__ void operator()(const f32x4 (&acc)[2][2][4][2], const Unit& u, int wr, int wc, int fr, int fq) const {
        const int row0 = u.pm * 256 + wr * 64 + fr, col0 = u.pn * 256 + wc * 32 + 8 * fq;
#pragma unroll
        for (int ai = 0; ai < 2; ++ai)
#pragma unroll
            for (int m = 0; m < 4; ++m) {
                const int row = row0 + ai * 128 + m * 16;
                const float s = rsqrtf(SS[row] * (1.0f / 1024.0f) + 1e-6f) * extra;
                bf16* rowp = O + (size_t)row * ldc + col0;
#pragma unroll
                for (int bj = 0; bj < 2; ++bj) {
                    const f32x4 v0 = acc[ai][bj][m][0] * s, v1 = acc[ai][bj][m][1] * s;
                    u32x4 w; w.x = pack2(v0[0], v0[1]); w.y = pack2(v0[2], v0[3]); w.z = pack2(v1[0], v1[1]); w.w = pack2(v1[2], v1[3]);
                    *(u32x4*)(rowp + bj * 128) = w;
                }
            }
    }
};
struct EpiMkv {
    static constexpr bool PERM = false, AFTER_DRAIN = false;
    float* OK; float* OV; bf16* KB; bf16* VB;
    __device__ __forceinline__ void operator()(const f32x4 (&acc)[2][2][4][2], const Unit& u, int wr, int wc, int fr, int fq) const {
        const int row0 = u.pm * 256 + wr * 64 + fr;
        const bool isv = u.pn >= 4;
        const int col0 = (u.pn & 3) * 256 + wc * 32 + 4 * fq;
        float* Of = isv ? OV : OK; bf16* Ob = isv ? VB : KB;
#pragma unroll
        for (int ai = 0; ai < 2; ++ai)
#pragma unroll
            for (int m = 0; m < 4; ++m) {
                const int row = row0 + ai * 128 + m * 16;
#pragma unroll
                for (int bj = 0; bj < 2; ++bj)
#pragma unroll
                    for (int n = 0; n < 2; ++n) {
                        const size_t off = (size_t)row * 1024 + col0 + bj * 128 + n * 16;
                        const f32x4 v = acc[ai][bj][m][n];
                        *(f32x4*)(Of + off) = v;
                        u32x2 w; w.x = pack2(v[0], v[1]); w.y = pack2(v[2], v[3]);
                        *(u32x2*)(Ob + off) = w;
                    }
            }
    }
};

template <class Epi>
__device__ __forceinline__ void run_gemm(LAS unsigned char* lds, const bf16* A, const bf16* Bt, int M, int N, int K, const Epi& E, int rot = 0) {
    pg8::Gemm g{A, Bt, M, N, K};
    const int G = (int)gridDim.x;
    pg8::StaticOrder S; S.init(M, N, G, ((int)blockIdx.x + G - (rot % G)) % G);
    pg8::gemm_phase<Epi, pg8::StaticOrder, false>(lds, g, S, E, nullptr);
}


typedef short bf16x8 __attribute__((ext_vector_type(8)));
typedef short s16x4 __attribute__((ext_vector_type(4)));

__device__ __forceinline__ bf16x8 pack8(const f32x4& a, const f32x4& b) {
    u32x4 w; w.x = pack2(a[0], a[1]); w.y = pack2(a[2], a[3]); w.z = pack2(b[0], b[1]); w.w = pack2(b[2], b[3]);
    return __builtin_bit_cast(bf16x8, w);
}
__device__ __forceinline__ bf16x8 ldsB_tr(const LAS unsigned char* base, int stride, int k0, int n0, int r, int q) {
    const LAS unsigned char* a0 = base + (k0 + 8 * q + (r >> 2)) * stride + (n0 + 4 * (r & 3)) * 2;
    const s16x4 lo = __builtin_amdgcn_ds_read_tr16_b64_v4i16((LAS s16x4*)a0);
    const s16x4 hi = __builtin_amdgcn_ds_read_tr16_b64_v4i16((LAS s16x4*)(a0 + 4 * stride));
    bf16x8 o; o[0] = lo[0]; o[1] = lo[1]; o[2] = lo[2]; o[3] = lo[3]; o[4] = hi[0]; o[5] = hi[1]; o[6] = hi[2]; o[7] = hi[3];
    return o;
}

constexpr int AT_KS = 272, AT_VS = 288, AT_BUF = 256 * 288;

template <bool F32>
__device__ __forceinline__ void at_stage_half(const void* src, int hh, LAS unsigned char* buf, int stride) {
    const int tid = tidx();
#pragma unroll
    for (int pass = 0; pass < 8; ++pass) {
        const int row = pass * 32 + (tid >> 4), c = tid & 15;
        u32x4 w;
        if (F32) {
            const float* s = (const float*)src + (size_t)row * 1024 + hh * 128 + c * 8;
            const float4 a = *(const float4*)s, b = *(const float4*)(s + 4);
            w.x = pack2(a.x, a.y); w.y = pack2(a.z, a.w); w.z = pack2(b.x, b.y); w.w = pack2(b.z, b.w);
        } else {
            w = *(const u32x4*)((const bf16*)src + (size_t)row * 1024 + hh * 128 + c * 8);
        }
        *(LAS u32x4*)(buf + row * stride + c * 16) = w;
    }
}

__device__ __forceinline__ void attn_phase(const Params& p, LAS unsigned char* lds) {
    unsigned char* ws = p.ws;
    const bf16* QB = (const bf16*)(ws + WS_QB);
    bf16* OB = (bf16*)(ws + WS_OB);
    const int tid = tidx(), lane = tid & 63, wv = tid >> 6, r = lane & 15, q = lane >> 4;
    LAS unsigned char* buf0 = lds;
    LAS unsigned char* buf1 = lds + AT_BUF;
    const int nunits = 256 + 512;
    for (int u = blockIdx.x; u < nunits; u += gridDim.x) {
        int t0, ntok, h; const void* Ksrc; const void* Vsrc; bool f32src;
        if (u < 256) { const int b = u >> 5; h = (u >> 3) & 3; const int tt = u & 7; t0 = b * SEQ + tt * 256; ntok = 256; f32src = false;
            Ksrc = (const bf16*)(ws + WS_MKB) + (size_t)b * 256 * 1024 + h * 256; Vsrc = (const bf16*)(ws + WS_MVB) + (size_t)b * 256 * 1024 + h * 256; }
        else { const int su = u - 256; const int b = su >> 2; h = su & 3; t0 = TP + b * DECS; ntok = DECS; f32src = true;
            Ksrc = p.in[6] + (size_t)b * 256 * 1024 + h * 256; Vsrc = p.in[7] + (size_t)b * 256 * 1024 + h * 256; }
        const int ntiles = (ntok == 256) ? 2 : (wv == 0 ? 1 : 0);
        __syncthreads();
        if (f32src) { at_stage_half<true>(Ksrc, 0, buf0, AT_KS); at_stage_half<true>(Ksrc, 1, buf1, AT_KS); }
        else { at_stage_half<false>(Ksrc, 0, buf0, AT_KS); at_stage_half<false>(Ksrc, 1, buf1, AT_KS); }
        __syncthreads();
        bf16x8 pf[2][8];
#pragma unroll
        for (int tile = 0; tile < 2; ++tile) {
#pragma unroll
            for (int s = 0; s < 8; ++s) pf[tile][s] = (bf16x8){0, 0, 0, 0, 0, 0, 0, 0};
            if (tile < ntiles) {
                const int tl = (ntok == 256 ? wv * 32 : 0) + tile * 16 + r;
                const int tq = t0 + (tl < ntok ? tl : ntok - 1);
                bf16x8 qf[8];
#pragma unroll
                for (int ks = 0; ks < 8; ++ks) qf[ks] = *(const bf16x8*)(QB + (size_t)tq * 1024 + h * 256 + 32 * ks + 8 * q);
                f32x4 acc[16];
#pragma unroll
                for (int mt = 0; mt < 16; ++mt) acc[mt] = (f32x4){0.f, 0.f, 0.f, 0.f};
#pragma unroll
                for (int ks = 0; ks < 8; ++ks) {
                    const LAS unsigned char* kb = (ks < 4 ? buf0 : buf1) + (32 * (ks & 3) + 8 * q) * 2;
#pragma unroll
                    for (int mt = 0; mt < 16; ++mt) {
                        const bf16x8 a = *(const LAS bf16x8*)(kb + (16 * mt + r) * AT_KS);
                        acc[mt] = __builtin_amdgcn_mfma_f32_16x16x32_bf16(a, qf[ks], acc[mt], 0, 0, 0);
                    }
                }
                float mx = -3.0e38f;
#pragma unroll
                for (int mt = 0; mt < 16; ++mt) mx = fmaxf(fmaxf(fmaxf(acc[mt][0], acc[mt][1]), fmaxf(acc[mt][2], acc[mt][3])), mx);
                mx = fmaxf(mx, __shfl_xor(mx, 16)); mx = fmaxf(mx, __shfl_xor(mx, 32));
                float sum = 0.f;
#pragma unroll
                for (int mt = 0; mt < 16; ++mt)
#pragma unroll
                    for (int j = 0; j < 4; ++j) { const float e = __expf(acc[mt][j] - mx); acc[mt][j] = e; sum += e; }
                sum += __shfl_xor(sum, 16); sum += __shfl_xor(sum, 32);
                const float inv = 1.0f / sum;
#pragma unroll
                for (int s = 0; s < 8; ++s) pf[tile][s] = pack8(acc[2 * s] * inv, acc[2 * s + 1] * inv);
            }
        }
        __syncthreads();
        if (f32src) { at_stage_half<true>(Vsrc, 0, buf0, AT_VS); at_stage_half<true>(Vsrc, 1, buf1, AT_VS); }
        else { at_stage_half<false>(Vsrc, 0, buf0, AT_VS); at_stage_half<false>(Vsrc, 1, buf1, AT_VS); }
        __syncthreads();
#pragma unroll
        for (int tile = 0; tile < 2; ++tile) {
            if (tile < ntiles) {
                const int tl0 = (ntok == 256 ? wv * 32 : 0) + tile * 16;
#pragma unroll
                for (int half = 0; half < 2; ++half) {
                    f32x4 o[8];
#pragma unroll
                    for (int dt = 0; dt < 8; ++dt) o[dt] = (f32x4){0.f, 0.f, 0.f, 0.f};
                    const LAS unsigned char* vb = half ? buf1 : buf0;
#pragma unroll
                    for (int s = 0; s < 8; ++s) {
#pragma unroll
                        for (int dt = 0; dt < 8; ++dt) {
                            const LAS unsigned char* a0 = vb + (32 * s + 4 * q + (r >> 2)) * AT_VS + (16 * dt + 4 * (r & 3)) * 2;
                            const s16x4 lo = __builtin_amdgcn_ds_read_tr16_b64_v4i16((LAS s16x4*)a0);
                            const s16x4 hi = __builtin_amdgcn_ds_read_tr16_b64_v4i16((LAS s16x4*)(a0 + 16 * AT_VS));
                            bf16x8 bfr; bfr[0] = lo[0]; bfr[1] = lo[1]; bfr[2] = lo[2]; bfr[3] = lo[3]; bfr[4] = hi[0]; bfr[5] = hi[1]; bfr[6] = hi[2]; bfr[7] = hi[3];
                            o[dt] = __builtin_amdgcn_mfma_f32_16x16x32_bf16(pf[tile][s], bfr, o[dt], 0, 0, 0);
                        }
                    }
#pragma unroll
                    for (int dt = 0; dt < 8; ++dt)
#pragma unroll
                        for (int j = 0; j < 4; ++j) {
                            const int tl = tl0 + 4 * q + j;
                            if (tl < ntok) OB[(size_t)(t0 + tl) * 1024 + h * 256 + half * 128 + 16 * dt + r] = f2bf(o[dt][j]);
                        }
                }
            }
        }
    }
}

constexpr int PE_TOK = 68;
constexpr int PE_KSTR = 272;
constexpr int PE_SUBK = 0;
constexpr int PE_SELI = 0, PE_SELG = PE_TOK * 128 * 4;
constexpr int PE_TOP = 69632;
constexpr int PE_PT = PE_TOP + PE_TOK * 8 * 33 * 4;

template <int CTRL> __device__ __forceinline__ float dppf(float v) { return __int_as_float(__builtin_amdgcn_update_dpp(0, __float_as_int(v), CTRL, 0xF, 0xF, true)); }
__device__ __forceinline__ float wave_sum_u(float v) {
    v += dppf<0xB1>(v); v += dppf<0x4E>(v); v += dppf<0x141>(v); v += dppf<0x140>(v);
    const float a = __int_as_float(__builtin_amdgcn_readlane(__float_as_int(v), 0)), b = __int_as_float(__builtin_amdgcn_readlane(__float_as_int(v), 16));
    const float c = __int_as_float(__builtin_amdgcn_readlane(__float_as_int(v), 32)), d = __int_as_float(__builtin_amdgcn_readlane(__float_as_int(v), 48));
    return (a + b) + (c + d);
}
typedef __bf16 bf16x2v __attribute__((ext_vector_type(2)));
__device__ __forceinline__ float dot2bf(unsigned a, unsigned b, float acc) {
    return __builtin_amdgcn_fdot2_f32_bf16(__builtin_bit_cast(bf16x2v, a), __builtin_bit_cast(bf16x2v, b), acc, false);
}
__device__ __forceinline__ float gelu_erf(float x) { return 0.5f * x * (1.0f + erff(x * 0.70710678118654752f)); }

__device__ __forceinline__ void peer_select_phase(const Params& p, LAS unsigned char* lds) {
    unsigned char* ws = p.ws;
    const bf16* PQB = (const bf16*)(ws + WS_PQB);
    const bf16* SUBK = (const bf16*)(ws + WS_SUBK);
    const bf16* PU = (const bf16*)(ws + WS_PU);
    const bf16* PVt = (const bf16*)(ws + WS_PV);
    const float* H = (const float*)(ws + WS_H);
    const float* SS2 = (const float*)(ws + WS_CTL + CTL_SS2);
    const float* gffn = p.in[27]; const float* gfin = p.in[32];
    float* Y = p.out + O_Y;
    const int tid = tidx(), lane = tid & 63, wv = tid >> 6, r = lane & 15, q = lane >> 4;
    LAS float* TOP = (LAS float*)(lds + PE_TOP);
    unsigned short* GSELI = (unsigned short*)(ws + WS_SELI);
    float* GSELG = (float*)(ws + WS_SELG);
    LAS unsigned char* PT = lds + PE_PT;

    for (int chunk = blockIdx.x; chunk < T / PE_TOK; chunk += gridDim.x) {
        const int tok0 = chunk * PE_TOK;
        __syncthreads();
#pragma unroll
        for (int i = 0; i < 8; ++i) {
            const int e = tid + i * NT, row = e >> 4, c16 = e & 15;
            *(LAS u32x4*)(lds + PE_SUBK + row * PE_KSTR + c16 * 16) = *(const u32x4*)(SUBK + (size_t)row * 128 + c16 * 8);
        }
        if (tid < 64) {
            int i = 0, base = 0, k = tid;
            if (k < 50) { while (k - base >= 16 / (i + 1)) { base += 16 / (i + 1); ++i; } PT[k] = (unsigned char)((i << 4) | (k - base)); }
            else PT[k] = 0;
        }
        __syncthreads();
        {
            const int h = wv;
            for (int nt = 0; nt < 5; ++nt) {
                const int tl = nt * 16 + r;
                const int t = tok0 + (tl < PE_TOK ? tl : PE_TOK - 1);
#pragma unroll
                for (int c = 0; c < 2; ++c) {
                    bf16x8 qf[4];
#pragma unroll
                    for (int ks = 0; ks < 4; ++ks) qf[ks] = *(const bf16x8*)(PQB + (size_t)t * 2048 + h * 256 + c * 128 + 32 * ks + 8 * q);
                    f32x4 acc[8];
#pragma unroll
                    for (int mt = 0; mt < 8; ++mt) acc[mt] = (f32x4){0.f, 0.f, 0.f, 0.f};
#pragma unroll
                    for (int ks = 0; ks < 4; ++ks)
#pragma unroll
                        for (int mt = 0; mt < 8; ++mt) {
                            const bf16x8 a = *(const LAS bf16x8*)(lds + PE_SUBK + (c * 128 + 16 * mt + r) * PE_KSTR + (32 * ks + 8 * q) * 2);
                            acc[mt] = __builtin_amdgcn_mfma_f32_16x16x32_bf16(a, qf[ks], acc[mt], 0, 0, 0);
                        }
                    float v[32];
#pragma unroll
                    for (int mt = 0; mt < 8; ++mt)
#pragma unroll
                        for (int j = 0; j < 4; ++j) v[mt * 4 + j] = __uint_as_float((__float_as_uint(acc[mt][j]) & ~127u) | (unsigned)(16 * mt + 4 * q + j));
                    float top[16];
#pragma unroll
                    for (int rd = 0; rd < 16; ++rd) {
                        float m = v[0];
#pragma unroll
                        for (int i = 1; i < 32; ++i) m = fmaxf(m, v[i]);
                        m = fmaxf(m, __shfl_xor(m, 16)); m = fmaxf(m, __shfl_xor(m, 32));
                        top[rd] = m;
#pragma unroll
                        for (int i = 0; i < 32; ++i) v[i] = (v[i] == m) ? -3.0e38f : v[i];
                    }
                    if (q == 0 && tl < PE_TOK) {
                        LAS float* dst = TOP + (tl * 8 + h) * 33 + c * 16;
#pragma unroll
                        for (int i = 0; i < 16; ++i) dst[i] = top[i];
                    }
                }
            }
        }
        __syncthreads();
        for (int pr = tid; pr < PE_TOK * 8; pr += NT) {
            const LAS float* tp = TOP + pr * 33;
            float A[16], B[16];
#pragma unroll
            for (int i = 0; i < 16; ++i) { A[i] = tp[i]; B[i] = tp[16 + i]; }
            float cd[50];
            {
                int k = 0;
#pragma unroll
                for (int i = 0; i < 16; ++i)
#pragma unroll
                    for (int j = 0; j < 16; ++j)
                        if ((i + 1) * (j + 1) <= 16) { cd[k] = __uint_as_float((__float_as_uint(A[i] + B[j]) & ~63u) | (unsigned)k); ++k; }
            }
            float win[16];
#pragma unroll
            for (int rd = 0; rd < 16; ++rd) {
                float m = cd[0];
#pragma unroll
                for (int i = 1; i < 50; ++i) m = fmaxf(m, cd[i]);
                win[rd] = m;
#pragma unroll
                for (int i = 0; i < 50; ++i) cd[i] = (cd[i] == m) ? -3.0e38f : cd[i];
            }
            float e[16], sum = 0.f;
#pragma unroll
            for (int rd = 0; rd < 16; ++rd) { e[rd] = __expf(win[rd] - win[0]); sum += e[rd]; }
            const float inv = 1.0f / sum;
            const int tl = pr >> 3, h = pr & 7;
#pragma unroll
            for (int rd = 0; rd < 16; ++rd) {
                const unsigned k = __float_as_uint(win[rd]) & 63u;
                const unsigned ij = PT[k];
                const unsigned ka = __float_as_uint(tp[ij >> 4]) & 127u, kb = __float_as_uint(tp[16 + (ij & 15)]) & 127u;
                GSELI[(size_t)(tok0 + tl) * 128 + h * 16 + rd] = (unsigned short)(ka * 128u + kb);
                GSELG[(size_t)(tok0 + tl) * 128 + h * 16 + rd] = e[rd] * inv;
            }
        }
        __syncthreads();
    }
}

constexpr float PE_USCALE = 64.0f, PE_VSCALE = 8.0f;
typedef float f32x2 __attribute__((ext_vector_type(2)));

__device__ __forceinline__ void cvt_peer_tables(const float* __restrict__ src, unsigned char* __restrict__ dst, float scale, int vb, int nvb) {
    const size_t npieces = (size_t)16384 * 64;
    for (size_t i = (size_t)vb * NT + tidx(); i < npieces; i += (size_t)nvb * NT) {
        const size_t e = i >> 6; const int cc = (int)(i & 63);
        const float4* s = (const float4*)(src + e * 1024 + cc * 16);
        const float4 a = s[0], b = s[1], c = s[2], d = s[3];
        u32x4 w;
        int t = 0;
        t = __builtin_amdgcn_cvt_pk_fp8_f32(a.x * scale, a.y * scale, t, false); t = __builtin_amdgcn_cvt_pk_fp8_f32(a.z * scale, a.w * scale, t, true); w.x = (unsigned)t;
        t = __builtin_amdgcn_cvt_pk_fp8_f32(b.x * scale, b.y * scale, t, false); t = __builtin_amdgcn_cvt_pk_fp8_f32(b.z * scale, b.w * scale, t, true); w.y = (unsigned)t;
        t = __builtin_amdgcn_cvt_pk_fp8_f32(c.x * scale, c.y * scale, t, false); t = __builtin_amdgcn_cvt_pk_fp8_f32(c.z * scale, c.w * scale, t, true); w.z = (unsigned)t;
        t = __builtin_amdgcn_cvt_pk_fp8_f32(d.x * scale, d.y * scale, t, false); t = __builtin_amdgcn_cvt_pk_fp8_f32(d.z * scale, d.w * scale, t, true); w.w = (unsigned)t;
        *(u32x4*)(dst + ((size_t)(cc >> 3) * 16384 + e) * 128 + 16 * (cc & 7)) = w;
    }
}
__device__ __forceinline__ void fp8x16_to_f32(const u32x4& w, float (&v)[16]) {
    const unsigned ww[4] = {w.x, w.y, w.z, w.w};
#pragma unroll
    for (int k = 0; k < 4; ++k) {
        const f32x2 lo = __builtin_amdgcn_cvt_pk_f32_fp8((int)ww[k], false), hi = __builtin_amdgcn_cvt_pk_f32_fp8((int)ww[k], true);
        v[4 * k] = lo[0]; v[4 * k + 1] = lo[1]; v[4 * k + 2] = hi[0]; v[4 * k + 3] = hi[1];
    }
}
__device__ __forceinline__ void peer_part_rank(int& part, int& rank, int& nrank, int& npass) {
    const int G = gridDim.x;
    if ((G & 7) == 0) { part = blockIdx.x & 7; rank = blockIdx.x >> 3; nrank = G >> 3; npass = 1; }
    else { part = 0; rank = blockIdx.x; nrank = G; npass = 8; }
}

#define PE_WAIT_ALL() do { asm volatile("s_waitcnt vmcnt(0)" ::: "memory"); __builtin_amdgcn_sched_barrier(0); } while (0)
__device__ __forceinline__ void pe_issue_half(const unsigned char* tabu, const unsigned (&idx)[8], int h, LAS unsigned char* hb, int cb) {
#pragma unroll
    for (int i = 0; i < 4; ++i) {
        const unsigned w = idx[4 * h + i];
        __builtin_amdgcn_global_load_lds((const unsigned*)(tabu + (size_t)((w & 0xffffu) * 128u + 16u * cb)), (LAS unsigned*)(hb + (2 * i) * 1024), 16, 0, 0);
        __builtin_amdgcn_global_load_lds((const unsigned*)(tabu + (size_t)((w >> 16) * 128u + 16u * cb)), (LAS unsigned*)(hb + (2 * i + 1) * 1024), 16, 0, 0);
    }
}
__device__ __forceinline__ void pe_load_idx(const unsigned short* GSELI, int t, int rowi, unsigned (&idx)[8]) {
#pragma unroll
    for (int i = 0; i < 8; ++i) idx[i] = (unsigned)GSELI[(size_t)t * 128 + 16 * i + rowi] | ((unsigned)GSELI[(size_t)t * 128 + 16 * i + 8 + rowi] << 16);
}
__device__ __forceinline__ void fp8x16_to_f32x2(const u32x4& w, f32x2 (&v)[8]) {
    const unsigned ww[4] = {w.x, w.y, w.z, w.w};
#pragma unroll
    for (int k = 0; k < 4; ++k) { v[2 * k] = __builtin_amdgcn_cvt_pk_f32_fp8((int)ww[k], false); v[2 * k + 1] = __builtin_amdgcn_cvt_pk_f32_fp8((int)ww[k], true); }
}

__device__ __forceinline__ void peer_u_phase(const Params& p, LAS unsigned char* lds) {
    unsigned char* ws = p.ws;
    const unsigned char* UP = ws + WS_PU;
    const unsigned short* GSELI = (const unsigned short*)(ws + WS_SELI);
    float* PART = (float*)(ws + WS_PART);
    const float* H = (const float*)(ws + WS_H);
    const float* SS2 = (const float*)(ws + WS_CTL + CTL_SS2);
    const float* gffn = p.in[27];
    const int lane = tidx() & 63, wv = tidx() >> 6, rowi = lane >> 3, cb = lane & 7;
    LAS unsigned char* wb = lds + wv * 16384;
    int part0, rank, nrank, npass; peer_part_rank(part0, rank, nrank, npass);
    const int step = nrank * 8;
    for (int pass = 0; pass < npass; ++pass) {
        const int part = part0 + pass;
        const unsigned char* tabu = UP + (size_t)part * 16384 * 128;
        int t = rank * 8 + wv;
        if (t >= T) continue;
        unsigned idxA[8], idxB[8];
        pe_load_idx(GSELI, t, rowi, idxA);
        if (t + step < T) pe_load_idx(GSELI, t + step, rowi, idxB);
        pe_issue_half(tabu, idxA, 0, wb, cb);
        f32x2 xs[8];
#define PE_U_TOKEN(IDXC, IDXN) do { \
            { const float rstd2 = rsqrtf(SS2[t] * (1.0f / 1024.0f) + 1e-6f) * (1.0f / PE_USCALE); \
              _Pragma("unroll") for (int i = 0; i < 4; ++i) { const float4 h4 = *(const float4*)(H + (size_t)t * 1024 + 128 * part + 16 * cb + 4 * i); \
                const float4 g4 = *(const float4*)(gffn + 128 * part + 16 * cb + 4 * i); \
                xs[2 * i] = (f32x2){h4.x * rstd2 * g4.x, h4.y * rstd2 * g4.y}; xs[2 * i + 1] = (f32x2){h4.z * rstd2 * g4.z, h4.w * rstd2 * g4.w}; } } \
            _Pragma("unroll") for (int h = 0; h < 2; ++h) { \
                PE_WAIT_ALL();                                               \
                if (h == 0) pe_issue_half(tabu, IDXC, 1, wb + 8192, cb); \
                else if (t + step < T) pe_issue_half(tabu, IDXN, 0, wb, cb); \
                __builtin_amdgcn_sched_barrier(0); \
                _Pragma("unroll") for (int i = 0; i < 8; ++i) { \
                    const u32x4 w = *(const LAS u32x4*)(wb + h * 8192 + i * 1024 + lane * 16); \
                    f32x2 v[8]; fp8x16_to_f32x2(w, v); \
                    f32x2 d2 = v[0] * xs[0]; \
                    _Pragma("unroll") for (int k = 1; k < 8; ++k) d2 = __builtin_elementwise_fma(v[k], xs[k], d2); \
                    float d = d2[0] + d2[1]; \
                    d += dppf<0xB1>(d); d += dppf<0x4E>(d); d += dppf<0x141>(d); \
                    if (cb == 0) PART[((size_t)part * T + t) * 128 + 8 * (8 * h + i) + rowi] = d; } \
                __builtin_amdgcn_sched_barrier(0); } \
            if (t + 2 * step < T) pe_load_idx(GSELI, t + 2 * step, rowi, IDXC); } while (0)
        for (;;) {
            PE_U_TOKEN(idxA, idxB);
            t += step; if (t >= T) break;
            PE_U_TOKEN(idxB, idxA);
            t += step; if (t >= T) break;
        }
#undef PE_U_TOKEN
        PE_WAIT_ALL();
    }
}

__device__ __forceinline__ void peer_v_phase(const Params& p, LAS unsigned char* lds) {
    unsigned char* ws = p.ws;
    const unsigned char* VP = ws + WS_PV;
    const unsigned short* GSELI = (const unsigned short*)(ws + WS_SELI);
    const float* GSELG = (const float*)(ws + WS_SELG);
    const float* PART = (const float*)(ws + WS_PART);
    float* H = (float*)(ws + WS_H);
    float* SS3 = (float*)(ws + WS_CTL + CTL_SS3);
    const int lane = tidx() & 63, wv = tidx() >> 6, rowi = lane >> 3, cb = lane & 7;
    LAS unsigned char* wb = lds + wv * 16384;
    LAS float* cw = (LAS float*)(lds + 8 * 16384) + wv * 128;
    int part0, rank, nrank, npass; peer_part_rank(part0, rank, nrank, npass);
    const int step = nrank * 8;
    for (int pass = 0; pass < npass; ++pass) {
        const int part = part0 + pass;
        const unsigned char* tabu = VP + (size_t)part * 16384 * 128;
        int t = rank * 8 + wv;
        if (t >= T) continue;
        unsigned idxA[8], idxB[8];
        pe_load_idx(GSELI, t, rowi, idxA);
        if (t + step < T) pe_load_idx(GSELI, t + step, rowi, idxB);
        pe_issue_half(tabu, idxA, 0, wb, cb);
        f32x2 acc[8];
#define PE_V_TOKEN(IDXC, IDXN) do { \
            _Pragma("unroll") for (int hh = 0; hh < 2; ++hh) { \
                const int e = lane + 64 * hh; \
                float s = 0.f; \
                _Pragma("unroll") for (int pp = 0; pp < 8; ++pp) s += PART[((size_t)pp * T + t) * 128 + e]; \
                cw[e] = GSELG[(size_t)t * 128 + e] * gelu_erf(s) * (1.0f / PE_VSCALE); } \
            _Pragma("unroll") for (int k = 0; k < 8; ++k) acc[k] = (f32x2){0.f, 0.f}; \
            _Pragma("unroll") for (int h = 0; h < 2; ++h) { \
                PE_WAIT_ALL(); \
                if (h == 0) pe_issue_half(tabu, IDXC, 1, wb + 8192, cb); \
                else if (t + step < T) pe_issue_half(tabu, IDXN, 0, wb, cb); \
                __builtin_amdgcn_sched_barrier(0); \
                _Pragma("unroll") for (int i = 0; i < 8; ++i) { \
                    const u32x4 w = *(const LAS u32x4*)(wb + h * 8192 + i * 1024 + lane * 16); \
                    const float c = cw[8 * (8 * h + i) + rowi]; const f32x2 c2 = (f32x2){c, c}; \
                    f32x2 v[8]; fp8x16_to_f32x2(w, v); \
                    _Pragma("unroll") for (int k = 0; k < 8; ++k) acc[k] = __builtin_elementwise_fma(v[k], c2, acc[k]); } \
                __builtin_amdgcn_sched_barrier(0); } \
            _Pragma("unroll") for (int k = 0; k < 8; ++k) { \
                acc[k][0] += __shfl_xor(acc[k][0], 8); acc[k][1] += __shfl_xor(acc[k][1], 8); \
                acc[k][0] += __shfl_xor(acc[k][0], 16); acc[k][1] += __shfl_xor(acc[k][1], 16); \
                acc[k][0] += __shfl_xor(acc[k][0], 32); acc[k][1] += __shfl_xor(acc[k][1], 32); } \
            float ss = 0.f; \
            if (rowi == 0) { \
                float* hp = H + (size_t)t * 1024 + 128 * part + 16 * cb; \
                _Pragma("unroll") for (int i = 0; i < 4; ++i) { \
                    float4 h4 = *(const float4*)(hp + 4 * i); \
                    h4.x += acc[2 * i][0]; h4.y += acc[2 * i][1]; h4.z += acc[2 * i + 1][0]; h4.w += acc[2 * i + 1][1]; \
                    ss += h4.x * h4.x + h4.y * h4.y + h4.z * h4.z + h4.w * h4.w; \
                    *(float4*)(hp + 4 * i) = h4; } } \
            ss += dppf<0xB1>(ss); ss += dppf<0x4E>(ss); ss += dppf<0x141>(ss); \
            if (lane == 0) atomicAdd(SS3 + t, ss); \
            if (t + 2 * step < T) pe_load_idx(GSELI, t + 2 * step, rowi, IDXC); } while (0)
        for (;;) {
            PE_V_TOKEN(idxA, idxB);
            t += step; if (t >= T) break;
            PE_V_TOKEN(idxB, idxA);
            t += step; if (t >= T) break;
        }
#undef PE_V_TOKEN
        PE_WAIT_ALL();
    }
}

__device__ __forceinline__ void final_norm_phase(const Params& p) {
    const float* H = (const float*)(p.ws + WS_H);
    const float* SS3 = (const float*)(p.ws + WS_CTL + CTL_SS3);
    const float* gfin = p.in[32];
    float* Y = p.out + O_Y;
    const int lane = tidx() & 63, wv = tidx() >> 6;
    for (int t = blockIdx.x * 8 + wv; t < T; t += gridDim.x * 8) {
        const float rs = rsqrtf(SS3[t] * (1.0f / 1024.0f) + 1e-6f);
#pragma unroll
        for (int i = 0; i < 4; ++i) {
            const float4 h4 = ((const float4*)(H + (size_t)t * 1024))[lane + 64 * i], g4 = ((const float4*)gfin)[lane + 64 * i];
            float4 o; o.x = h4.x * rs * g4.x; o.y = h4.y * rs * g4.y; o.z = h4.z * rs * g4.z; o.w = h4.w * rs * g4.w;
            ((float4*)(Y + (size_t)t * 1024))[lane + 64 * i] = o;
        }
    }
}


__device__ __forceinline__ bf16x8 frag_tr(const LAS unsigned char* base, int stride, int k0, int n0, int r, int q) {
    const LAS unsigned char* a0 = base + (k0 + 4 * q + (r >> 2)) * stride + (n0 + 4 * (r & 3)) * 2;
    const s16x4 lo = __builtin_amdgcn_ds_read_tr16_b64_v4i16((LAS s16x4*)a0);
    const s16x4 hi = __builtin_amdgcn_ds_read_tr16_b64_v4i16((LAS s16x4*)(a0 + 16 * stride));
    bf16x8 o; o[0] = lo[0]; o[1] = lo[1]; o[2] = lo[2]; o[3] = lo[3]; o[4] = hi[0]; o[5] = hi[1]; o[6] = hi[2]; o[7] = hi[3];
    return o;
}
__device__ __forceinline__ bf16x8 frag_kc_pk(const LAS unsigned char* base, int stride, int m0, int k0, int r, int q) {
    const LAS unsigned char* a0 = base + (m0 + r) * stride + (k0 + 4 * q) * 2;
    const u32x2 lo = *(const LAS u32x2*)a0, hi = *(const LAS u32x2*)(a0 + 32);
    u32x4 w; w.x = lo.x; w.y = lo.y; w.z = hi.x; w.w = hi.y;
    return __builtin_bit_cast(bf16x8, w);
}
__device__ __forceinline__ bf16x8 frag_kc(const LAS unsigned char* base, int stride, int m0, int k0, int r, int q) {
    return *(const LAS bf16x8*)(base + (m0 + r) * stride + (k0 + 8 * q) * 2);
}
__device__ __forceinline__ float softplus_f(float x) { return x > 20.f ? x : log1pf(__expf(x)); }
__device__ __forceinline__ float silu_f(float x) { return x * __builtin_amdgcn_rcpf(1.0f + __expf(-x)); }


__device__ __forceinline__ void ssd_conv_prepass(const Params& p, bf16* XBCA) {
    const bf16* PROJB = (const bf16*)(p.ws + WS_PROJB);
    const float* conv_w = p.in[15]; const float* conv_b = p.in[16];
    const int npieces = T * 192;
    for (int e = blockIdx.x * NT + tidx(); e < npieces; e += gridDim.x * NT) {
        const int t = e / 192, pc = e - t * 192, col = pc * 8;
        int l, t0; const float* hist;
        if (t < TP) { l = t & (SEQ - 1); t0 = t - l; hist = nullptr; }
        else { const int b = (t - TP) / DECS; l = (t - TP) - b * DECS; t0 = t - l; hist = p.in[4] + (size_t)b * 3 * SSM_XBC; }
        float acc[8];
        { const float4 b0 = *(const float4*)(conv_b + col), b1 = *(const float4*)(conv_b + col + 4);
          acc[0] = b0.x; acc[1] = b0.y; acc[2] = b0.z; acc[3] = b0.w; acc[4] = b1.x; acc[5] = b1.y; acc[6] = b1.z; acc[7] = b1.w; }
#pragma unroll
        for (int tp = 0; tp < 4; ++tp) {
            const int ls = l - 3 + tp;
            float xv[8];
            if (ls >= 0) {
                const u32x4 rv = *(const u32x4*)(PROJB + (size_t)(t0 + ls) * PROJW + 3072 + col);
                xv[0] = __uint_as_float(rv.x << 16); xv[1] = __uint_as_float(rv.x & 0xffff0000u); xv[2] = __uint_as_float(rv.y << 16); xv[3] = __uint_as_float(rv.y & 0xffff0000u);
                xv[4] = __uint_as_float(rv.z << 16); xv[5] = __uint_as_float(rv.z & 0xffff0000u); xv[6] = __uint_as_float(rv.w << 16); xv[7] = __uint_as_float(rv.w & 0xffff0000u);
            } else if (hist) {
                const float* s = hist + (size_t)(3 + ls) * SSM_XBC + col;
                const float4 a = *(const float4*)s, bb = *(const float4*)(s + 4);
                xv[0] = bf2f(f2bf(a.x)); xv[1] = bf2f(f2bf(a.y)); xv[2] = bf2f(f2bf(a.z)); xv[3] = bf2f(f2bf(a.w));
                xv[4] = bf2f(f2bf(bb.x)); xv[5] = bf2f(f2bf(bb.y)); xv[6] = bf2f(f2bf(bb.z)); xv[7] = bf2f(f2bf(bb.w));
            } else {
#pragma unroll
                for (int k = 0; k < 8; ++k) xv[k] = 0.f;
            }
            const float4 w0 = *(const float4*)(conv_w + tp * SSM_XBC + col), w1 = *(const float4*)(conv_w + tp * SSM_XBC + col + 4);
            acc[0] += w0.x * xv[0]; acc[1] += w0.y * xv[1]; acc[2] += w0.z * xv[2]; acc[3] += w0.w * xv[3];
            acc[4] += w1.x * xv[4]; acc[5] += w1.y * xv[5]; acc[6] += w1.z * xv[6]; acc[7] += w1.w * xv[7];
        }
        u32x4 o; o.x = pack2(silu_f(acc[0]), silu_f(acc[1])); o.y = pack2(silu_f(acc[2]), silu_f(acc[3])); o.z = pack2(silu_f(acc[4]), silu_f(acc[5])); o.w = pack2(silu_f(acc[6]), silu_f(acc[7]));
        *(u32x4*)(XBCA + (size_t)t * SSM_XBC + col) = o;
    }
}

__device__ __forceinline__ void ssd_scalar_prepass(const Params& p, float* SCAL) {
    const float* SMALL = (const float*)(p.ws + WS_SMALL);
    const int lane = tidx() & 63, wv = tidx() >> 6;
    for (int task = blockIdx.x * 8 + wv; task < (256 + 128) * 16; task += gridDim.x * 8) {
        const int cg = task >> 4, head = task & 15;
        const int t0 = cg < 256 ? cg * 64 : TP + (cg - 256) * DECS, nvalid = cg < 256 ? 64 : DECS;
        const bool valid = lane < nvalid;
        const float Ah = -__expf(p.in[17][head]), dtb = p.in[18][head];
        const float dt = valid ? softplus_f(SMALL[(size_t)(t0 + (valid ? lane : 0)) * 32 + 16 + head] + dtb) : 0.f;
        float acs = dt * Ah;
#pragma unroll
        for (int o = 1; o < 64; o <<= 1) { const float up = __shfl_up(acs, o); if (lane >= o) acs += up; }
        const float last = __shfl(acs, 63);
        float* dst = SCAL + (size_t)task * 256;
        dst[lane] = dt; dst[64 + lane] = acs; dst[128 + lane] = dt * __expf(last - acs); dst[192 + lane] = __expf(acs);
    }
}

constexpr int SD_XS = 160, SD_BS = 288, SD_CS = 272, SD_ZS = 144, SD_SS = 160;
constexpr int SD_XN = 0;
constexpr int SD_XW = SD_XN + 64 * 160;
constexpr int SD_BN = SD_XW + 64 * 160;
constexpr int SD_CN = SD_BN + 64 * 288;
constexpr int SD_ZN = SD_CN + 64 * 272;
constexpr int SD_SC = SD_ZN + 64 * 144;
constexpr int SD_TBUF = SD_SC + 1024;
constexpr int SD_ST = 2 * SD_TBUF;
constexpr int SD_END = SD_ST + 128 * 160;
static_assert(SD_END <= LDS_MISC, "SSD LDS budget");

__device__ __forceinline__ void ssd_load_chunk(const Params& p, const bf16* XBCA, const float* SCAL, u32x4 (&rg)[5], u32x4& rz, float& rs, float& rw, int c, int cg, int head, int g, int t0, int nvalid) {
    const bf16* PROJB = (const bf16*)(p.ws + WS_PROJB);
    const int tid = tidx();
#pragma unroll
    for (int i = 0; i < 5; ++i) {
        const int e = tid + NT * i;
        int l, col;
        if (e < 512) { l = e >> 3; col = head * 64 + (e & 7) * 8; }
        else if (e < 1536) { l = (e - 512) >> 4; col = 1024 + g * 128 + ((e - 512) & 15) * 8; }
        else { l = (e - 1536) >> 4; col = 1280 + g * 128 + ((e - 1536) & 15) * 8; }
        rg[i] = (l < nvalid) ? *(const u32x4*)(XBCA + (size_t)(t0 + c * 64 + l) * SSM_XBC + col) : (u32x4){0u, 0u, 0u, 0u};
    }
    { const int l = tid >> 3; rz = (l < nvalid) ? *(const u32x4*)(PROJB + (size_t)(t0 + c * 64 + l) * PROJW + 5632 + head * 64 + (tid & 7) * 8) : (u32x4){0u, 0u, 0u, 0u}; }
    const float* sp = SCAL + ((size_t)cg * 16 + head) * 256;
    rs = sp[tid & 255]; rw = sp[128 + (tid >> 3)];
}

template <bool YGF32>
__device__ __forceinline__ void ssd_stream(const Params& p, LAS unsigned char* lds, bool prompt, int b, int head, void* YG, const bf16* XBCA, const float* SCAL) {
    const int tid = tidx(), lane = tid & 63, wv = tid >> 6, r = lane & 15, q = lane >> 4;
    const int g = head >> 3;
    const int nchunks = prompt ? 32 : 1, nvalid = prompt ? 64 : DECS, t0 = prompt ? b * SEQ : TP + b * DECS;
    const int cg0 = prompt ? b * 32 : 256 + b;
    const float Dh = p.in[19][head];

    const int pt_s = wv & 3, nh = wv >> 2;
    f32x4 Sacc[4];
#pragma unroll
    for (int i = 0; i < 4; ++i) {
        if (prompt) Sacc[i] = (f32x4){0.f, 0.f, 0.f, 0.f};
        else {
            const float* s0 = p.in[5] + (((size_t)b * 16 + head) * 64 + 16 * pt_s + 4 * q) * 128 + 16 * (4 * nh + i) + r;
            Sacc[i] = (f32x4){s0[0], s0[128], s0[256], s0[384]};
        }
    }
    u32x4 rg[5], rz; float rs, rw;
    ssd_load_chunk(p, XBCA, SCAL, rg, rz, rs, rw, 0, cg0, head, g, t0, nvalid);
    __syncthreads();
#pragma unroll
    for (int i = 0; i < 4; ++i) {
        u32x2 w; w.x = pack2(Sacc[i][0], Sacc[i][1]); w.y = pack2(Sacc[i][2], Sacc[i][3]);
        *(LAS u32x2*)(lds + SD_ST + (16 * (4 * nh + i) + r) * SD_SS + (16 * pt_s + 4 * q) * 2) = w;
    }
    for (int c = 0; c < nchunks; ++c) {
        LAS unsigned char* tb = lds + (c & 1) * SD_TBUF;
        LAS float* SC = (LAS float*)(tb + SD_SC);
#pragma unroll
        for (int i = 0; i < 5; ++i) {
            const int e = tid + NT * i;
            if (e < 512) *(LAS u32x4*)(tb + SD_XN + (e >> 3) * SD_XS + (e & 7) * 16) = rg[i];
            else if (e < 1536) *(LAS u32x4*)(tb + SD_BN + ((e - 512) >> 4) * SD_BS + ((e - 512) & 15) * 16) = rg[i];
            else *(LAS u32x4*)(tb + SD_CN + ((e - 1536) >> 4) * SD_CS + ((e - 1536) & 15) * 16) = rg[i];
        }
        *(LAS u32x4*)(tb + SD_ZN + (tid >> 3) * SD_ZS + (tid & 7) * 16) = rz;
        if (tid < 256) SC[tid] = rs;
        {
            const u32x4 xv = rg[0];
            u32x4 o2;
            o2.x = pack2(__uint_as_float(xv.x << 16) * rw, __uint_as_float(xv.x & 0xffff0000u) * rw); o2.y = pack2(__uint_as_float(xv.y << 16) * rw, __uint_as_float(xv.y & 0xffff0000u) * rw);
            o2.z = pack2(__uint_as_float(xv.z << 16) * rw, __uint_as_float(xv.z & 0xffff0000u) * rw); o2.w = pack2(__uint_as_float(xv.w << 16) * rw, __uint_as_float(xv.w & 0xffff0000u) * rw);
            *(LAS u32x4*)(tb + SD_XW + (tid >> 3) * SD_XS + (tid & 7) * 16) = o2;
        }
        if (c + 1 < nchunks) ssd_load_chunk(p, XBCA, SCAL, rg, rz, rs, rw, c + 1, cg0 + c + 1, head, g, t0, nvalid);
        __syncthreads();
        {
            const int lt = wv & 3, ph = wv >> 2;
            f32x4 Y[2] = {(f32x4){0.f, 0.f, 0.f, 0.f}, (f32x4){0.f, 0.f, 0.f, 0.f}};
#pragma unroll
            for (int ks = 0; ks < 4; ++ks) {
                const bf16x8 a = frag_kc_pk(tb + SD_CN, SD_CS, 16 * lt, 32 * ks, r, q);
#pragma unroll
                for (int pi = 0; pi < 2; ++pi) {
                    const bf16x8 bb = frag_tr(lds + SD_ST, SD_SS, 32 * ks, 16 * (2 * ph + pi), r, q);
                    Y[pi] = __builtin_amdgcn_mfma_f32_16x16x32_bf16(a, bb, Y[pi], 0, 0, 0);
                }
            }
#pragma unroll
            for (int j = 0; j < 4; ++j) { const float ea = SC[192 + 16 * lt + 4 * q + j]; Y[0][j] *= ea; Y[1][j] *= ea; }
            f32x4 G[4];
            const float acs_l = SC[64 + 16 * lt + r];
#pragma unroll
            for (int mt = 0; mt < 4; ++mt) {
                G[mt] = (f32x4){0.f, 0.f, 0.f, 0.f};
                if (mt <= lt) {
#pragma unroll
                    for (int ks = 0; ks < 4; ++ks) {
                        const bf16x8 a = frag_kc(tb + SD_BN, SD_BS, 16 * mt, 32 * ks, r, q);
                        const bf16x8 bb = frag_kc(tb + SD_CN, SD_CS, 16 * lt, 32 * ks, r, q);
                        G[mt] = __builtin_amdgcn_mfma_f32_16x16x32_bf16(a, bb, G[mt], 0, 0, 0);
                    }
#pragma unroll
                    for (int j = 0; j < 4; ++j) {
                        const int lp = 16 * mt + 4 * q + j, l = 16 * lt + r;
                        G[mt][j] = (lp <= l) ? G[mt][j] * __expf(acs_l - SC[64 + lp]) * SC[lp] : 0.f;
                    }
                }
            }
#pragma unroll
            for (int s = 0; s < 2; ++s) {
                if (2 * s <= lt) {
                    const bf16x8 a = pack8(G[2 * s], G[2 * s + 1]);
#pragma unroll
                    for (int pi = 0; pi < 2; ++pi) {
                        const bf16x8 bb = frag_tr(tb + SD_XN, SD_XS, 32 * s, 16 * (2 * ph + pi), r, q);
                        Y[pi] = __builtin_amdgcn_mfma_f32_16x16x32_bf16(a, bb, Y[pi], 0, 0, 0);
                    }
                }
            }
#pragma unroll
            for (int pi = 0; pi < 2; ++pi)
#pragma unroll
                for (int j = 0; j < 4; ++j) {
                    const int l = 16 * lt + 4 * q + j, pp = 16 * (2 * ph + pi) + r;
                    if (l < nvalid) {
                        const size_t t = (size_t)(t0 + c * 64 + l);
                        const float x = bf2f(*(const LAS bf16*)(tb + SD_XN + l * SD_XS + pp * 2));
                        const float z = bf2f(*(const LAS bf16*)(tb + SD_ZN + l * SD_ZS + pp * 2));
                        const float yv = (Y[pi][j] + Dh * x) * silu_f(z);
                        if (YGF32) ((float*)YG)[t * 1024 + head * 64 + pp] = yv; else ((bf16*)YG)[t * 1024 + head * 64 + pp] = f2bf(yv);
                    }
                }
        }
        __syncthreads();
        {
            const float dec = SC[192 + 63];
#pragma unroll
            for (int i = 0; i < 4; ++i) {
                f32x4 acc = Sacc[i] * dec;
#pragma unroll
                for (int s = 0; s < 2; ++s) {
                    const bf16x8 a = frag_tr(tb + SD_XW, SD_XS, 32 * s, 16 * pt_s, r, q);
                    const bf16x8 bb = frag_tr(tb + SD_BN, SD_BS, 32 * s, 16 * (4 * nh + i), r, q);
                    acc = __builtin_amdgcn_mfma_f32_16x16x32_bf16(a, bb, acc, 0, 0, 0);
                }
                Sacc[i] = acc;
                u32x2 w; w.x = pack2(acc[0], acc[1]); w.y = pack2(acc[2], acc[3]);
                *(LAS u32x2*)(lds + SD_ST + (16 * (4 * nh + i) + r) * SD_SS + (16 * pt_s + 4 * q) * 2) = w;
            }
        }
    }
    float* so = p.out + (prompt ? O_P_SS : O_S_SS) + (((size_t)b * 16 + head) * 64) * 128;
#pragma unroll
    for (int i = 0; i < 4; ++i)
#pragma unroll
        for (int j = 0; j < 4; ++j) so[(size_t)(16 * pt_s + 4 * q + j) * 128 + 16 * (4 * nh + i) + r] = Sacc[i][j];
}

constexpr size_t DN_ITEM_BYTES = 73728;
constexpr int DN_NITEMS = 2048 + 1024;
constexpr size_t WS_DNI = WS_MIX;
constexpr size_t WS_DNGT = WS_DNI + (size_t)DN_NITEMS * DN_ITEM_BYTES;

constexpr int DP_RAW = 0, DP_RAWS = 784;
constexpr int DP_QN = 52736, DP_TS = 272;
constexpr int DP_KN = DP_QN + 64 * 272;
constexpr int DP_KB = DP_KN + 64 * 272;
constexpr int DP_VN = DP_KB + 64 * 272;
constexpr int DP_LB = DP_VN + 64 * 272, DP_LS = 144;
constexpr int DP_LF = DP_LB + 64 * 144;
constexpr int DP_TD = DP_LF + 4 * 16 * 17 * 4, DP_TDS = 80;
constexpr int DP_SC = DP_TD + 64 * 80;
constexpr int DP_END = DP_SC + 1024;

__device__ __forceinline__ float sigmoid_f(float x) { return __builtin_amdgcn_rcpf(1.0f + __expf(-x)); }

__device__ __forceinline__ void dn_item_decode(int item, bool& prompt, int& b, int& h, int& c) {
    prompt = item < 2048;
    if (prompt) { b = item >> 8; h = (item >> 5) & 7; c = item & 31; } else { b = (item - 2048) >> 3; h = (item - 2048) & 7; c = 0; }
}
__device__ __forceinline__ void dn_load_raw(const Params& p, int item, u32x4 (&raw)[7]) {
    const bf16* PROJB = (const bf16*)(p.ws + WS_PROJB);
    bool prompt; int b, h, c; dn_item_decode(item, prompt, b, h, c);
    const int nvalid = prompt ? 64 : DECS, t0 = prompt ? b * SEQ : TP + b * DECS;
    const int tid = tidx(), pcx = tid & 15, rg = tid >> 4;
#pragma unroll
    for (int i = 0; i < 6; ++i) {
        const int part = i >> 1, l = (i & 1) * 32 + rg;
        raw[i] = (l < nvalid) ? *(const u32x4*)(PROJB + (size_t)(t0 + c * 64 + l) * PROJW + part * 1024 + h * 128 + pcx * 8) : (u32x4){0u, 0u, 0u, 0u};
    }
    u32x4 v = (u32x4){0u, 0u, 0u, 0u};
    if (tid < 144) {
        const int part = rg >= 6 ? 2 : (rg >= 3 ? 1 : 0), hr = rg - 3 * part;
        const int col = part * 1024 + h * 128 + pcx * 8;
        const int ls = c * 64 + hr - 3;
        if (ls >= 0) v = *(const u32x4*)(PROJB + (size_t)(t0 + ls) * PROJW + col);
        else if (!prompt) {
            const float* s = p.in[2] + ((size_t)b * 3 + hr) * DN_QKV + col;
            const float4 a = *(const float4*)s, bb = *(const float4*)(s + 4);
            v.x = pack2(a.x, a.y); v.y = pack2(a.z, a.w); v.z = pack2(bb.x, bb.y); v.w = pack2(bb.z, bb.w);
        }
    }
    raw[6] = v;
}

__device__ __forceinline__ void dn_prep_item(const Params& p, LAS unsigned char* lds, int item) {
    unsigned char* ws = p.ws;
    const float* SMALL = (const float*)(ws + WS_SMALL);
    const float* conv_w = p.in[11];
    const int tid = tidx(), lane = tid & 63, wv = tid >> 6, r = lane & 15, q = lane >> 4;
    bool prompt; int b, h, c; dn_item_decode(item, prompt, b, h, c);
    const int nvalid = prompt ? 64 : DECS, t0 = prompt ? b * SEQ : TP + b * DECS;
    unsigned char* ib = ws + WS_DNI + (size_t)item * DN_ITEM_BYTES;
    bf16* UT = (bf16*)ib; bf16* WT = (bf16*)(ib + 16384); bf16* QD = (bf16*)(ib + 32768); bf16* KDT = (bf16*)(ib + 49152); bf16* ATT = (bf16*)(ib + 65536);
    LAS float* SC = (LAS float*)(lds + DP_SC);
    LAS float* LF = (LAS float*)(lds + DP_LF);
    const float Ah = -__expf(p.in[12][h]), dtb = p.in[13][h];

    __syncthreads();
    {
        u32x4 raw[7];
        dn_load_raw(p, item, raw);
        const int pcx = tid & 15, rg = tid >> 4;
#pragma unroll
        for (int i = 0; i < 6; ++i) *(LAS u32x4*)(lds + DP_RAW + ((i & 1) * 32 + rg + 3) * DP_RAWS + ((i >> 1) * 16 + pcx) * 16) = raw[i];
        if (tid < 144) { const int part = rg >= 6 ? 2 : (rg >= 3 ? 1 : 0), hr = rg - 3 * part; *(LAS u32x4*)(lds + DP_RAW + hr * DP_RAWS + (part * 16 + pcx) * 16) = raw[6]; }
    }
    for (int i = tid; i < (64 * 144 + 4 * 16 * 17 * 4 + 64 * 80) / 4; i += NT) ((LAS unsigned*)(lds + DP_LB))[i] = 0u;
    if (wv == 0) {
        const int l = lane; const bool valid = l < nvalid;
        const size_t t = (size_t)(t0 + c * 64 + (valid ? l : 0));
        const float beta = valid ? sigmoid_f(SMALL[t * 32 + h]) : 0.f;
        float gc = valid ? Ah * softplus_f(SMALL[t * 32 + 8 + h] + dtb) : 0.f;
#pragma unroll
        for (int o = 1; o < 64; o <<= 1) { const float up = __shfl_up(gc, o); if (lane >= o) gc += up; }
        const float last = __shfl(gc, 63);
        SC[l] = beta; SC[64 + l] = gc; SC[128 + l] = __expf(gc); SC[192 + l] = __expf(last - gc);
        if (lane == 0) ((float*)(ws + WS_DNGT))[item] = __expf(last);
    }
    __syncthreads();
    {
        const int l = tid >> 3, ch = tid & 7;
        const bool valid = l < nvalid;
        const float beta = SC[l], egc = SC[128 + l];
#pragma unroll 1
        for (int part = 2; part >= 0; --part) {
            float acc[16];
#pragma unroll
            for (int k = 0; k < 16; ++k) acc[k] = 0.f;
            const int col = part * 1024 + h * 128 + ch * 16;
#pragma unroll
            for (int tp = 0; tp < 4; ++tp) {
                const LAS unsigned char* rp = lds + DP_RAW + (l + tp) * DP_RAWS + (part * 16 + ch * 2) * 16;
                const u32x4 r0 = *(const LAS u32x4*)rp, r1 = *(const LAS u32x4*)(rp + 16);
                const float* wp = conv_w + tp * DN_QKV + col;
                const float4 w0 = *(const float4*)wp, w1 = *(const float4*)(wp + 4), w2 = *(const float4*)(wp + 8), w3 = *(const float4*)(wp + 12);
                acc[0] += w0.x * __uint_as_float(r0.x << 16); acc[1] += w0.y * __uint_as_float(r0.x & 0xffff0000u);
                acc[2] += w0.z * __uint_as_float(r0.y << 16); acc[3] += w0.w * __uint_as_float(r0.y & 0xffff0000u);
                acc[4] += w1.x * __uint_as_float(r0.z << 16); acc[5] += w1.y * __uint_as_float(r0.z & 0xffff0000u);
                acc[6] += w1.z * __uint_as_float(r0.w << 16); acc[7] += w1.w * __uint_as_float(r0.w & 0xffff0000u);
                acc[8] += w2.x * __uint_as_float(r1.x << 16); acc[9] += w2.y * __uint_as_float(r1.x & 0xffff0000u);
                acc[10] += w2.z * __uint_as_float(r1.y << 16); acc[11] += w2.w * __uint_as_float(r1.y & 0xffff0000u);
                acc[12] += w3.x * __uint_as_float(r1.z << 16); acc[13] += w3.y * __uint_as_float(r1.z & 0xffff0000u);
                acc[14] += w3.z * __uint_as_float(r1.w << 16); acc[15] += w3.w * __uint_as_float(r1.w & 0xffff0000u);
            }
            float ss = 0.f;
#pragma unroll
            for (int k = 0; k < 16; ++k) { acc[k] = valid ? silu_f(acc[k]) : 0.f; ss += acc[k] * acc[k]; }
            ss += __shfl_xor(ss, 1); ss += __shfl_xor(ss, 2); ss += __shfl_xor(ss, 4);
            const float sc = part == 2 ? 1.0f : (part == 1 ? rsqrtf(ss + 1e-6f) : rsqrtf(ss + 1e-6f) * 0.08838834764831845f);
            const float sc2 = part == 1 ? beta : egc;
            const int off = l * DP_TS + ch * 32;
#pragma unroll
            for (int hh = 0; hh < 2; ++hh) {
                unsigned w1[4], w2[4];
#pragma unroll
                for (int k = 0; k < 4; ++k) {
                    const float a0 = acc[hh * 8 + 2 * k] * sc, a1 = acc[hh * 8 + 2 * k + 1] * sc;
                    w1[k] = pack2(a0, a1); w2[k] = pack2(a0 * sc2, a1 * sc2);
                }
                const u32x4 o1 = (u32x4){w1[0], w1[1], w1[2], w1[3]}, o2 = (u32x4){w2[0], w2[1], w2[2], w2[3]};
                if (part == 2) *(LAS u32x4*)(lds + DP_VN + off + hh * 16) = o1;
                else if (part == 1) { *(LAS u32x4*)(lds + DP_KN + off + hh * 16) = o1; *(LAS u32x4*)(lds + DP_KB + off + hh * 16) = o2; }
                else { *(LAS u32x4*)(lds + DP_QN + off + hh * 16) = o1; *(u32x4*)(QD + l * 128 + ch * 16 + hh * 8) = o2; }
            }
        }
    }
    __syncthreads();
    for (int tile = wv; tile < 20; tile += 8) {
        const int id = tile % 10, isqk = tile / 10;
        int it = 0, jt = id; while (jt > it) { jt -= it + 1; ++it; }
        f32x4 acc = (f32x4){0.f, 0.f, 0.f, 0.f};
#pragma unroll
        for (int ks = 0; ks < 4; ++ks) {
            const bf16x8 a = frag_kc(lds + (isqk ? DP_QN : DP_KB), DP_TS, 16 * it, 32 * ks, r, q);
            const bf16x8 bb = frag_kc(lds + DP_KN, DP_TS, 16 * jt, 32 * ks, r, q);
            acc = __builtin_amdgcn_mfma_f32_16x16x32_bf16(a, bb, acc, 0, 0, 0);
        }
        const int j = 16 * jt + r;
        const float gcj = SC[64 + j];
#pragma unroll
        for (int jj = 0; jj < 4; ++jj) {
            const int i = 16 * it + 4 * q + jj;
            const float dec = __expf(SC[64 + i] - gcj);
            if (isqk) { ATT[i * 64 + j] = f2bf(j <= i ? acc[jj] * dec : 0.f); }
            else {
                const float lv = (j < i) ? acc[jj] * dec : 0.f;
                *(LAS bf16*)(lds + DP_LB + i * DP_LS + j * 2) = f2bf(-lv);
                if (it == jt) LF[(it * 16 + (4 * q + jj)) * 17 + r] = lv;
            }
        }
    }
    if (wv >= 4) {
        for (int e = tid - 256; e < 6 * 256; e += 256) {
            const int tix = e >> 8, w = e & 255; const int it = tix < 3 ? 0 : (tix < 5 ? 1 : 2), jt = tix < 3 ? tix + 1 : (tix < 5 ? tix - 1 : 3);
            ATT[(16 * it + (w >> 4)) * 64 + 16 * jt + (w & 15)] = 0;
        }
    }
    __syncthreads();
    if (wv == 0) {
        const int blk = lane >> 4, col = lane & 15;
        const LAS float* Lb = LF + blk * 16 * 17;
        float x[16];
#pragma unroll
        for (int k = 0; k < 16; ++k) {
            float s = (k == col) ? 1.f : 0.f;
#pragma unroll
            for (int m = 0; m < k; ++m) s -= Lb[k * 17 + m] * x[m];
            x[k] = s;
        }
#pragma unroll
        for (int k = 0; k < 16; ++k) *(LAS bf16*)(lds + DP_TD + (16 * blk + k) * DP_TDS + col * 2) = f2bf(x[k]);
    }
    {
        const int d = tid >> 2, lq = tid & 3;
        unsigned w[8];
#pragma unroll
        for (int k = 0; k < 8; ++k) {
            const int l0 = 16 * lq + 2 * k;
            const float a = bf2f(*(const LAS bf16*)(lds + DP_KN + l0 * DP_TS + d * 2)) * SC[192 + l0];
            const float bb = bf2f(*(const LAS bf16*)(lds + DP_KN + (l0 + 1) * DP_TS + d * 2)) * SC[192 + l0 + 1];
            w[k] = pack2(a, bb);
        }
        *(u32x4*)(KDT + d * 64 + 16 * lq) = (u32x4){w[0], w[1], w[2], w[3]};
        *(u32x4*)(KDT + d * 64 + 16 * lq + 8) = (u32x4){w[4], w[5], w[6], w[7]};
    }
    __syncthreads();
    const f32x4 zero4 = (f32x4){0.f, 0.f, 0.f, 0.f};
#pragma unroll
    for (int cc = 0; cc < 2; ++cc) {
        const int ct = 2 * wv + cc;
        const bool isw = ct >= 8;
        const int colb = (ct & 7) * 16 + r;
        f32x4 R[4];
#pragma unroll
        for (int I = 0; I < 4; ++I)
#pragma unroll
            for (int jj = 0; jj < 4; ++jj) {
                const int row = 16 * I + 4 * q + jj;
                R[I][jj] = isw ? bf2f(*(const LAS bf16*)(lds + DP_KB + row * DP_TS + colb * 2)) * SC[128 + row]
                               : bf2f(*(const LAS bf16*)(lds + DP_VN + row * DP_TS + colb * 2)) * SC[row];
            }
        f32x4 X[4];
        X[0] = __builtin_amdgcn_mfma_f32_16x16x32_bf16(frag_kc_pk(lds + DP_TD, DP_TDS, 0, 0, r, q), pack8(R[0], zero4), zero4, 0, 0, 0);
        f32x4 a1 = __builtin_amdgcn_mfma_f32_16x16x32_bf16(frag_kc_pk(lds + DP_LB, DP_LS, 16, 0, r, q), pack8(X[0], zero4), R[1], 0, 0, 0);
        X[1] = __builtin_amdgcn_mfma_f32_16x16x32_bf16(frag_kc_pk(lds + DP_TD, DP_TDS, 16, 0, r, q), pack8(a1, zero4), zero4, 0, 0, 0);
        f32x4 a2 = __builtin_amdgcn_mfma_f32_16x16x32_bf16(frag_kc_pk(lds + DP_LB, DP_LS, 32, 0, r, q), pack8(X[0], X[1]), R[2], 0, 0, 0);
        X[2] = __builtin_amdgcn_mfma_f32_16x16x32_bf16(frag_kc_pk(lds + DP_TD, DP_TDS, 32, 0, r, q), pack8(a2, zero4), zero4, 0, 0, 0);
        f32x4 a3 = __builtin_amdgcn_mfma_f32_16x16x32_bf16(frag_kc_pk(lds + DP_LB, DP_LS, 48, 0, r, q), pack8(X[0], X[1]), R[3], 0, 0, 0);
        a3 = __builtin_amdgcn_mfma_f32_16x16x32_bf16(frag_kc_pk(lds + DP_LB, DP_LS, 48, 32, r, q), pack8(X[2], zero4), a3, 0, 0, 0);
        X[3] = __builtin_amdgcn_mfma_f32_16x16x32_bf16(frag_kc_pk(lds + DP_TD, DP_TDS, 48, 0, r, q), pack8(a3, zero4), zero4, 0, 0, 0);
        bf16* dst = (isw ? WT : UT) + colb * 64;
#pragma unroll
        for (int I = 0; I < 4; ++I) { u32x2 w; w.x = pack2(X[I][0], X[I][1]); w.y = pack2(X[I][2], X[I][3]); *(u32x2*)(dst + 16 * I + 4 * q) = w; }
    }
}

constexpr int DS_ST = 0, DS_STS = 272;
constexpr int DS_WT = DS_ST + 64 * 272, DS_WTS = 160;
constexpr int DS_QD = DS_WT + 128 * 160, DS_QDS = 272;
constexpr int DS_AT = DS_QD + 64 * 272, DS_ATS = 144;
constexpr int DS_KD = DS_AT + 64 * 144, DS_KDS = 144;
constexpr int DS_UT = DS_KD + 2 * 128 * 144, DS_UTS = 144;
constexpr int DS_END = DS_UT + 64 * 144;

__device__ __forceinline__ void dn_load_item(const unsigned char* ib, int half, u32x4 (&rg)[8]) {
    const int tid = tidx();
#pragma unroll
    for (int i = 0; i < 2; ++i) rg[i] = *(const u32x4*)(ib + 16384 + (size_t)(tid + NT * i) * 16);
#pragma unroll
    for (int i = 0; i < 2; ++i) rg[2 + i] = *(const u32x4*)(ib + 32768 + (size_t)(tid + NT * i) * 16);
#pragma unroll
    for (int i = 0; i < 2; ++i) rg[4 + i] = *(const u32x4*)(ib + 49152 + (size_t)(tid + NT * i) * 16);
    rg[6] = *(const u32x4*)(ib + 65536 + (size_t)tid * 16);
    rg[7] = *(const u32x4*)(ib + (size_t)half * 8192 + (size_t)tid * 16);
}
__device__ __forceinline__ void dn_store_item_lds(LAS unsigned char* lds, const u32x4 (&rg)[8], int kdbuf) {
    const int tid = tidx();
#pragma unroll
    for (int i = 0; i < 2; ++i) { const int e = tid + NT * i; *(LAS u32x4*)(lds + DS_WT + (e >> 3) * DS_WTS + (e & 7) * 16) = rg[i]; }
#pragma unroll
    for (int i = 0; i < 2; ++i) { const int e = tid + NT * i; *(LAS u32x4*)(lds + DS_QD + (e >> 4) * DS_QDS + (e & 15) * 16) = rg[2 + i]; }
#pragma unroll
    for (int i = 0; i < 2; ++i) { const int e = tid + NT * i; *(LAS u32x4*)(lds + DS_KD + kdbuf * 128 * DS_KDS + (e >> 3) * DS_KDS + (e & 7) * 16) = rg[4 + i]; }
    *(LAS u32x4*)(lds + DS_AT + (tid >> 3) * DS_ATS + (tid & 7) * 16) = rg[6];
    *(LAS u32x4*)(lds + DS_UT + (tid >> 3) * DS_UTS + (tid & 7) * 16) = rg[7];
}

__device__ __forceinline__ void dn_scan_stream(const Params& p, LAS unsigned char* lds, bool prompt, int b, int h, int half, bf16* ODN) {
    unsigned char* ws = p.ws;
    const int tid = tidx(), lane = tid & 63, wv = tid >> 6, r = lane & 15, q = lane >> 4;
    const int nchunks = prompt ? 32 : 1, nvalid = prompt ? 64 : DECS, t0 = prompt ? b * SEQ : TP + b * DECS;
    const int item0 = prompt ? ((b * 8 + h) * 32) : (2048 + b * 8 + h);
    const float* GT = (const float*)(ws + WS_DNGT);
    const int et = wv & 3, hf = wv >> 2;
    f32x4 Sacc[4];
#pragma unroll
    for (int i = 0; i < 4; ++i) {
        if (prompt) Sacc[i] = (f32x4){0.f, 0.f, 0.f, 0.f};
        else {
            const float* s0 = p.in[3] + (((size_t)b * 8 + h) * 128 + 16 * (4 * hf + i) + 4 * q) * 128 + 64 * half + 16 * et + r;
            Sacc[i] = (f32x4){s0[0], s0[128], s0[256], s0[384]};
        }
    }
    __syncthreads();
#pragma unroll
    for (int i = 0; i < 4; ++i) {
        u32x2 w; w.x = pack2(Sacc[i][0], Sacc[i][1]); w.y = pack2(Sacc[i][2], Sacc[i][3]);
        *(LAS u32x2*)(lds + DS_ST + (16 * et + r) * DS_STS + (16 * (4 * hf + i) + 4 * q) * 2) = w;
    }
    u32x4 rg[8];
    dn_load_item(ws + WS_DNI + (size_t)item0 * DN_ITEM_BYTES, half, rg);
    dn_store_item_lds(lds, rg, 0);
    if (nchunks > 1) dn_load_item(ws + WS_DNI + (size_t)(item0 + 1) * DN_ITEM_BYTES, half, rg);
    for (int c = 0; c < nchunks; ++c) {
        const float gtot = GT[item0 + c];
        __syncthreads();
        f32x4 vn[4];
#pragma unroll
        for (int lt = 0; lt < 4; ++lt) vn[lt] = (f32x4){0.f, 0.f, 0.f, 0.f};
        bf16x8 sB[4];
#pragma unroll
        for (int ks = 0; ks < 4; ++ks) sB[ks] = frag_kc_pk(lds + DS_ST, DS_STS, 16 * et, 32 * ks, r, q);
#pragma unroll
        for (int ks = 0; ks < 4; ++ks)
#pragma unroll
            for (int lt = 0; lt < 4; ++lt) {
                const bf16x8 a = frag_tr(lds + DS_WT, DS_WTS, 32 * ks, 16 * lt, r, q);
                vn[lt] = __builtin_amdgcn_mfma_f32_16x16x32_bf16(a, sB[ks], vn[lt], 0, 0, 0);
            }
#pragma unroll
        for (int lt = 0; lt < 4; ++lt) {
            const u32x2 uu = *(const LAS u32x2*)(lds + DS_UT + (16 * et + r) * DS_UTS + (16 * lt + 4 * q) * 2);
            vn[lt][0] = __uint_as_float(uu.x << 16) - vn[lt][0]; vn[lt][1] = __uint_as_float(uu.x & 0xffff0000u) - vn[lt][1];
            vn[lt][2] = __uint_as_float(uu.y << 16) - vn[lt][2]; vn[lt][3] = __uint_as_float(uu.y & 0xffff0000u) - vn[lt][3];
        }
        const bf16x8 vB0 = pack8(vn[0], vn[1]), vB1 = pack8(vn[2], vn[3]);
#pragma unroll
        for (int li = 0; li < 2; ++li) {
            const int lt = 2 * hf + li;
            f32x4 o = (f32x4){0.f, 0.f, 0.f, 0.f};
#pragma unroll
            for (int ks = 0; ks < 4; ++ks) o = __builtin_amdgcn_mfma_f32_16x16x32_bf16(frag_kc_pk(lds + DS_QD, DS_QDS, 16 * lt, 32 * ks, r, q), sB[ks], o, 0, 0, 0);
            o = __builtin_amdgcn_mfma_f32_16x16x32_bf16(frag_kc_pk(lds + DS_AT, DS_ATS, 16 * lt, 0, r, q), vB0, o, 0, 0, 0);
            o = __builtin_amdgcn_mfma_f32_16x16x32_bf16(frag_kc_pk(lds + DS_AT, DS_ATS, 16 * lt, 32, r, q), vB1, o, 0, 0, 0);
#pragma unroll
            for (int j = 0; j < 4; ++j) {
                const int l = 16 * lt + 4 * q + j;
                if (l < nvalid) ODN[(size_t)(t0 + c * 64 + l) * 1024 + h * 128 + 64 * half + 16 * et + r] = f2bf(o[j]);
            }
        }
        __syncthreads();
#pragma unroll
        for (int i = 0; i < 4; ++i) {
            const int dt = 4 * hf + i;
            f32x4 acc = Sacc[i] * gtot;
            acc = __builtin_amdgcn_mfma_f32_16x16x32_bf16(frag_kc_pk(lds + DS_KD + (c & 1) * 128 * DS_KDS, DS_KDS, 16 * dt, 0, r, q), vB0, acc, 0, 0, 0);
            acc = __builtin_amdgcn_mfma_f32_16x16x32_bf16(frag_kc_pk(lds + DS_KD + (c & 1) * 128 * DS_KDS, DS_KDS, 16 * dt, 32, r, q), vB1, acc, 0, 0, 0);
            Sacc[i] = acc;
            u32x2 w; w.x = pack2(acc[0], acc[1]); w.y = pack2(acc[2], acc[3]);
            *(LAS u32x2*)(lds + DS_ST + (16 * et + r) * DS_STS + (16 * dt + 4 * q) * 2) = w;
        }
        if (c + 1 < nchunks) {
            dn_store_item_lds(lds, rg, (c + 1) & 1);
            if (c + 2 < nchunks) dn_load_item(ws + WS_DNI + (size_t)(item0 + c + 2) * DN_ITEM_BYTES, half, rg);
        }
    }
    float* so = p.out + (prompt ? O_P_DN : O_S_DN) + (((size_t)b * 8 + h) * 128) * 128;
#pragma unroll
    for (int i = 0; i < 4; ++i)
#pragma unroll
        for (int j = 0; j < 4; ++j) so[(size_t)(16 * (4 * hf + i) + 4 * q + j) * 128 + 64 * half + 16 * et + r] = Sacc[i][j];
}

__device__ __forceinline__ void mix_norm_phase(const Params& p, const bf16* ODN, const bf16* YGB) {
    unsigned char* ws = p.ws;
    const bf16* PROJB = (const bf16*)(ws + WS_PROJB);
    bf16* OCATB = (bf16*)(ws + WS_OCATB);
    const int lane = tidx() & 63, wv = tidx() >> 6;
    const float* dnw = p.in[14]; const float* ssw = p.in[20];
    for (int t = blockIdx.x * 8 + wv; t < T; t += gridDim.x * 8) {
        {
            const u32x4 a = *(const u32x4*)(ODN + (size_t)t * 1024 + 16 * lane), bq = *(const u32x4*)(ODN + (size_t)t * 1024 + 16 * lane + 8);
            const u32x4 za = *(const u32x4*)(PROJB + (size_t)t * PROJW + 4608 + 16 * lane), zb = *(const u32x4*)(PROJB + (size_t)t * PROJW + 4608 + 16 * lane + 8);
            const unsigned w[8] = {a.x, a.y, a.z, a.w, bq.x, bq.y, bq.z, bq.w}, zw[8] = {za.x, za.y, za.z, za.w, zb.x, zb.y, zb.z, zb.w};
            float v[16]; float ss = 0.f;
#pragma unroll
            for (int i = 0; i < 8; ++i) { v[2 * i] = __uint_as_float(w[i] << 16); v[2 * i + 1] = __uint_as_float(w[i] & 0xffff0000u); ss += v[2 * i] * v[2 * i] + v[2 * i + 1] * v[2 * i + 1]; }
            ss += __shfl_xor(ss, 1); ss += __shfl_xor(ss, 2); ss += __shfl_xor(ss, 4);
            const float rstd = rsqrtf(ss * (1.0f / 128.0f) + 1e-6f);
            unsigned o[8];
#pragma unroll
            for (int i = 0; i < 8; ++i) {
                const int cw = (16 * lane + 2 * i) & 127;
                const float z0 = __uint_as_float(zw[i] << 16), z1 = __uint_as_float(zw[i] & 0xffff0000u);
                o[i] = pack2(v[2 * i] * rstd * dnw[cw] * silu_f(z0), v[2 * i + 1] * rstd * dnw[cw + 1] * silu_f(z1));
            }
            *(u32x4*)(OCATB + (size_t)t * 2048 + 16 * lane) = (u32x4){o[0], o[1], o[2], o[3]};
            *(u32x4*)(OCATB + (size_t)t * 2048 + 16 * lane + 8) = (u32x4){o[4], o[5], o[6], o[7]};
        }
        {
            const u32x4 a = *(const u32x4*)(YGB + (size_t)t * 1024 + 16 * lane), bq = *(const u32x4*)(YGB + (size_t)t * 1024 + 16 * lane + 8);
            const unsigned w[8] = {a.x, a.y, a.z, a.w, bq.x, bq.y, bq.z, bq.w};
            float v[16]; float ss = 0.f;
#pragma unroll
            for (int i = 0; i < 8; ++i) { v[2 * i] = __uint_as_float(w[i] << 16); v[2 * i + 1] = __uint_as_float(w[i] & 0xffff0000u); ss += v[2 * i] * v[2 * i] + v[2 * i + 1] * v[2 * i + 1]; }
            ss += __shfl_xor(ss, 1); ss += __shfl_xor(ss, 2); ss += __shfl_xor(ss, 4); ss += __shfl_xor(ss, 8); ss += __shfl_xor(ss, 16);
            const float rstd = rsqrtf(ss * (1.0f / 512.0f) + 1e-6f);
            unsigned o[8];
#pragma unroll
            for (int i = 0; i < 8; ++i) { const int cw = 16 * lane + 2 * i; o[i] = pack2(v[2 * i] * rstd * ssw[cw], v[2 * i + 1] * rstd * ssw[cw + 1]); }
            *(u32x4*)(OCATB + (size_t)t * 2048 + 1024 + 16 * lane) = (u32x4){o[0], o[1], o[2], o[3]};
            *(u32x4*)(OCATB + (size_t)t * 2048 + 1024 + 16 * lane + 8) = (u32x4){o[4], o[5], o[6], o[7]};
        }
    }
    for (int s = blockIdx.x; s < 8 + 128; s += gridDim.x) {
        const bool prompt = s < 8; const int b = prompt ? s : s - 8;
        const int tlast = prompt ? (b * SEQ + SEQ - 3) : (TP + b * DECS + DECS - 3);
        float* dnc = p.out + (prompt ? O_P_DNC : O_S_DNC) + (size_t)b * 3 * DN_QKV;
        float* sc = p.out + (prompt ? O_P_SC : O_S_SC) + (size_t)b * 3 * SSM_XBC;
        for (int i = tidx(); i < 3 * (DN_QKV + SSM_XBC); i += NT) {
            const int rr = i / (DN_QKV + SSM_XBC), cc = i - rr * (DN_QKV + SSM_XBC);
            const float v = bf2f(PROJB[(size_t)(tlast + rr) * PROJW + cc]);
            if (cc < DN_QKV) dnc[rr * DN_QKV + cc] = v; else sc[rr * SSM_XBC + (cc - DN_QKV)] = v;
        }
    }
}

constexpr int DSM_ACT = 0, DSM_RED = 8 * 384 * 4, DSM_SC = DSM_RED + 2 * 512 * 4, DSM_END = DSM_SC + 256;
__device__ __forceinline__ void dn_sample_item(const Params& p, LAS unsigned char* lds, int b, int h, bf16* ODN) {
    unsigned char* ws = p.ws;
    const bf16* PROJB = (const bf16*)(ws + WS_PROJB);
    const float* SMALL = (const float*)(ws + WS_SMALL);
    const float* conv_w = p.in[11];
    const int tid = tidx(), lane = tid & 63, wv = tid >> 6, j = tid & 127, iq = tid >> 7;
    LAS float* act = (LAS float*)(lds + DSM_ACT);
    LAS float* red = (LAS float*)(lds + DSM_RED); LAS float* sc = (LAS float*)(lds + DSM_SC);
    const int t0 = TP + b * DECS;
    const float Ah = -__expf(p.in[12][h]), dtb = p.in[13][h];
    float S[32];
    const float* s0 = p.in[3] + (((size_t)b * 8 + h) * 128 + 32 * iq) * 128 + j;
#pragma unroll
    for (int i = 0; i < 32; ++i) S[i] = s0[(size_t)i * 128];
    __syncthreads();
#pragma unroll
    for (int it = 0; it < 6; ++it) {
        const int e = tid + NT * it, l = e / 384, cl3 = e - l * 384, part = cl3 >> 7, col = part * 1024 + h * 128 + (cl3 & 127);
        float a = 0.f;
#pragma unroll
        for (int tp = 0; tp < 4; ++tp) {
            const int ls = l - 3 + tp;
            const float x = ls >= 0 ? bf2f(PROJB[(size_t)(t0 + ls) * PROJW + col]) : bf2f(f2bf(p.in[2][((size_t)b * 3 + (3 + ls)) * DN_QKV + col]));
            a += conv_w[tp * DN_QKV + col] * x;
        }
        act[e] = silu_f(a);
    }
    if (tid < 8) { const size_t t = (size_t)(t0 + tid); sc[16 + tid] = sigmoid_f(SMALL[t * 32 + h]); sc[24 + tid] = __expf(Ah * softplus_f(SMALL[t * 32 + 8 + h] + dtb)); }
    __syncthreads();
    {
        const float q0 = act[wv * 384 + lane], q1 = act[wv * 384 + 64 + lane], k0 = act[wv * 384 + 128 + lane], k1 = act[wv * 384 + 192 + lane];
        const float sq = wave_sum_u(q0 * q0 + q1 * q1), sk2 = wave_sum_u(k0 * k0 + k1 * k1);
        if (lane == 0) { sc[wv] = rsqrtf(sq + 1e-6f) * 0.08838834764831845f; sc[8 + wv] = rsqrtf(sk2 + 1e-6f); }
    }
    __syncthreads();
    for (int l = 0; l < DECS; ++l) {
        const LAS float* qs = act + l * 384; const LAS float* ks = qs + 128; const LAS float* vs = qs + 256;
        LAS float* rd = red + (l & 1) * 512;
        const float rq = sc[l], rk = sc[8 + l], beta = sc[16 + l], a = sc[24 + l];
        float sk = 0.f;
#pragma unroll
        for (int i = 0; i < 32; ++i) { S[i] *= a; sk += S[i] * ks[32 * iq + i]; }
        rd[iq * 128 + j] = sk * rk;
        __syncthreads();
        const float delta = beta * (vs[j] - (rd[j] + rd[128 + j] + rd[256 + j] + rd[384 + j]));
        float o = 0.f;
#pragma unroll
        for (int i = 0; i < 32; ++i) { S[i] += ks[32 * iq + i] * rk * delta; o += S[i] * qs[32 * iq + i]; }
        __syncthreads();
        rd[iq * 128 + j] = o * rq;
        __syncthreads();
        if (iq == 0) ODN[(size_t)(t0 + l) * 1024 + h * 128 + j] = f2bf(rd[j] + rd[128 + j] + rd[256 + j] + rd[384 + j]);
    }
    float* so = p.out + O_S_DN + (((size_t)b * 8 + h) * 128 + 32 * iq) * 128 + j;
#pragma unroll
    for (int i = 0; i < 32; ++i) so[(size_t)i * 128] = S[i];
}

#ifndef PROBE_REP
#define PROBE_REP -1
#endif
#ifndef MIX_YGF32
#define MIX_YGF32 false
#endif
constexpr size_t WS_YGB = WS_XN;
enum { PH_PROLOGUE = 0, PH_INPROJ = 1, PH_MIX_PREP = 2, PH_MIX_SCAN = 3, PH_MIX_NORM = 4, PH_WOUT = 5, PH_QKV = 6, PH_ATTN = 7, PH_WXO = 8, PH_PQ = 9, PH_PEER = 10, PH_PEER_U = 11, PH_PEER_V = 12, PH_FINAL = 13, PH_END = 14 };

__global__ void __launch_bounds__(NT, 2) mega(Params p) {
    extern __shared__ __attribute__((aligned(16))) unsigned char lds_raw[];
    LAS unsigned char* lds = (LAS unsigned char*)lds_raw;
    volatile LAS unsigned* misc = (volatile LAS unsigned*)(lds + LDS_MISC);
    if (threadIdx.x < 4) misc[threadIdx.x] = 0u;
    __syncthreads();
    unsigned char* ws = p.ws;
    XcdBarrier bar; bar.bar = (unsigned*)(ws + WS_CTL); bar.x = 0; bar.st = misc;
    if (p.use_bar) bar = xcd_barrier_post((unsigned*)(ws + WS_CTL), misc);
    float* SS1 = (float*)(ws + WS_CTL + CTL_SS1);
    float* SS2 = (float*)(ws + WS_CTL + CTL_SS2);
#define IN(k) (p.ph_lo <= (k) && (k) < p.ph_hi)
#define REPS(k) ((PROBE_REP == (k)) ? 2 : 1)
#define SEAM(k) do { if (p.use_bar && IN((k) + 1)) xcd_barrier(bar); } while (0)
    if (IN(PH_PROLOGUE)) { for (int rr = 0; rr < REPS(PH_PROLOGUE); ++rr) p0_prologue(p, lds); SEAM(PH_PROLOGUE); }
    if (IN(PH_INPROJ)) {
        EpiProj E{(bf16*)(ws + WS_PROJB), (float*)(ws + WS_SMALL)};
        for (int rr = 0; rr < REPS(PH_INPROJ); ++rr) run_gemm(lds, (const bf16*)(ws + WS_XN), (const bf16*)(ws + WS_WIN), T, NPAD, 1024, E);
        SEAM(PH_INPROJ);
    }
    bf16* ODN = (bf16*)(p.out + O_Y);
    bf16* YGB = ODN + (size_t)T * 1024;
    float* SCAL = (float*)(ws + WS_OCATB + (size_t)T * SSM_XBC * 2);
    bf16* XBCA = (bf16*)(ws + WS_OCATB);
    if (IN(PH_MIX_PREP)) {
        for (int rr = 0; rr < REPS(PH_MIX_PREP); ++rr) {
            for (int r2 = 0; r2 < REPS(102); ++r2) { ssd_conv_prepass(p, XBCA); ssd_scalar_prepass(p, SCAL); }
            for (int r2 = 0; r2 < REPS(103); ++r2) for (int item = blockIdx.x; item < 2048; item += gridDim.x) dn_prep_item(p, lds, item);
        }
        SEAM(PH_MIX_PREP);
    }
    if (IN(PH_MIX_SCAN)) {
        for (int rr = 0; rr < REPS(PH_MIX_SCAN); ++rr) {
            for (int r2 = 0; r2 < REPS(104); ++r2)
            for (int it = blockIdx.x; it < 256; it += gridDim.x) {
                if (it < 128) { for (int r3 = 0; r3 < REPS(105); ++r3) dn_scan_stream(p, lds, true, it >> 4, (it >> 1) & 7, it & 1, ODN); }
                else { for (int r3 = 0; r3 < REPS(106); ++r3) ssd_stream<false>(p, lds, true, (it - 128) >> 4, (it - 128) & 15, (void*)YGB, XBCA, SCAL); }
            }
            unsigned* qctr = (unsigned*)(ws + WS_CTL + CTL_QUEUE) + rr * 64;
            for (;;) {
                __syncthreads();
                if (threadIdx.x == 0) misc[8] = atomicAdd(qctr, 1u);
                __syncthreads();
                const int it = (int)misc[8];
                if (it >= 3072) break;
                if (it < 1024) dn_sample_item(p, lds, it >> 3, it & 7, ODN);
                else ssd_stream<false>(p, lds, false, (it - 1024) >> 4, (it - 1024) & 15, (void*)YGB, XBCA, SCAL);
            }
        }
        SEAM(PH_MIX_SCAN);
    }
    if (IN(PH_MIX_NORM)) { for (int rr = 0; rr < REPS(PH_MIX_NORM); ++rr) mix_norm_phase(p, ODN, YGB); SEAM(PH_MIX_NORM); }
    if (IN(PH_WOUT)) {
        EpiRes E{p.in[0], p.in[1], (float*)(ws + WS_H), (bf16*)(ws + WS_HB), SS1};
        run_gemm(lds, (const bf16*)(ws + WS_OCATB), (const bf16*)(ws + WS_WOUT), T, 1024, 2048, E);
        SEAM(PH_WOUT);
    }
    if (IN(PH_QKV)) {
        EpiScale E{(bf16*)(ws + WS_QB), 1024, SS1, 0.0625f};
        EpiMkv E2{p.out + O_P_MK, p.out + O_P_MV, (bf16*)(ws + WS_MKB), (bf16*)(ws + WS_MVB)};
        for (int rr = 0; rr < REPS(PH_QKV); ++rr) {
        run_gemm(lds, (const bf16*)(ws + WS_HB), (const bf16*)(ws + WS_WXQ), T, 1024, 1024, E);
        run_gemm(lds, (const bf16*)(ws + WS_MEMN), (const bf16*)(ws + WS_WMKV), 2048, 2048, 1024, E2, 16);
        }
        SEAM(PH_QKV);
    }
    if (IN(PH_ATTN)) { for (int rr = 0; rr < REPS(PH_ATTN); ++rr) attn_phase(p, lds); SEAM(PH_ATTN); }
    if (IN(PH_WXO)) {
        EpiRes E{(const float*)(ws + WS_H), (const float*)(ws + WS_H) + (size_t)TP * 1024, (float*)(ws + WS_H), (bf16*)(ws + WS_HB), SS2};
        run_gemm(lds, (const bf16*)(ws + WS_OB), (const bf16*)(ws + WS_WXO), T, 1024, 1024, E);
        SEAM(PH_WXO);
    }
    if (IN(PH_PQ)) {
        EpiScale E{(bf16*)(ws + WS_PQB), 2048, SS2, 1.0f};
        for (int rr = 0; rr < REPS(PH_PQ); ++rr) run_gemm(lds, (const bf16*)(ws + WS_HB), (const bf16*)(ws + WS_WPQ), T, 2048, 1024, E);
        SEAM(PH_PQ);
    }
    if (IN(PH_PEER)) { for (int rr = 0; rr < REPS(PH_PEER); ++rr) peer_select_phase(p, lds); SEAM(PH_PEER); }
    if (IN(PH_PEER_U)) { for (int rr = 0; rr < REPS(PH_PEER_U); ++rr) peer_u_phase(p, lds); SEAM(PH_PEER_U); }
    if (IN(PH_PEER_V)) { peer_v_phase(p, lds); SEAM(PH_PEER_V); }
    if (IN(PH_FINAL)) { for (int rr = 0; rr < REPS(PH_FINAL); ++rr) final_norm_phase(p); }
#undef IN
#undef SEAM
}

__global__ void __launch_bounds__(256) cvt_bf16_to_f32(const bf16* __restrict__ s, float* __restrict__ d, size_t n) {
    for (size_t i = (size_t)blockIdx.x * 256 + threadIdx.x; i < n; i += (size_t)gridDim.x * 256) d[i] = bf2f(s[i]);
}
__global__ void __launch_bounds__(256) cvt_f32_to_bf16(const float* __restrict__ s, bf16* __restrict__ d, size_t n) {
    for (size_t i = (size_t)blockIdx.x * 256 + threadIdx.x; i < n; i += (size_t)gridDim.x * 256) d[i] = f2bf(s[i]);
}
}

static int g_grid = 0;
static void mega_setup() {
    if (g_grid) return;
    int dev = 0, cus = 0, per_cu = 0;
    hipGetDevice(&dev);
    hipDeviceGetAttribute(&cus, hipDeviceAttributeMultiprocessorCount, dev);
    hipFuncSetAttribute((const void*)fk::mega, hipFuncAttributeMaxDynamicSharedMemorySize, fk::LDS_BYTES);
    hipOccupancyMaxActiveBlocksPerMultiprocessor(&per_cu, (const void*)fk::mega, fk::NT, fk::LDS_BYTES);
    if (per_cu < 1) { fprintf(stderr, "occupancy query says %d blocks/CU\n", per_cu); per_cu = 1; }
    (void)hipGetLastError();
    g_grid = cus;
}
static void mega_launch(hipStream_t s, const fk::Params& base, int lo, int hi, int use_bar) {
    fk::Params p = base; p.ph_lo = lo; p.ph_hi = hi; p.use_bar = use_bar; p.pad = 0;
    hipLaunchKernelGGL(fk::mega, dim3(g_grid), dim3(fk::NT), fk::LDS_BYTES, s, p);
}
static void cvt_b2f(hipStream_t s, const void* src, float* dst, size_t n) { fk::cvt_bf16_to_f32<<<2048, 256, 0, s>>>((const fk::bf16*)src, dst, n); }
static void cvt_f2b(hipStream_t s, const float* src, void* dst, size_t n) { fk::cvt_f32_to_bf16<<<2048, 256, 0, s>>>(src, (fk::bf16*)dst, n); }

extern "C" void kernel_launch(void* const* d_in, const int* in_sizes, int n_in, void* d_out, int out_size, void* d_ws, size_t ws_size, hipStream_t stream) {
    mega_setup();
    fk::Params P{};
    for (int i = 0; i < 33; ++i) P.in[i] = (const float*)d_in[i];
    P.out = (float*)d_out; P.ws = (unsigned char*)d_ws;
    hipMemsetAsync((unsigned char*)d_ws + fk::WS_CTL, 0, fk::CTL_BYTES, stream);
    mega_launch(stream, P, 0, fk::PH_END, 1);
}
```

```cpp
#include <hip/hip_runtime.h>
#include <stdint.h>
#include <stdio.h>

constexpr int D = 1024, BATCH = 8, SEQ = 2048, DECB = 128, DECS = 8;
constexpr int TP = BATCH * SEQ, TS = DECB * DECS, T = TP + TS;
constexpr int DN_QKV = 3072, SSM_XBC = 1536, NPROJ = 6688;
constexpr size_t O_Y = 0;
constexpr size_t O_P_DNC = 17825792, O_P_DN = 17899520, O_P_SC = 18948096, O_P_SS = 18984960, O_P_MK = 20033536, O_P_MV = 22130688;
constexpr size_t O_S_DNC = 24227840, O_S_DN = 25407488, O_S_SC = 42184704, O_S_SS = 42774528;

#define XB_TMO      128
#define XB_XCNT(j)  (256  + 64 * (j))
#define XB_XSUB(j)  (1280 + 64 * (j))
#define XB_XGEN(j)  (2304 + 64 * (j))
#define XB_TOP      3328
#define XB_TOPGEN   3392
#define XCD_BAR_WORDS 3456
#define XB_SPIN_CAP (1u << 18)
#define LAS __attribute__((address_space(3)))

__device__ __forceinline__ unsigned xb_ld(unsigned* p)              { return __hip_atomic_load(p, __ATOMIC_RELAXED, __HIP_MEMORY_SCOPE_AGENT); }
__device__ __forceinline__ unsigned xb_add(unsigned* p, unsigned v) { return __hip_atomic_fetch_add(p, v, __ATOMIC_RELAXED, __HIP_MEMORY_SCOPE_AGENT); }
__device__ __forceinline__ unsigned xb_xcc_id() { return (unsigned)__builtin_amdgcn_s_getreg((3 << 11) | 20) & 0xFu; }
#define XB_SPIN(cond, bar) do { unsigned _sp = 0; while (cond) { __builtin_amdgcn_s_sleep(1); \
    if ((++_sp & 255u) == 0u) { if (xb_ld(&(bar)[XB_TMO])) break; if (_sp > XB_SPIN_CAP) { atomicAdd(&(bar)[XB_TMO], 1u); break; } } } } while (0)

struct XcdBarrier {
    unsigned* bar; unsigned x;
    volatile LAS unsigned* st;
};

__device__ __forceinline__ XcdBarrier xcd_barrier_post(unsigned* bar, volatile LAS unsigned* st) {
    XcdBarrier b; b.bar = bar; b.x = xb_xcc_id(); b.st = st;
    if (threadIdx.x == 0) (void)xb_add(&bar[XB_XCNT(b.x)], 1u);
    return b;
}
__device__ __forceinline__ void xcd_barrier_complete(unsigned* bar, unsigned x, unsigned& nloc, unsigned& nx) {
    const unsigned G = gridDim.x * gridDim.y * gridDim.z;
    unsigned sum, cnt, mine, sp = 0u;
    for (;;) {
        sum = 0u; cnt = 0u; mine = 0u;
#pragma unroll
        for (unsigned j = 0; j < 16; ++j) { const unsigned c = xb_ld(&bar[XB_XCNT(j)]); sum += c; cnt += (c > 0u) ? 1u : 0u; mine = (j == x) ? c : mine; }
        if (sum == G) break;
        __builtin_amdgcn_s_sleep(1);
        if ((++sp & 255u) == 0u) { if (xb_ld(&bar[XB_TMO])) break; if (sp > XB_SPIN_CAP) { atomicAdd(&bar[XB_TMO], 1u); break; } }
    }
    nloc = mine > 0u ? mine : 1u; nx = cnt > 0u ? cnt : 1u;
}

__device__ __forceinline__ void xcd_barrier(const XcdBarrier& b) {
    asm volatile("s_waitcnt vmcnt(0)" ::: "memory");
    __syncthreads();
    if (threadIdx.x == 0) {
        unsigned* bar = b.bar;
        __builtin_amdgcn_s_waitcnt(0);
        unsigned nloc = b.st[0], nx = b.st[1];
        if (nloc == 0u) { xcd_barrier_complete(bar, b.x, nloc, nx); b.st[0] = nloc; b.st[1] = nx; }
        const unsigned old = xb_add(&bar[XB_XSUB(b.x)], 1u);
        const unsigned gen = old / nloc;
        if (old + 1u == (gen + 1u) * nloc) {
            __builtin_amdgcn_fence(__ATOMIC_RELEASE, "agent");
            asm volatile("s_waitcnt vmcnt(0)" ::: "memory");
            const unsigned og = xb_add(&bar[XB_TOP], 1u);
            const unsigned tg = og / nx;
            if (og + 1u == (tg + 1u) * nx) xb_add(&bar[XB_TOPGEN], 1u);
            else XB_SPIN(xb_ld(&bar[XB_TOPGEN]) == tg, bar);
            __builtin_amdgcn_fence(__ATOMIC_ACQUIRE, "agent");
            xb_add(&bar[XB_XGEN(b.x)], 1u);
            asm volatile("s_waitcnt vmcnt(0)" ::: "memory");
        } else {
            XB_SPIN(xb_ld(&bar[XB_XGEN(b.x)]) == gen, bar);
            __builtin_amdgcn_fence(__ATOMIC_ACQUIRE, "agent");
            asm volatile("s_waitcnt vmcnt(0)" ::: "memory");
        }
    }
    __syncthreads();
}

__device__ __forceinline__ int tidx() { int t = threadIdx.x; asm volatile("" : "+v"(t)); return t; }

namespace pg8 {
#define PG8_LAS __attribute__((address_space(3)))
typedef unsigned short bf16_t;
typedef short bf16x8 __attribute__((ext_vector_type(8)));
typedef float f32x4 __attribute__((ext_vector_type(4)));
typedef unsigned u32x4 __attribute__((ext_vector_type(4)));
constexpr int BM = 256, BK = 64, HALF = 128, HTB = HALF * BK * 2  , STAGE_BYTES = 8 * HTB, NXCD = 8, WGM = 8;

__host__ __device__ __forceinline__ int lds_byte(int r, int c) { const int st = (r >> 4) * 2 + (c >> 5), rr = r & 15, cc = c & 31, ob = rr * 64 + cc * 2; return st * 1024 + (ob ^ (((ob >> 9) & 1) << 5)); }
__host__ __device__ __forceinline__ void stage_rc(int b, int& R, int& C) { const int st = b / 1024, sb = b % 1024, swz = sb ^ (((sb >> 9) & 1) << 5); R = (st >> 1) * 16 + swz / 64; C = (st & 1) * 32 + (swz % 64) / 2; }
__host__ __device__ __forceinline__ int perm32(int rho) { const int n = rho >> 4, i = rho & 15; return 8 * (i >> 2) + 4 * n + (i & 3); }

struct Unit { int pm, pn; };
struct Gemm { const bf16_t* A; const bf16_t* Bt; int M, N, K; };

struct StaticOrder {
    int nM, nN, nwg, G, c;
    __host__ __device__ void init(int M, int N, int G_, int c_) { nM = M / BM; nN = N / BM; nwg = nM * nN; G = G_; c = c_; }
    __host__ __device__ bool next(int i, Unit& u) const {
        const long L = (long)i * G + c; if (L >= nwg) return false;
        int wgid = (int)L; { const int q = nwg / NXCD, r = nwg % NXCD, xcd = wgid % NXCD, off = wgid / NXCD; wgid = (xcd < r ? xcd * (q + 1) : r * (q + 1) + (xcd - r) * q) + off; }
        const int nig = WGM * nN, gid = wgid / nig, fm = gid * WGM, gsz = (nM - fm) < WGM ? (nM - fm) : WGM;
        u.pm = fm + ((wgid % nig) % gsz); u.pn = (wgid % nig) / gsz; return true;
    }
    __device__ __forceinline__ void a_ready(const Unit&) const {}
    __device__ __forceinline__ void done(const Unit&) const {}
};
__device__ __forceinline__ unsigned cvt_pk_bf16(float lo, float hi) { unsigned r; asm volatile("v_cvt_pk_bf16_f32 %0, %1, %2" : "=v"(r) : "v"(lo), "v"(hi)); return r; }
typedef float f32x2 __attribute__((ext_vector_type(2)));
template <class Epi, class Sched, bool STAMP = false>
__device__ __forceinline__ void gemm_phase(PG8_LAS unsigned char* lds, const Gemm g, const Sched& S, const Epi& E, unsigned long long* stamps) {
    const int tid = tidx(), wid = __builtin_amdgcn_readfirstlane(tid >> 6), lane = tid & 63, wr = wid >> 2, wc = wid & 3, fr = lane & 15, fq = lane >> 4;
    const int K = g.K, nt = K / BK;
    int ts_lo = 0, ts_hi = 0, nts = 0; const unsigned long long rt_entry = STAMP ? (unsigned long long)wall_clock64() : 0ull;
#define PG8_STAMP() do { if (STAMP && wid == 0 && nts < 64) { const unsigned long long _c = (unsigned long long)clock64(); \
        ts_lo = (lane == nts) ? (int)(unsigned)_c : ts_lo; ts_hi = (lane == nts) ? (int)(unsigned)(_c >> 32) : ts_hi; ++nts; } } while (0)
    PG8_STAMP();
    unsigned voffA[2], voffB[2];
#pragma unroll
    for (int i = 0; i < 2; ++i) { int R, C; stage_rc(tid * 16 + i * 8192, R, C); const int Rb = Epi::PERM ? ((R & ~31) + perm32(R & 31)) : R;
        voffA[i] = (unsigned)(R * K + C) * 2u; voffB[i] = (unsigned)(Rb * K + C) * 2u; }
    const size_t kstep = (size_t)(BK * 2);
    const size_t hstep = (size_t)HALF * K * 2;
    const size_t tstep = 2 * hstep;
    const unsigned ldsw = (unsigned)wid * 1024u;
    const int aoff = lds_byte(wr * 64 + fr, fq * 8), boff = lds_byte(wc * 32 + fr, fq * 8);
#define PG8_SA(b, h) (((b) * 2 + (h)) * HTB)
#define PG8_SB(b, h) ((4 + (b) * 2 + (h)) * HTB)
#define PG8_STAGE(bufoff, gbase, voff) do { _Pragma("unroll") for (int _i = 0; _i < 2; ++_i) \
        __builtin_amdgcn_global_load_lds((const unsigned*)((const char*)(gbase) + (voff)[_i]), (PG8_LAS unsigned*)(lds + (bufoff) + ldsw + _i * 8192), 16, 0, 0); } while (0)
#define PG8_LDA(dst, b, h) do { _Pragma("unroll") for (int m = 0; m < 4; ++m) _Pragma("unroll") for (int k = 0; k < 2; ++k) dst[m][k] = *(const PG8_LAS bf16x8*)(lds + PG8_SA(b, h) + aoff + m * 2048 + k * 1024); } while (0)
#define PG8_LDB(dst, b, h) do { _Pragma("unroll") for (int n = 0; n < 2; ++n) _Pragma("unroll") for (int k = 0; k < 2; ++k) dst[n][k] = *(const PG8_LAS bf16x8*)(lds + PG8_SB(b, h) + boff + n * 2048 + k * 1024); } while (0)
#define PG8_MMA(ai, bj, At, Bt) do { __builtin_amdgcn_s_setprio(1); _Pragma("unroll") for (int m = 0; m < 4; ++m) _Pragma("unroll") for (int n = 0; n < 2; ++n) _Pragma("unroll") for (int k = 0; k < 2; ++k) \
        acc[ai][bj][m][n] = __builtin_amdgcn_mfma_f32_16x16x32_bf16(Bt[n][k], At[m][k], acc[ai][bj][m][n], 0, 0, 0); __builtin_amdgcn_s_setprio(0); } while (0)
#define PG8_WAIT_V(n) asm volatile("s_waitcnt vmcnt(" #n ")" ::: "memory")
#define PG8_WAIT_L(n) asm volatile("s_waitcnt lgkmcnt(" #n ")" ::: "memory")
#define PG8_BAR __builtin_amdgcn_s_barrier()
#define PG8_SCHED __builtin_amdgcn_sched_barrier(0)
    Unit cur, nxt; int ui = 0;
    if (!S.next(0, cur)) return;
    f32x4 acc[2][2][4][2];
#pragma unroll
    for (int a = 0; a < 2; ++a)
#pragma unroll
        for (int b = 0; b < 2; ++b)
#pragma unroll
            for (int m = 0; m < 4; ++m)
#pragma unroll
                for (int n = 0; n < 2; ++n) acc[a][b][m][n] = (f32x4){0.f, 0.f, 0.f, 0.f};
    bf16x8 At[4][2], B0[2][2], B1[2][2];
    const char* cA = (const char*)g.A + (size_t)cur.pm * tstep; const char* cB = (const char*)g.Bt + (size_t)cur.pn * tstep;
    S.a_ready(cur);
    PG8_STAGE(PG8_SB(0, 0), cB, voffB); PG8_STAGE(PG8_SA(0, 0), cA, voffA); PG8_STAGE(PG8_SB(0, 1), cB + hstep, voffB); PG8_STAGE(PG8_SA(0, 1), cA + hstep, voffA);
    if (wr == 1) PG8_BAR;
    PG8_WAIT_V(4); PG8_BAR;
    PG8_STAGE(PG8_SB(1, 0), cB + kstep, voffB); PG8_STAGE(PG8_SA(1, 0), cA + kstep, voffA); PG8_STAGE(PG8_SB(1, 1), cB + hstep + kstep, voffB);
    PG8_WAIT_V(6); PG8_BAR;
    PG8_STAMP();
    for (;;) {
        const bool has_next = S.next(ui + 1, nxt);
        const char* nA = has_next ? (const char*)g.A + (size_t)nxt.pm * tstep : cA; const char* nB = has_next ? (const char*)g.Bt + (size_t)nxt.pn * tstep : cB;
        for (int t = 0; t < nt; t += 2) {
            const bool last = (t == nt - 2);
            const char* a1 = cA + (size_t)(t + 1) * kstep;
            const char* a2 = last ? nA : cA + (size_t)(t + 2) * kstep; const char* b2 = last ? nB : cB + (size_t)(t + 2) * kstep;
            const char* a3 = a2 + kstep; const char* b3 = b2 + kstep;
            if (last && has_next) S.a_ready(nxt);
            PG8_LDB(B0, 0, 0); PG8_SCHED; PG8_LDA(At, 0, 0); PG8_STAGE(PG8_SA(1, 1), a1 + hstep, voffA);
            PG8_WAIT_L(8); PG8_BAR; PG8_WAIT_L(0); PG8_MMA(0, 0, At, B0); PG8_BAR; PG8_SCHED;
            PG8_LDB(B1, 0, 1); PG8_STAGE(PG8_SB(0, 0), b2, voffB);
            PG8_BAR; PG8_WAIT_L(0); PG8_MMA(0, 1, At, B1); PG8_BAR;
            PG8_LDA(At, 0, 1); PG8_STAGE(PG8_SA(0, 0), a2, voffA);
            PG8_BAR; PG8_WAIT_L(0); PG8_MMA(1, 0, At, B0); PG8_BAR; PG8_SCHED;
            PG8_STAGE(PG8_SB(0, 1), b2 + hstep, voffB);
            PG8_WAIT_V(6); PG8_BAR; PG8_MMA(1, 1, At, B1); PG8_BAR;
            PG8_LDB(B0, 1, 0); PG8_SCHED; PG8_LDA(At, 1, 0); PG8_STAGE(PG8_SA(0, 1), a2 + hstep, voffA);
            PG8_WAIT_L(8); PG8_BAR; PG8_WAIT_L(0); PG8_MMA(0, 0, At, B0); PG8_BAR; PG8_SCHED;
            PG8_LDB(B1, 1, 1); PG8_STAGE(PG8_SB(1, 0), b3, voffB);
            PG8_BAR; PG8_WAIT_L(0); PG8_MMA(0, 1, At, B1); PG8_BAR;
            PG8_LDA(At, 1, 1); PG8_STAGE(PG8_SA(1, 0), a3, voffA);
            PG8_BAR; PG8_WAIT_L(0); PG8_MMA(1, 0, At, B0); PG8_BAR; PG8_SCHED;
            PG8_STAGE(PG8_SB(1, 1), b3 + hstep, voffB);
            PG8_WAIT_V(6); PG8_BAR; PG8_MMA(1, 1, At, B1); PG8_BAR;
        }
        PG8_STAMP();
        if constexpr (!Epi::AFTER_DRAIN) { E(acc, cur, wr, wc, fr, fq); S.done(cur); }
        PG8_STAMP();
        if (!has_next) break;
#pragma unroll
        for (int a = 0; a < 2; ++a)
#pragma unroll
            for (int b = 0; b < 2; ++b)
#pragma unroll
                for (int m = 0; m < 4; ++m)
#pragma unroll
                    for (int n = 0; n < 2; ++n) acc[a][b][m][n] = (f32x4){0.f, 0.f, 0.f, 0.f};
        cur = nxt; cA = nA; cB = nB; ++ui;
    }
    PG8_WAIT_V(0);
    if (wr == 0) PG8_BAR;
    PG8_BAR;
    if constexpr (Epi::AFTER_DRAIN) { E.fused(acc, cur, wr, wc, fr, fq, lds, wid, lane); S.done(cur); }
    PG8_STAMP();
    if (STAMP && wid == 0) { stamps[lane] = lane < nts ? (((unsigned long long)(unsigned)ts_hi << 32) | (unsigned)ts_lo) : 0ull;
        if (lane == 62) stamps[62] = rt_entry; if (lane == 63) stamps[63] = (unsigned long long)wall_clock64(); }
#undef PG8_STAMP
#undef PG8_SA
#undef PG8_SB
#undef PG8_STAGE
#undef PG8_LDA
#undef PG8_LDB
#undef PG8_MMA
#undef PG8_WAIT_V
#undef PG8_WAIT_L
#undef PG8_BAR
#undef PG8_SCHED
}
}

namespace fk {
typedef unsigned short bf16;
typedef float f32x4 __attribute__((ext_vector_type(4)));
typedef unsigned u32x4 __attribute__((ext_vector_type(4)));
typedef unsigned u32x2 __attribute__((ext_vector_type(2)));

typedef __bf16 hwbf16x2 __attribute__((ext_vector_type(2)));
__device__ __forceinline__ bf16 f2bf(float f) { return __builtin_bit_cast(bf16, (__bf16)f); }
__device__ __forceinline__ float bf2f(bf16 b) { return __uint_as_float(((unsigned)b) << 16); }
__device__ __forceinline__ unsigned pack2(float lo, float hi) { hwbf16x2 v; v[0] = (__bf16)lo; v[1] = (__bf16)hi; return __builtin_bit_cast(unsigned, v); }

constexpr int NT = 512;
constexpr int LDS_BYTES = 163840, LDS_MISC = LDS_BYTES - 1024;
constexpr int NPAD = 6912;
constexpr int PROJW = 6656;

constexpr size_t al256(size_t x) { return (x + 255) & ~(size_t)255; }
constexpr size_t WS_CTL = 0, CTL_BYTES = 393216;
constexpr size_t CTL_SS1 = 65536, CTL_SS2 = 163840, CTL_SS3 = 262144, CTL_QUEUE = 32768;
constexpr size_t WS_WIN = WS_CTL + CTL_BYTES;
constexpr size_t WS_WOUT = WS_WIN + (size_t)NPAD * 1024 * 2;
constexpr size_t WS_WXQ = WS_WOUT + (size_t)1024 * 2048 * 2;
constexpr size_t WS_WMKV = WS_WXQ + (size_t)1024 * 1024 * 2;
constexpr size_t WS_WXO = WS_WMKV + (size_t)2048 * 1024 * 2;
constexpr size_t WS_WPQ = WS_WXO + (size_t)1024 * 1024 * 2;
constexpr size_t WS_SUBK = WS_WPQ + (size_t)2048 * 1024 * 2;
constexpr size_t WS_PU = WS_SUBK + (size_t)2 * 128 * 128 * 2;
constexpr size_t WS_PV = WS_PU + (size_t)16384 * 1024 * 2;
constexpr size_t WS_XN = WS_PV + (size_t)16384 * 1024 * 2;
constexpr size_t WS_MEMN = WS_XN + (size_t)T * 1024 * 2;
constexpr size_t WS_MKB = WS_MEMN + (size_t)2048 * 1024 * 2;
constexpr size_t WS_MVB = WS_MKB + (size_t)2048 * 1024 * 2;
constexpr size_t WS_SMALL = WS_MVB + (size_t)2048 * 1024 * 2;
constexpr size_t WS_OCATB = WS_SMALL + (size_t)T * 32 * 4;
constexpr size_t WS_PROJB = WS_OCATB + (size_t)T * 2048 * 2;
constexpr size_t WS_MIX = WS_PROJB + (size_t)T * PROJW * 2;
constexpr size_t WS_H = WS_PROJB;
constexpr size_t WS_HB = WS_H + (size_t)T * 1024 * 4;
constexpr size_t WS_QB = WS_HB + (size_t)T * 1024 * 2;
constexpr size_t WS_OB = WS_QB + (size_t)T * 1024 * 2;
constexpr size_t WS_PQB = WS_OCATB;
constexpr size_t WS_SELI = WS_MIX;
constexpr size_t WS_SELG = WS_SELI + (size_t)T * 128 * 2;
constexpr size_t WS_PART = WS_SELG + (size_t)T * 128 * 4;
constexpr size_t WS_COEF = WS_PART + (size_t)8 * T * 128 * 4;

struct Params {
    const float* in[33];
    float* out;
    unsigned char* ws;
    int ph_lo, ph_hi;
    int use_bar;
    int pad;
};

__device__ __forceinline__ void transpose_cvt(const float* __restrict__ W, int K, int N, int Npad, const float* __restrict__ gain, bf16* __restrict__ Wt,
                                              float* ft  , int vb, int nvb) {
    const int tid = tidx();
    const int ntk = K / 64, ntn = Npad / 64, ntiles = ntk * ntn;
    for (int tile = vb; tile < ntiles; tile += nvb) {
        const int k0 = (tile % ntk) * 64, n0 = (tile / ntk) * 64;
        __syncthreads();
#pragma unroll
        for (int i = 0; i < 2; ++i) {
            const int e = tid + i * NT;
            const int kr = e >> 4, c4 = e & 15;
            const int n = n0 + c4 * 4;
            float4 v = make_float4(0.f, 0.f, 0.f, 0.f);
            if (n + 3 < N) v = *(const float4*)(W + (size_t)(k0 + kr) * N + n);
            else { const float* wr = W + (size_t)(k0 + kr) * N; if (n < N) v.x = wr[n]; if (n + 1 < N) v.y = wr[n + 1]; if (n + 2 < N) v.z = wr[n + 2]; }
            const float g = gain ? gain[k0 + kr] : 1.0f;
            float* d = ft + kr * 65 + c4 * 4;
            d[0] = v.x * g; d[1] = v.y * g; d[2] = v.z * g; d[3] = v.w * g;
        }
        __syncthreads();
        const int kc8 = tid & 7, nr = tid >> 3;
        u32x4 w;
        w.x = pack2(ft[(kc8 * 8 + 0) * 65 + nr], ft[(kc8 * 8 + 1) * 65 + nr]);
        w.y = pack2(ft[(kc8 * 8 + 2) * 65 + nr], ft[(kc8 * 8 + 3) * 65 + nr]);
        w.z = pack2(ft[(kc8 * 8 + 4) * 65 + nr], ft[(kc8 * 8 + 5) * 65 + nr]);
        w.w = pack2(ft[(kc8 * 8 + 6) * 65 + nr], ft[(kc8 * 8 + 7) * 65 + nr]);
        *(u32x4*)(Wt + (size_t)(n0 + nr) * K + k0 + kc8 * 8) = w;
    }
}
__device__ __forceinline__ void cvt_stream(const float* __restrict__ src, bf16* __restrict__ dst, size_t n, int vb, int nvb) {
    const size_t n8 = n / 8;
    for (size_t i = (size_t)vb * NT + tidx(); i < n8; i += (size_t)nvb * NT) {
        const float4 a = ((const float4*)src)[2 * i], b = ((const float4*)src)[2 * i + 1];
        u32x4 w; w.x = pack2(a.x, a.y); w.y = pack2(a.z, a.w); w.z = pack2(b.x, b.y); w.w = pack2(b.z, b.w);
        ((u32x4*)dst)[i] = w;
    }
}
__device__ __forceinline__ void norm_rows_bf16(const Params& p, bf16* __restrict__ XN, bf16* __restrict__ MEMN, int vb, int nvb) {
    const int lane = tidx() & 63, wv = tidx() >> 6;
    const int nrows = T + 2048;
    for (int r = vb * 8 + wv; r < nrows; r += nvb * 8) {
        const float* src; bf16* dst;
        if (r < TP) { src = p.in[0] + (size_t)r * 1024; dst = XN + (size_t)r * 1024; }
        else if (r < T) { src = p.in[1] + (size_t)(r - TP) * 1024; dst = XN + (size_t)r * 1024; }
        else { src = p.in[8] + (size_t)(r - T) * 1024; dst = MEMN + (size_t)(r - T) * 1024; }
        float4 v[4]; float ss = 0.f;
#pragma unroll
        for (int i = 0; i < 4; ++i) { v[i] = ((const float4*)src)[lane + 64 * i]; ss += v[i].x * v[i].x + v[i].y * v[i].y + v[i].z * v[i].z + v[i].w * v[i].w; }
#pragma unroll
        for (int o = 32; o > 0; o >>= 1) ss += __shfl_xor(ss, o);
        const float rstd = rsqrtf(ss * (1.0f / 1024.0f) + 1e-6f);
#pragma unroll
        for (int i = 0; i < 4; ++i) { u32x2 w; w.x = pack2(v[i].x * rstd, v[i].y * rstd); w.y = pack2(v[i].z * rstd, v[i].w * rstd); ((u32x2*)dst)[lane + 64 * i] = w; }
    }
}
__device__ __forceinline__ void cvt_peer_tables(const float* __restrict__ src, unsigned char* __restrict__ dst, float scale, int vb, int nvb);
__device__ __forceinline__ void p0_prologue(const Params& p, LAS unsigned char* lds) {
    float* ft = (float*)(unsigned char*)lds;
    unsigned char* ws = p.ws;
    const int vb = blockIdx.x, nvb = gridDim.x;
    transpose_cvt(p.in[10], 1024, NPROJ, NPAD, p.in[9], (bf16*)(ws + WS_WIN), ft, vb, nvb);
    transpose_cvt(p.in[21], 2048, 1024, 1024, nullptr, (bf16*)(ws + WS_WOUT), ft, vb, nvb);
    transpose_cvt(p.in[24], 1024, 1024, 1024, p.in[22], (bf16*)(ws + WS_WXQ), ft, vb, nvb);
    transpose_cvt(p.in[25], 1024, 2048, 2048, p.in[23], (bf16*)(ws + WS_WMKV), ft, vb, nvb);
    transpose_cvt(p.in[26], 1024, 1024, 1024, nullptr, (bf16*)(ws + WS_WXO), ft, vb, nvb);
    transpose_cvt(p.in[28], 1024, 2048, 2048, p.in[27], (bf16*)(ws + WS_WPQ), ft, vb, nvb);
    cvt_stream(p.in[29], (bf16*)(ws + WS_SUBK), (size_t)2 * 128 * 128, vb, nvb);
    cvt_peer_tables(p.in[30], ws + WS_PU, 64.0f, vb, nvb);
    cvt_peer_tables(p.in[31], ws + WS_PV, 8.0f, vb, nvb);
    norm_rows_bf16(p, (bf16*)(ws + WS_XN), (bf16*)(ws + WS_MEMN), vb, nvb);
}

using pg8::Unit;
struct EpiProj {
    static constexpr bool PERM = true, AFTER_DRAIN = false;
    bf16* O; float* SM;
    __device__ __forceinline__ void operator()(const f32x4 (&acc)[2][2][4][2], const Unit& u, int wr, int wc, int fr, int fq) const {
        const int row0 = u.pm * 256 + wr * 64 + fr;
        if (u.pn < 26) {
            const int col0 = u.pn * 256 + wc * 32 + 8 * fq;
#pragma unroll
            for (int ai = 0; ai < 2; ++ai)
#pragma unroll
                for (int m = 0; m < 4; ++m) {
                    bf16* rowp = O + (size_t)(row0 + ai * 128 + m * 16) * PROJW + col0;
#pragma unroll
                    for (int bj = 0; bj < 2; ++bj) {
                        const f32x4 v0 = acc[ai][bj][m][0], v1 = acc[ai][bj][m][1];
                        u32x4 w; w.x = pack2(v0[0], v0[1]); w.y = pack2(v0[2], v0[3]); w.z = pack2(v1[0], v1[1]); w.w = pack2(v1[2], v1[3]);
                        *(u32x4*)(rowp + bj * 128) = w;
                    }
                }
        } else if (wc == 0) {
#pragma unroll
            for (int ai = 0; ai < 2; ++ai)
#pragma unroll
                for (int m = 0; m < 4; ++m) {
                    float* rowp = SM + (size_t)(row0 + ai * 128 + m * 16) * 32 + 8 * fq;
                    *(f32x4*)(rowp) = acc[ai][0][m][0];
                    *(f32x4*)(rowp + 4) = acc[ai][0][m][1];
                }
        }
    }
};
struct EpiRes {
    static constexpr bool PERM = false, AFTER_DRAIN = false;
    const float* res_p; const float* res_s;
    float* H; bf16* HB; float* SS;
    __device__ __forceinline__ void operator()(const f32x4 (&acc)[2][2][4][2], const Unit& u, int wr, int wc, int fr, int fq) const {
        const int row0 = u.pm * 256 + wr * 64 + fr, col0 = u.pn * 256 + wc * 32 + 4 * fq;
        const float* rbase = (u.pm < TP / 256) ? res_p : res_s - (size_t)TP * 1024;
#pragma unroll
        for (int ai = 0; ai < 2; ++ai)
#pragma unroll
            for (int m = 0; m < 4; ++m) {
                const int row = row0 + ai * 128 + m * 16;
                float ssq = 0.f;
#pragma unroll
                for (int bj = 0; bj < 2; ++bj)
#pragma unroll
                    for (int n = 0; n < 2; ++n) {
                        const size_t off = (size_t)row * 1024 + col0 + bj * 128 + n * 16;
                        const f32x4 r = *(const f32x4*)(rbase + off);
                        const f32x4 v = acc[ai][bj][m][n] + r;
                        *(f32x4*)(H + off) = v;
                        u32x2 w; w.x = pack2(v[0], v[1]); w.y = pack2(v[2], v[3]);
                        *(u32x2*)(HB + off) = w;
                        ssq += v[0] * v[0] + v[1] * v[1] + v[2] * v[2] + v[3] * v[3];
                    }
                ssq += __shfl_xor(ssq, 16); ssq += __shfl_xor(ssq, 32);
                if (fq == 0) atomicAdd(SS + row, ssq);
            }
    }
};
struct EpiScale {
    static constexpr bool PERM = true, AFTER_DRAIN = false;
    bf16* O; int ldc; const float* SS; float extra;
    __device__ __forceinline__ void operator()(const f32x4 (&acc)[2][2][4][2], const Unit& u, int wr, int wc, int fr, int fq) const {
        const int row0 = u.pm * 256 + wr * 64 + fr, col0 = u.pn * 256 + wc * 32 + 8 * fq;
#pragma unroll
        for (int ai = 0; ai < 2; ++ai)
#pragma unroll
            for (int m = 0; m < 4; ++m) {
                const int row = row0 + ai * 128 + m * 16;
                const float s = rsqrtf(SS[row] * (1.0f / 1024.0f) + 1e-6f) * extra;
                bf16* rowp = O + (size_t)row * ldc + col0;
#pragma unroll
                for (int bj = 0; bj < 2; ++bj) {
                    const f32x4 v0 = acc[ai][bj][m][0] * s, v1 = acc[ai][bj][m][1] * s;
                    u32x4 w; w.x = pack2(v0[0], v0[1]); w.y = pack2(v0[2], v0[3]); w.z = pack2(v1[0], v1[1]); w.w = pack2(v1[2], v1[3]);
                    *(u32x4*)(rowp + bj * 128) = w;
                }
            }
    }
};
struct EpiMkv {
    static constexpr bool PERM = false, AFTER_DRAIN = false;
    float* OK; float* OV; bf16* KB; bf16* VB;
    __device__ __forceinline__ void operator()(const f32x4 (&acc)[2][2][4][2], const Unit& u, int wr, int wc, int fr, int fq) const {
        const int row0 = u.pm * 256 + wr * 64 + fr;
        const bool isv = u.pn >= 4;
        const int col0 = (u.pn & 3) * 256 + wc * 32 + 4 * fq;
        float* Of = isv ? OV : OK; bf16* Ob = isv ? VB : KB;
#pragma unroll
        for (int ai = 0; ai < 2; ++ai)
#pragma unroll
            for (int m = 0; m < 4; ++m) {
                const int row = row0 + ai * 128 + m * 16;
#pragma unroll
                for (int bj = 0; bj < 2; ++bj)
#pragma unroll
                    for (int n = 0; n < 2; ++n) {
                        const size_t off = (size_t)row * 1024 + col0 + bj * 128 + n * 16;
                        const f32x4 v = acc[ai][bj][m][n];
                        *(f32x4*)(Of + off) = v;
                        u32x2 w; w.x = pack2(v[0], v[1]); w.y = pack2(v[2], v[3]);
                        *(u32x2*)(Ob + off) = w;
                    }
            }
    }
};

template <class Epi>
__device__ __forceinline__ void run_gemm(LAS unsigned char* lds, const bf16* A, const bf16* Bt, int M, int N, int K, const Epi& E, int rot = 0) {
    pg8::Gemm g{A, Bt, M, N, K};
    const int G = (int)gridDim.x;
    pg8::StaticOrder S; S.init(M, N, G, ((int)blockIdx.x + G - (rot % G)) % G);
    pg8::gemm_phase<Epi, pg8::StaticOrder, false>(lds, g, S, E, nullptr);
}


typedef short bf16x8 __attribute__((ext_vector_type(8)));
typedef short s16x4 __attribute__((ext_vector_type(4)));

__device__ __forceinline__ bf16x8 pack8(const f32x4& a, const f32x4& b) {
    u32x4 w; w.x = pack2(a[0], a[1]); w.y = pack2(a[2], a[3]); w.z = pack2(b[0], b[1]); w.w = pack2(b[2], b[3]);
    return __builtin_bit_cast(bf16x8, w);
}
__device__ __forceinline__ bf16x8 ldsB_tr(const LAS unsigned char* base, int stride, int k0, int n0, int r, int q) {
    const LAS unsigned char* a0 = base + (k0 + 8 * q + (r >> 2)) * stride + (n0 + 4 * (r & 3)) * 2;
    const s16x4 lo = __builtin_amdgcn_ds_read_tr16_b64_v4i16((LAS s16x4*)a0);
    const s16x4 hi = __builtin_amdgcn_ds_read_tr16_b64_v4i16((LAS s16x4*)(a0 + 4 * stride));
    bf16x8 o; o[0] = lo[0]; o[1] = lo[1]; o[2] = lo[2]; o[3] = lo[3]; o[4] = hi[0]; o[5] = hi[1]; o[6] = hi[2]; o[7] = hi[3];
    return o;
}

constexpr int AT_KS = 272, AT_VS = 288, AT_BUF = 256 * 288;

template <bool F32>
__device__ __forceinline__ void at_stage_half(const void* src, int hh, LAS unsigned char* buf, int stride) {
    const int tid = tidx();
#pragma unroll
    for (int pass = 0; pass < 8; ++pass) {
        const int row = pass * 32 + (tid >> 4), c = tid & 15;
        u32x4 w;
        if (F32) {
            const float* s = (const float*)src + (size_t)row * 1024 + hh * 128 + c * 8;
            const float4 a = *(const float4*)s, b = *(const float4*)(s + 4);
            w.x = pack2(a.x, a.y); w.y = pack2(a.z, a.w); w.z = pack2(b.x, b.y); w.w = pack2(b.z, b.w);
        } else {
            w = *(const u32x4*)((const bf16*)src + (size_t)row * 1024 + hh * 128 + c * 8);
        }
        *(LAS u32x4*)(buf + row * stride + c * 16) = w;
    }
}

__device__ __forceinline__ void attn_phase(const Params& p, LAS unsigned char* lds) {
    unsigned char* ws = p.ws;
    const bf16* QB = (const bf16*)(ws + WS_QB);
    bf16* OB = (bf16*)(ws + WS_OB);
    const int tid = tidx(), lane = tid & 63, wv = tid >> 6, r = lane & 15, q = lane >> 4;
    LAS unsigned char* buf0 = lds;
    LAS unsigned char* buf1 = lds + AT_BUF;
    const int nunits = 256 + 512;
    for (int u = blockIdx.x; u < nunits; u += gridDim.x) {
        int t0, ntok, h; const void* Ksrc; const void* Vsrc; bool f32src;
        if (u < 256) { const int b = u >> 5; h = (u >> 3) & 3; const int tt = u & 7; t0 = b * SEQ + tt * 256; ntok = 256; f32src = false;
            Ksrc = (const bf16*)(ws + WS_MKB) + (size_t)b * 256 * 1024 + h * 256; Vsrc = (const bf16*)(ws + WS_MVB) + (size_t)b * 256 * 1024 + h * 256; }
        else { const int su = u - 256; const int b = su >> 2; h = su & 3; t0 = TP + b * DECS; ntok = DECS; f32src = true;
            Ksrc = p.in[6] + (size_t)b * 256 * 1024 + h * 256; Vsrc = p.in[7] + (size_t)b * 256 * 1024 + h * 256; }
        const int ntiles = (ntok == 256) ? 2 : (wv == 0 ? 1 : 0);
        __syncthreads();
        if (f32src) { at_stage_half<true>(Ksrc, 0, buf0, AT_KS); at_stage_half<true>(Ksrc, 1, buf1, AT_KS); }
        else { at_stage_half<false>(Ksrc, 0, buf0, AT_KS); at_stage_half<false>(Ksrc, 1, buf1, AT_KS); }
        __syncthreads();
        bf16x8 pf[2][8];
#pragma unroll
        for (int tile = 0; tile < 2; ++tile) {
#pragma unroll
            for (int s = 0; s < 8; ++s) pf[tile][s] = (bf16x8){0, 0, 0, 0, 0, 0, 0, 0};
            if (tile < ntiles) {
                const int tl = (ntok == 256 ? wv * 32 : 0) + tile * 16 + r;
                const int tq = t0 + (tl < ntok ? tl : ntok - 1);
                bf16x8 qf[8];
#pragma unroll
                for (int ks = 0; ks < 8; ++ks) qf[ks] = *(const bf16x8*)(QB + (size_t)tq * 1024 + h * 256 + 32 * ks + 8 * q);
                f32x4 acc[16];
#pragma unroll
                for (int mt = 0; mt < 16; ++mt) acc[mt] = (f32x4){0.f, 0.f, 0.f, 0.f};
#pragma unroll
                for (int ks = 0; ks < 8; ++ks) {
                    const LAS unsigned char* kb = (ks < 4 ? buf0 : buf1) + (32 * (ks & 3) + 8 * q) * 2;
#pragma unroll
                    for (int mt = 0; mt < 16; ++mt) {
                        const bf16x8 a = *(const LAS bf16x8*)(kb + (16 * mt + r) * AT_KS);
                        acc[mt] = __builtin_amdgcn_mfma_f32_16x16x32_bf16(a, qf[ks], acc[mt], 0, 0, 0);
                    }
                }
                float mx = -3.0e38f;
#pragma unroll
                for (int mt = 0; mt < 16; ++mt) mx = fmaxf(fmaxf(fmaxf(acc[mt][0], acc[mt][1]), fmaxf(acc[mt][2], acc[mt][3])), mx);
                mx = fmaxf(mx, __shfl_xor(mx, 16)); mx = fmaxf(mx, __shfl_xor(mx, 32));
                float sum = 0.f;
#pragma unroll
                for (int mt = 0; mt < 16; ++mt)
#pragma unroll
                    for (int j = 0; j < 4; ++j) { const float e = __expf(acc[mt][j] - mx); acc[mt][j] = e; sum += e; }
                sum += __shfl_xor(sum, 16); sum += __shfl_xor(sum, 32);
                const float inv = 1.0f / sum;
#pragma unroll
                for (int s = 0; s < 8; ++s) pf[tile][s] = pack8(acc[2 * s] * inv, acc[2 * s + 1] * inv);
            }
        }
        __syncthreads();
        if (f32src) { at_stage_half<true>(Vsrc, 0, buf0, AT_VS); at_stage_half<true>(Vsrc, 1, buf1, AT_VS); }
        else { at_stage_half<false>(Vsrc, 0, buf0, AT_VS); at_stage_half<false>(Vsrc, 1, buf1, AT_VS); }
        __syncthreads();
#pragma unroll
        for (int tile = 0; tile < 2; ++tile) {
            if (tile < ntiles) {
                const int tl0 = (ntok == 256 ? wv * 32 : 0) + tile * 16;
#pragma unroll
                for (int half = 0; half < 2; ++half) {
                    f32x4 o[8];
#pragma unroll
                    for (int dt = 0; dt < 8; ++dt) o[dt] = (f32x4){0.f, 0.f, 0.f, 0.f};
                    const LAS unsigned char* vb = half ? buf1 : buf0;
#pragma unroll
                    for (int s = 0; s < 8; ++s) {
#pragma unroll
                        for (int dt = 0; dt < 8; ++dt) {
                            const LAS unsigned char* a0 = vb + (32 * s + 4 * q + (r >> 2)) * AT_VS + (16 * dt + 4 * (r & 3)) * 2;
                            const s16x4 lo = __builtin_amdgcn_ds_read_tr16_b64_v4i16((LAS s16x4*)a0);
                            const s16x4 hi = __builtin_amdgcn_ds_read_tr16_b64_v4i16((LAS s16x4*)(a0 + 16 * AT_VS));
                            bf16x8 bfr; bfr[0] = lo[0]; bfr[1] = lo[1]; bfr[2] = lo[2]; bfr[3] = lo[3]; bfr[4] = hi[0]; bfr[5] = hi[1]; bfr[6] = hi[2]; bfr[7] = hi[3];
                            o[dt] = __builtin_amdgcn_mfma_f32_16x16x32_bf16(pf[tile][s], bfr, o[dt], 0, 0, 0);
                        }
                    }
#pragma unroll
                    for (int dt = 0; dt < 8; ++dt)
#pragma unroll
                        for (int j = 0; j < 4; ++j) {
                            const int tl = tl0 + 4 * q + j;
                            if (tl < ntok) OB[(size_t)(t0 + tl) * 1024 + h * 256 + half * 128 + 16 * dt + r] = f2bf(o[dt][j]);
                        }
                }
            }
        }
    }
}

constexpr int PE_TOK = 68;
constexpr int PE_KSTR = 272;
constexpr int PE_SUBK = 0;
constexpr int PE_SELI = 0, PE_SELG = PE_TOK * 128 * 4;
constexpr int PE_TOP = 69632;
constexpr int PE_PT = PE_TOP + PE_TOK * 8 * 33 * 4;

template <int CTRL> __device__ __forceinline__ float dppf(float v) { return __int_as_float(__builtin_amdgcn_update_dpp(0, __float_as_int(v), CTRL, 0xF, 0xF, true)); }
__device__ __forceinline__ float wave_sum_u(float v) {
    v += dppf<0xB1>(v); v += dppf<0x4E>(v); v += dppf<0x141>(v); v += dppf<0x140>(v);
    const float a = __int_as_float(__builtin_amdgcn_readlane(__float_as_int(v), 0)), b = __int_as_float(__builtin_amdgcn_readlane(__float_as_int(v), 16));
    const float c = __int_as_float(__builtin_amdgcn_readlane(__float_as_int(v), 32)), d = __int_as_float(__builtin_amdgcn_readlane(__float_as_int(v), 48));
    return (a + b) + (c + d);
}
typedef __bf16 bf16x2v __attribute__((ext_vector_type(2)));
__device__ __forceinline__ float dot2bf(unsigned a, unsigned b, float acc) {
    return __builtin_amdgcn_fdot2_f32_bf16(__builtin_bit_cast(bf16x2v, a), __builtin_bit_cast(bf16x2v, b), acc, false);
}
__device__ __forceinline__ float gelu_erf(float x) { return 0.5f * x * (1.0f + erff(x * 0.70710678118654752f)); }

__device__ __forceinline__ void peer_select_phase(const Params& p, LAS unsigned char* lds) {
    unsigned char* ws = p.ws;
    const bf16* PQB = (const bf16*)(ws + WS_PQB);
    const bf16* SUBK = (const bf16*)(ws + WS_SUBK);
    const bf16* PU = (const bf16*)(ws + WS_PU);
    const bf16* PVt = (const bf16*)(ws + WS_PV);
    const float* H = (const float*)(ws + WS_H);
    const float* SS2 = (const float*)(ws + WS_CTL + CTL_SS2);
    const float* gffn = p.in[27]; const float* gfin = p.in[32];
    float* Y = p.out + O_Y;
    const int tid = tidx(), lane = tid & 63, wv = tid >> 6, r = lane & 15, q = lane >> 4;
    LAS float* TOP = (LAS float*)(lds + PE_TOP);
    unsigned short* GSELI = (unsigned short*)(ws + WS_SELI);
    float* GSELG = (float*)(ws + WS_SELG);
    LAS unsigned char* PT = lds + PE_PT;

    for (int chunk = blockIdx.x; chunk < T / PE_TOK; chunk += gridDim.x) {
        const int tok0 = chunk * PE_TOK;
        __syncthreads();
#pragma unroll
        for (int i = 0; i < 8; ++i) {
            const int e = tid + i * NT, row = e >> 4, c16 = e & 15;
            *(LAS u32x4*)(lds + PE_SUBK + row * PE_KSTR + c16 * 16) = *(const u32x4*)(SUBK + (size_t)row * 128 + c16 * 8);
        }
        if (tid < 64) {
            int i = 0, base = 0, k = tid;
            if (k < 50) { while (k - base >= 16 / (i + 1)) { base += 16 / (i + 1); ++i; } PT[k] = (unsigned char)((i << 4) | (k - base)); }
            else PT[k] = 0;
        }
        __syncthreads();
        {
            const int h = wv;
            for (int nt = 0; nt < 5; ++nt) {
                const int tl = nt * 16 + r;
                const int t = tok0 + (tl < PE_TOK ? tl : PE_TOK - 1);
#pragma unroll
                for (int c = 0; c < 2; ++c) {
                    bf16x8 qf[4];
#pragma unroll
                    for (int ks = 0; ks < 4; ++ks) qf[ks] = *(const bf16x8*)(PQB + (size_t)t * 2048 + h * 256 + c * 128 + 32 * ks + 8 * q);
                    f32x4 acc[8];
#pragma unroll
                    for (int mt = 0; mt < 8; ++mt) acc[mt] = (f32x4){0.f, 0.f, 0.f, 0.f};
#pragma unroll
                    for (int ks = 0; ks < 4; ++ks)
#pragma unroll
                        for (int mt = 0; mt < 8; ++mt) {
                            const bf16x8 a = *(const LAS bf16x8*)(lds + PE_SUBK + (c * 128 + 16 * mt + r) * PE_KSTR + (32 * ks + 8 * q) * 2);
                            acc[mt] = __builtin_amdgcn_mfma_f32_16x16x32_bf16(a, qf[ks], acc[mt], 0, 0, 0);
                        }
                    float v[32];
#pragma unroll
                    for (int mt = 0; mt < 8; ++mt)
#pragma unroll
                        for (int j = 0; j < 4; ++j) v[mt * 4 + j] = __uint_as_float((__float_as_uint(acc[mt][j]) & ~127u) | (unsigned)(16 * mt + 4 * q + j));
                    float top[16];
#pragma unroll
                    for (int rd = 0; rd < 16; ++rd) {
                        float m = v[0];
#pragma unroll
                        for (int i = 1; i < 32; ++i) m = fmaxf(m, v[i]);
                        m = fmaxf(m, __shfl_xor(m, 16)); m = fmaxf(m, __shfl_xor(m, 32));
                        top[rd] = m;
#pragma unroll
                        for (int i = 0; i < 32; ++i) v[i] = (v[i] == m) ? -3.0e38f : v[i];
                    }
                    if (q == 0 && tl < PE_TOK) {
                        LAS float* dst = TOP + (tl * 8 + h) * 33 + c * 16;
#pragma unroll
                        for (int i = 0; i < 16; ++i) dst[i] = top[i];
                    }
                }
            }
        }
        __syncthreads();
        for (int pr = tid; pr < PE_TOK * 8; pr += NT) {
            const LAS float* tp = TOP + pr * 33;
            float A[16], B[16];
#pragma unroll
            for (int i = 0; i < 16; ++i) { A[i] = tp[i]; B[i] = tp[16 + i]; }
            float cd[50];
            {
                int k = 0;
#pragma unroll
                for (int i = 0; i < 16; ++i)
#pragma unroll
                    for (int j = 0; j < 16; ++j)
                        if ((i + 1) * (j + 1) <= 16) { cd[k] = __uint_as_float((__float_as_uint(A[i] + B[j]) & ~63u) | (unsigned)k); ++k; }
            }
            float win[16];
#pragma unroll
            for (int rd = 0; rd < 16; ++rd) {
                float m = cd[0];
#pragma unroll
                for (int i = 1; i < 50; ++i) m = fmaxf(m, cd[i]);
                win[rd] = m;
#pragma unroll
                for (int i = 0; i < 50; ++i) cd[i] = (cd[i] == m) ? -3.0e38f : cd[i];
            }
            float e[16], sum = 0.f;
#pragma unroll
            for (int rd = 0; rd < 16; ++rd) { e[rd] = __expf(win[rd] - win[0]); sum += e[rd]; }
            const float inv = 1.0f / sum;
            const int tl = pr >> 3, h = pr & 7;
#pragma unroll
            for (int rd = 0; rd < 16; ++rd) {
                const unsigned k = __float_as_uint(win[rd]) & 63u;
                const unsigned ij = PT[k];
                const unsigned ka = __float_as_uint(tp[ij >> 4]) & 127u, kb = __float_as_uint(tp[16 + (ij & 15)]) & 127u;
                GSELI[(size_t)(tok0 + tl) * 128 + h * 16 + rd] = (unsigned short)(ka * 128u + kb);
                GSELG[(size_t)(tok0 + tl) * 128 + h * 16 + rd] = e[rd] * inv;
            }
        }
        __syncthreads();
    }
}

constexpr float PE_USCALE = 64.0f, PE_VSCALE = 8.0f;
typedef float f32x2 __attribute__((ext_vector_type(2)));

__device__ __forceinline__ void cvt_peer_tables(const float* __restrict__ src, unsigned char* __restrict__ dst, float scale, int vb, int nvb) {
    const size_t npieces = (size_t)16384 * 64;
    for (size_t i = (size_t)vb * NT + tidx(); i < npieces; i += (size_t)nvb * NT) {
        const size_t e = i >> 6; const int cc = (int)(i & 63);
        const float4* s = (const float4*)(src + e * 1024 + cc * 16);
        const float4 a = s[0], b = s[1], c = s[2], d = s[3];
        u32x4 w;
        int t = 0;
        t = __builtin_amdgcn_cvt_pk_fp8_f32(a.x * scale, a.y * scale, t, false); t = __builtin_amdgcn_cvt_pk_fp8_f32(a.z * scale, a.w * scale, t, true); w.x = (unsigned)t;
        t = __builtin_amdgcn_cvt_pk_fp8_f32(b.x * scale, b.y * scale, t, false); t = __builtin_amdgcn_cvt_pk_fp8_f32(b.z * scale, b.w * scale, t, true); w.y = (unsigned)t;
        t = __builtin_amdgcn_cvt_pk_fp8_f32(c.x * scale, c.y * scale, t, false); t = __builtin_amdgcn_cvt_pk_fp8_f32(c.z * scale, c.w * scale, t, true); w.z = (unsigned)t;
        t = __builtin_amdgcn_cvt_pk_fp8_f32(d.x * scale, d.y * scale, t, false); t = __builtin_amdgcn_cvt_pk_fp8_f32(d.z * scale, d.w * scale, t, true); w.w = (unsigned)t;
        *(u32x4*)(dst + ((size_t)(cc >> 3) * 16384 + e) * 128 + 16 * (cc & 7)) = w;
    }
}
__device__ __forceinline__ void fp8x16_to_f32(const u32x4& w, float (&v)[16]) {
    const unsigned ww[4] = {w.x, w.y, w.z, w.w};
#pragma unroll
    for (int k = 0; k < 4; ++k) {
        const f32x2 lo = __builtin_amdgcn_cvt_pk_f32_fp8((int)ww[k], false), hi = __builtin_amdgcn_cvt_pk_f32_fp8((int)ww[k], true);
        v[4 * k] = lo[0]; v[4 * k + 1] = lo[1]; v[4 * k + 2] = hi[0]; v[4 * k + 3] = hi[1];
    }
}
__device__ __forceinline__ void peer_part_rank(int& part, int& rank, int& nrank, int& npass) {
    const int G = gridDim.x;
    if ((G & 7) == 0) { part = blockIdx.x & 7; rank = blockIdx.x >> 3; nrank = G >> 3; npass = 1; }
    else { part = 0; rank = blockIdx.x; nrank = G; npass = 8; }
}

__device__ __forceinline__ void pe_load_half(const unsigned char* tabu, const unsigned (&idx)[8], int h, u32x4 (&R)[8], int cb) {
#pragma unroll
    for (int i = 0; i < 4; ++i) {
        const unsigned w = idx[4 * h + i];
        R[2 * i] = *(const u32x4*)(tabu + (size_t)((w & 0xffffu) * 128u + 16u * cb));
        R[2 * i + 1] = *(const u32x4*)(tabu + (size_t)((w >> 16) * 128u + 16u * cb));
    }
}
__device__ __forceinline__ void pe_load_idx(const unsigned short* GSELI, int t, int rowi, unsigned (&idx)[8]) {
#pragma unroll
    for (int i = 0; i < 8; ++i) idx[i] = (unsigned)GSELI[(size_t)t * 128 + 16 * i + rowi] | ((unsigned)GSELI[(size_t)t * 128 + 16 * i + 8 + rowi] << 16);
}
__device__ __forceinline__ void fp8x16_to_f32x2(const u32x4& w, f32x2 (&v)[8]) {
    const unsigned ww[4] = {w.x, w.y, w.z, w.w};
#pragma unroll
    for (int k = 0; k < 4; ++k) { v[2 * k] = __builtin_amdgcn_cvt_pk_f32_fp8((int)ww[k], false); v[2 * k + 1] = __builtin_amdgcn_cvt_pk_f32_fp8((int)ww[k], true); }
}

__device__ __forceinline__ void peer_u_phase(const Params& p, LAS unsigned char* lds) {
    unsigned char* ws = p.ws;
    const unsigned char* UP = ws + WS_PU;
    const unsigned short* GSELI = (const unsigned short*)(ws + WS_SELI);
    float* PART = (float*)(ws + WS_PART);
    const float* H = (const float*)(ws + WS_H);
    const float* SS2 = (const float*)(ws + WS_CTL + CTL_SS2);
    const float* gffn = p.in[27];
    const int lane = tidx() & 63, wv = tidx() >> 6, rowi = lane >> 3, cb = lane & 7;
    int part0, rank, nrank, npass; peer_part_rank(part0, rank, nrank, npass);
    const int step = nrank * 8;
    for (int pass = 0; pass < npass; ++pass) {
        const int part = part0 + pass;
        const unsigned char* tabu = UP + (size_t)part * 16384 * 128;
        int t = rank * 8 + wv;
        if (t >= T) continue;
        unsigned idxA[8], idxB[8];
        u32x4 RA[8], RB[8];
        pe_load_idx(GSELI, t, rowi, idxA);
        if (t + step < T) pe_load_idx(GSELI, t + step, rowi, idxB);
        pe_load_half(tabu, idxA, 0, RA, cb);
        f32x2 xs[8];
#define PE_U_HALF(R, h) do { \
            _Pragma("unroll") for (int i = 0; i < 8; ++i) { \
                f32x2 v[8]; fp8x16_to_f32x2(R[i], v); \
                f32x2 d2 = v[0] * xs[0]; \
                _Pragma("unroll") for (int k = 1; k < 8; ++k) d2 = __builtin_elementwise_fma(v[k], xs[k], d2); \
                float d = d2[0] + d2[1]; \
                d += dppf<0xB1>(d); d += dppf<0x4E>(d); d += dppf<0x141>(d); \
                if (cb == 0) PART[((size_t)part * T + t) * 128 + 8 * (8 * (h) + i) + rowi] = d; \
                __builtin_amdgcn_sched_barrier(0); } } while (0)
#define PE_U_TOKEN(IDXC, IDXN) do { \
            pe_load_half(tabu, IDXC, 1, RB, cb); \
            { const float rstd2 = rsqrtf(SS2[t] * (1.0f / 1024.0f) + 1e-6f) * (1.0f / PE_USCALE); \
              _Pragma("unroll") for (int i = 0; i < 4; ++i) { const float4 h4 = *(const float4*)(H + (size_t)t * 1024 + 128 * part + 16 * cb + 4 * i); \
                const float4 g4 = *(const float4*)(gffn + 128 * part + 16 * cb + 4 * i); \
                xs[2 * i] = (f32x2){h4.x * rstd2 * g4.x, h4.y * rstd2 * g4.y}; xs[2 * i + 1] = (f32x2){h4.z * rstd2 * g4.z, h4.w * rstd2 * g4.w}; } } \
            __builtin_amdgcn_sched_barrier(0); \
            PE_U_HALF(RA, 0); \
            if (t + step < T) pe_load_half(tabu, IDXN, 0, RA, cb); \
            __builtin_amdgcn_sched_barrier(0); \
            PE_U_HALF(RB, 1); \
            if (t + 2 * step < T) pe_load_idx(GSELI, t + 2 * step, rowi, IDXC); } while (0)
        for (;;) {
            PE_U_TOKEN(idxA, idxB);
            t += step; if (t >= T) break;
            PE_U_TOKEN(idxB, idxA);
            t += step; if (t >= T) break;
        }
#undef PE_U_TOKEN
#undef PE_U_HALF
    }
}

__device__ __forceinline__ void peer_v_phase(const Params& p, LAS unsigned char* lds) {
    unsigned char* ws = p.ws;
    const unsigned char* VP = ws + WS_PV;
    const unsigned short* GSELI = (const unsigned short*)(ws + WS_SELI);
    const float* COEF = (const float*)(ws + WS_COEF);
    float* H = (float*)(ws + WS_H);
    float* SS3 = (float*)(ws + WS_CTL + CTL_SS3);
    const int lane = tidx() & 63, wv = tidx() >> 6, rowi = lane >> 3, cb = lane & 7;
    LAS float* cw = (LAS float*)lds + wv * 128;
    int part0, rank, nrank, npass; peer_part_rank(part0, rank, nrank, npass);
    const int step = nrank * 8;
    for (int pass = 0; pass < npass; ++pass) {
        const int part = part0 + pass;
        const unsigned char* tabu = VP + (size_t)part * 16384 * 128;
        int t = rank * 8 + wv;
        if (t >= T) continue;
        unsigned idxA[8], idxB[8];
        u32x4 RA[8], RB[8];
        pe_load_idx(GSELI, t, rowi, idxA);
        if (t + step < T) pe_load_idx(GSELI, t + step, rowi, idxB);
        pe_load_half(tabu, idxA, 0, RA, cb);
        f32x2 acc[8];
#define PE_V_HALF(R, h) do { \
            _Pragma("unroll") for (int i = 0; i < 8; ++i) { \
                const float c = cw[8 * (8 * (h) + i) + rowi]; const f32x2 c2 = (f32x2){c, c}; \
                f32x2 v[8]; fp8x16_to_f32x2(R[i], v); \
                _Pragma("unroll") for (int k = 0; k < 8; ++k) acc[k] = __builtin_elementwise_fma(v[k], c2, acc[k]); \
                __builtin_amdgcn_sched_barrier(0); } } while (0)
#define PE_V_TOKEN(IDXC, IDXN) do { \
            pe_load_half(tabu, IDXC, 1, RB, cb); \
            cw[lane] = COEF[(size_t)t * 128 + lane]; cw[64 + lane] = COEF[(size_t)t * 128 + 64 + lane]; \
            _Pragma("unroll") for (int k = 0; k < 8; ++k) acc[k] = (f32x2){0.f, 0.f}; \
            __builtin_amdgcn_sched_barrier(0); \
            PE_V_HALF(RA, 0); \
            if (t + step < T) pe_load_half(tabu, IDXN, 0, RA, cb); \
            __builtin_amdgcn_sched_barrier(0); \
            PE_V_HALF(RB, 1); \
            _Pragma("unroll") for (int k = 0; k < 8; ++k) { \
                acc[k][0] += __shfl_xor(acc[k][0], 8); acc[k][1] += __shfl_xor(acc[k][1], 8); \
                acc[k][0] += __shfl_xor(acc[k][0], 16); acc[k][1] += __shfl_xor(acc[k][1], 16); \
                acc[k][0] += __shfl_xor(acc[k][0], 32); acc[k][1] += __shfl_xor(acc[k][1], 32); } \
            float ss = 0.f; \
            if (rowi == 0) { \
                float* hp = H + (size_t)t * 1024 + 128 * part + 16 * cb; \
                _Pragma("unroll") for (int i = 0; i < 4; ++i) { \
                    float4 h4 = *(const float4*)(hp + 4 * i); \
                    h4.x += acc[2 * i][0]; h4.y += acc[2 * i][1]; h4.z += acc[2 * i + 1][0]; h4.w += acc[2 * i + 1][1]; \
                    ss += h4.x * h4.x + h4.y * h4.y + h4.z * h4.z + h4.w * h4.w; \
                    *(float4*)(hp + 4 * i) = h4; } } \
            ss += dppf<0xB1>(ss); ss += dppf<0x4E>(ss); ss += dppf<0x141>(ss); \
            if (lane == 0) atomicAdd(SS3 + t, ss); \
            if (t + 2 * step < T) pe_load_idx(GSELI, t + 2 * step, rowi, IDXC); } while (0)
        for (;;) {
            PE_V_TOKEN(idxA, idxB);
            t += step; if (t >= T) break;
            PE_V_TOKEN(idxB, idxA);
            t += step; if (t >= T) break;
        }
#undef PE_V_TOKEN
#undef PE_V_HALF
    }
}

__device__ __forceinline__ void peer_coef_phase(const Params& p) {
    const float* GSELG = (const float*)(p.ws + WS_SELG);
    float* COEF = (float*)(p.ws + WS_COEF);
    const float* PART = (const float*)(p.ws + WS_PART);
    const size_t n = (size_t)T * 128;
    for (size_t i = (size_t)blockIdx.x * NT + tidx(); i < n; i += (size_t)gridDim.x * NT) {
        float s = 0.f;
#pragma unroll
        for (int pp = 0; pp < 8; ++pp) s += PART[(size_t)pp * n + i];
        COEF[i] = GSELG[i] * gelu_erf(s) * (1.0f / PE_VSCALE);
    }
}

__device__ __forceinline__ void final_norm_phase(const Params& p) {
    const float* H = (const float*)(p.ws + WS_H);
    const float* SS3 = (const float*)(p.ws + WS_CTL + CTL_SS3);
    const float* gfin = p.in[32];
    float* Y = p.out + O_Y;
    const int lane = tidx() & 63, wv = tidx() >> 6;
    for (int t = blockIdx.x * 8 + wv; t < T; t += gridDim.x * 8) {
        const float rs = rsqrtf(SS3[t] * (1.0f / 1024.0f) + 1e-6f);
#pragma unroll
        for (int i = 0; i < 4; ++i) {
            const float4 h4 = ((const float4*)(H + (size_t)t * 1024))[lane + 64 * i], g4 = ((const float4*)gfin)[lane + 64 * i];
            float4 o; o.x = h4.x * rs * g4.x; o.y = h4.y * rs * g4.y; o.z = h4.z * rs * g4.z; o.w = h4.w * rs * g4.w;
            ((float4*)(Y + (size_t)t * 1024))[lane + 64 * i] = o;
        }
    }
}


__device__ __forceinline__ bf16x8 frag_tr(const LAS unsigned char* base, int stride, int k0, int n0, int r, int q) {
    const LAS unsigned char* a0 = base + (k0 + 4 * q + (r >> 2)) * stride + (n0 + 4 * (r & 3)) * 2;
    const s16x4 lo = __builtin_amdgcn_ds_read_tr16_b64_v4i16((LAS s16x4*)a0);
    const s16x4 hi = __builtin_amdgcn_ds_read_tr16_b64_v4i16((LAS s16x4*)(a0 + 16 * stride));
    bf16x8 o; o[0] = lo[0]; o[1] = lo[1]; o[2] = lo[2]; o[3] = lo[3]; o[4] = hi[0]; o[5] = hi[1]; o[6] = hi[2]; o[7] = hi[3];
    return o;
}
__device__ __forceinline__ bf16x8 frag_kc_pk(const LAS unsigned char* base, int stride, int m0, int k0, int r, int q) {
    const LAS unsigned char* a0 = base + (m0 + r) * stride + (k0 + 4 * q) * 2;
    const u32x2 lo = *(const LAS u32x2*)a0, hi = *(const LAS u32x2*)(a0 + 32);
    u32x4 w; w.x = lo.x; w.y = lo.y; w.z = hi.x; w.w = hi.y;
    return __builtin_bit_cast(bf16x8, w);
}
__device__ __forceinline__ bf16x8 frag_kc(const LAS unsigned char* base, int stride, int m0, int k0, int r, int q) {
    return *(const LAS bf16x8*)(base + (m0 + r) * stride + (k0 + 8 * q) * 2);
}
__device__ __forceinline__ float softplus_f(float x) { return x > 20.f ? x : log1pf(__expf(x)); }
__device__ __forceinline__ float silu_f(float x) { return x * __builtin_amdgcn_rcpf(1.0f + __expf(-x)); }


__device__ __forceinline__ void ssd_conv_prepass(const Params& p, bf16* XBCA) {
    const bf16* PROJB = (const bf16*)(p.ws + WS_PROJB);
    const float* conv_w = p.in[15]; const float* conv_b = p.in[16];
    const int npieces = T * 192;
    for (int e = blockIdx.x * NT + tidx(); e < npieces; e += gridDim.x * NT) {
        const int t = e / 192, pc = e - t * 192, col = pc * 8;
        int l, t0; const float* hist;
        if (t < TP) { l = t & (SEQ - 1); t0 = t - l; hist = nullptr; }
        else { const int b = (t - TP) / DECS; l = (t - TP) - b * DECS; t0 = t - l; hist = p.in[4] + (size_t)b * 3 * SSM_XBC; }
        float acc[8];
        { const float4 b0 = *(const float4*)(conv_b + col), b1 = *(const float4*)(conv_b + col + 4);
          acc[0] = b0.x; acc[1] = b0.y; acc[2] = b0.z; acc[3] = b0.w; acc[4] = b1.x; acc[5] = b1.y; acc[6] = b1.z; acc[7] = b1.w; }
#pragma unroll
        for (int tp = 0; tp < 4; ++tp) {
            const int ls = l - 3 + tp;
            float xv[8];
            if (ls >= 0) {
                const u32x4 rv = *(const u32x4*)(PROJB + (size_t)(t0 + ls) * PROJW + 3072 + col);
                xv[0] = __uint_as_float(rv.x << 16); xv[1] = __uint_as_float(rv.x & 0xffff0000u); xv[2] = __uint_as_float(rv.y << 16); xv[3] = __uint_as_float(rv.y & 0xffff0000u);
                xv[4] = __uint_as_float(rv.z << 16); xv[5] = __uint_as_float(rv.z & 0xffff0000u); xv[6] = __uint_as_float(rv.w << 16); xv[7] = __uint_as_float(rv.w & 0xffff0000u);
            } else if (hist) {
                const float* s = hist + (size_t)(3 + ls) * SSM_XBC + col;
                const float4 a = *(const float4*)s, bb = *(const float4*)(s + 4);
                xv[0] = bf2f(f2bf(a.x)); xv[1] = bf2f(f2bf(a.y)); xv[2] = bf2f(f2bf(a.z)); xv[3] = bf2f(f2bf(a.w));
                xv[4] = bf2f(f2bf(bb.x)); xv[5] = bf2f(f2bf(bb.y)); xv[6] = bf2f(f2bf(bb.z)); xv[7] = bf2f(f2bf(bb.w));
            } else {
#pragma unroll
                for (int k = 0; k < 8; ++k) xv[k] = 0.f;
            }
            const float4 w0 = *(const float4*)(conv_w + tp * SSM_XBC + col), w1 = *(const float4*)(conv_w + tp * SSM_XBC + col + 4);
            acc[0] += w0.x * xv[0]; acc[1] += w0.y * xv[1]; acc[2] += w0.z * xv[2]; acc[3] += w0.w * xv[3];
            acc[4] += w1.x * xv[4]; acc[5] += w1.y * xv[5]; acc[6] += w1.z * xv[6]; acc[7] += w1.w * xv[7];
        }
        u32x4 o; o.x = pack2(silu_f(acc[0]), silu_f(acc[1])); o.y = pack2(silu_f(acc[2]), silu_f(acc[3])); o.z = pack2(silu_f(acc[4]), silu_f(acc[5])); o.w = pack2(silu_f(acc[6]), silu_f(acc[7]));
        *(u32x4*)(XBCA + (size_t)t * SSM_XBC + col) = o;
    }
}

__device__ __forceinline__ void ssd_scalar_prepass(const Params& p, float* SCAL) {
    const float* SMALL = (const float*)(p.ws + WS_SMALL);
    const int lane = tidx() & 63, wv = tidx() >> 6;
    for (int task = blockIdx.x * 8 + wv; task < (256 + 128) * 16; task += gridDim.x * 8) {
        const int cg = task >> 4, head = task & 15;
        const int t0 = cg < 256 ? cg * 64 : TP + (cg - 256) * DECS, nvalid = cg < 256 ? 64 : DECS;
        const bool valid = lane < nvalid;
        const float Ah = -__expf(p.in[17][head]), dtb = p.in[18][head];
        const float dt = valid ? softplus_f(SMALL[(size_t)(t0 + (valid ? lane : 0)) * 32 + 16 + head] + dtb) : 0.f;
        float acs = dt * Ah;
#pragma unroll
        for (int o = 1; o < 64; o <<= 1) { const float up = __shfl_up(acs, o); if (lane >= o) acs += up; }
        const float last = __shfl(acs, 63);
        float* dst = SCAL + (size_t)task * 256;
        dst[lane] = dt; dst[64 + lane] = acs; dst[128 + lane] = dt * __expf(last - acs); dst[192 + lane] = __expf(acs);
    }
}

constexpr int SD_XS = 160, SD_BS = 288, SD_CS = 272, SD_ZS = 144, SD_SS = 160;
constexpr int SD_XN = 0;
constexpr int SD_XW = SD_XN + 64 * 160;
constexpr int SD_BN = SD_XW + 64 * 160;
constexpr int SD_CN = SD_BN + 64 * 288;
constexpr int SD_ZN = SD_CN + 64 * 272;
constexpr int SD_SC = SD_ZN + 64 * 144;
constexpr int SD_TBUF = SD_SC + 1024;
constexpr int SD_ST = 2 * SD_TBUF;
constexpr int SD_END = SD_ST + 128 * 160;
static_assert(SD_END <= LDS_MISC, "SSD LDS budget");

__device__ __forceinline__ void ssd_load_chunk(const Params& p, const bf16* XBCA, const float* SCAL, u32x4 (&rg)[5], u32x4& rz, float& rs, float& rw, int c, int cg, int head, int g, int t0, int nvalid) {
    const bf16* PROJB = (const bf16*)(p.ws + WS_PROJB);
    const int tid = tidx();
#pragma unroll
    for (int i = 0; i < 5; ++i) {
        const int e = tid + NT * i;
        int l, col;
        if (e < 512) { l = e >> 3; col = head * 64 + (e & 7) * 8; }
        else if (e < 1536) { l = (e - 512) >> 4; col = 1024 + g * 128 + ((e - 512) & 15) * 8; }
        else { l = (e - 1536) >> 4; col = 1280 + g * 128 + ((e - 1536) & 15) * 8; }
        rg[i] = (l < nvalid) ? *(const u32x4*)(XBCA + (size_t)(t0 + c * 64 + l) * SSM_XBC + col) : (u32x4){0u, 0u, 0u, 0u};
    }
    { const int l = tid >> 3; rz = (l < nvalid) ? *(const u32x4*)(PROJB + (size_t)(t0 + c * 64 + l) * PROJW + 5632 + head * 64 + (tid & 7) * 8) : (u32x4){0u, 0u, 0u, 0u}; }
    const float* sp = SCAL + ((size_t)cg * 16 + head) * 256;
    rs = sp[tid & 255]; rw = sp[128 + (tid >> 3)];
}

template <bool YGF32>
__device__ __forceinline__ void ssd_stream(const Params& p, LAS unsigned char* lds, bool prompt, int b, int head, void* YG, const bf16* XBCA, const float* SCAL) {
    const int tid = tidx(), lane = tid & 63, wv = tid >> 6, r = lane & 15, q = lane >> 4;
    const int g = head >> 3;
    const int nchunks = prompt ? 32 : 1, nvalid = prompt ? 64 : DECS, t0 = prompt ? b * SEQ : TP + b * DECS;
    const int cg0 = prompt ? b * 32 : 256 + b;
    const float Dh = p.in[19][head];

    const int pt_s = wv & 3, nh = wv >> 2;
    f32x4 Sacc[4];
#pragma unroll
    for (int i = 0; i < 4; ++i) {
        if (prompt) Sacc[i] = (f32x4){0.f, 0.f, 0.f, 0.f};
        else {
            const float* s0 = p.in[5] + (((size_t)b * 16 + head) * 64 + 16 * pt_s + 4 * q) * 128 + 16 * (4 * nh + i) + r;
            Sacc[i] = (f32x4){s0[0], s0[128], s0[256], s0[384]};
        }
    }
    u32x4 rg[5], rz; float rs, rw;
    ssd_load_chunk(p, XBCA, SCAL, rg, rz, rs, rw, 0, cg0, head, g, t0, nvalid);
    __syncthreads();
#pragma unroll
    for (int i = 0; i < 4; ++i) {
        u32x2 w; w.x = pack2(Sacc[i][0], Sacc[i][1]); w.y = pack2(Sacc[i][2], Sacc[i][3]);
        *(LAS u32x2*)(lds + SD_ST + (16 * (4 * nh + i) + r) * SD_SS + (16 * pt_s + 4 * q) * 2) = w;
    }
    for (int c = 0; c < nchunks; ++c) {
        LAS unsigned char* tb = lds + (c & 1) * SD_TBUF;
        LAS float* SC = (LAS float*)(tb + SD_SC);
#pragma unroll
        for (int i = 0; i < 5; ++i) {
            const int e = tid + NT * i;
            if (e < 512) *(LAS u32x4*)(tb + SD_XN + (e >> 3) * SD_XS + (e & 7) * 16) = rg[i];
            else if (e < 1536) *(LAS u32x4*)(tb + SD_BN + ((e - 512) >> 4) * SD_BS + ((e - 512) & 15) * 16) = rg[i];
            else *(LAS u32x4*)(tb + SD_CN + ((e - 1536) >> 4) * SD_CS + ((e - 1536) & 15) * 16) = rg[i];
        }
        *(LAS u32x4*)(tb + SD_ZN + (tid >> 3) * SD_ZS + (tid & 7) * 16) = rz;
        if (tid < 256) SC[tid] = rs;
        {
            const u32x4 xv = rg[0];
            u32x4 o2;
            o2.x = pack2(__uint_as_float(xv.x << 16) * rw, __uint_as_float(xv.x & 0xffff0000u) * rw); o2.y = pack2(__uint_as_float(xv.y << 16) * rw, __uint_as_float(xv.y & 0xffff0000u) * rw);
            o2.z = pack2(__uint_as_float(xv.z << 16) * rw, __uint_as_float(xv.z & 0xffff0000u) * rw); o2.w = pack2(__uint_as_float(xv.w << 16) * rw, __uint_as_float(xv.w & 0xffff0000u) * rw);
            *(LAS u32x4*)(tb + SD_XW + (tid >> 3) * SD_XS + (tid & 7) * 16) = o2;
        }
        if (c + 1 < nchunks) ssd_load_chunk(p, XBCA, SCAL, rg, rz, rs, rw, c + 1, cg0 + c + 1, head, g, t0, nvalid);
        __syncthreads();
        {
            const int lt = wv & 3, ph = wv >> 2;
            f32x4 Y[2] = {(f32x4){0.f, 0.f, 0.f, 0.f}, (f32x4){0.f, 0.f, 0.f, 0.f}};
#pragma unroll
            for (int ks = 0; ks < 4; ++ks) {
                const bf16x8 a = frag_kc_pk(tb + SD_CN, SD_CS, 16 * lt, 32 * ks, r, q);
#pragma unroll
                for (int pi = 0; pi < 2; ++pi) {
                    const bf16x8 bb = frag_tr(lds + SD_ST, SD_SS, 32 * ks, 16 * (2 * ph + pi), r, q);
                    Y[pi] = __builtin_amdgcn_mfma_f32_16x16x32_bf16(a, bb, Y[pi], 0, 0, 0);
                }
            }
#pragma unroll
            for (int j = 0; j < 4; ++j) { const float ea = SC[192 + 16 * lt + 4 * q + j]; Y[0][j] *= ea; Y[1][j] *= ea; }
            f32x4 G[4];
            const float acs_l = SC[64 + 16 * lt + r];
#pragma unroll
            for (int mt = 0; mt < 4; ++mt) {
                G[mt] = (f32x4){0.f, 0.f, 0.f, 0.f};
                if (mt <= lt) {
#pragma unroll
                    for (int ks = 0; ks < 4; ++ks) {
                        const bf16x8 a = frag_kc(tb + SD_BN, SD_BS, 16 * mt, 32 * ks, r, q);
                        const bf16x8 bb = frag_kc(tb + SD_CN, SD_CS, 16 * lt, 32 * ks, r, q);
                        G[mt] = __builtin_amdgcn_mfma_f32_16x16x32_bf16(a, bb, G[mt], 0, 0, 0);
                    }
#pragma unroll
                    for (int j = 0; j < 4; ++j) {
                        const int lp = 16 * mt + 4 * q + j, l = 16 * lt + r;
                        G[mt][j] = (lp <= l) ? G[mt][j] * __expf(acs_l - SC[64 + lp]) * SC[lp] : 0.f;
                    }
                }
            }
#pragma unroll
            for (int s = 0; s < 2; ++s) {
                if (2 * s <= lt) {
                    const bf16x8 a = pack8(G[2 * s], G[2 * s + 1]);
#pragma unroll
                    for (int pi = 0; pi < 2; ++pi) {
                        const bf16x8 bb = frag_tr(tb + SD_XN, SD_XS, 32 * s, 16 * (2 * ph + pi), r, q);
                        Y[pi] = __builtin_amdgcn_mfma_f32_16x16x32_bf16(a, bb, Y[pi], 0, 0, 0);
                    }
                }
            }
#pragma unroll
            for (int pi = 0; pi < 2; ++pi)
#pragma unroll
                for (int j = 0; j < 4; ++j) {
                    const int l = 16 * lt + 4 * q + j, pp = 16 * (2 * ph + pi) + r;
                    if (l < nvalid) {
                        const size_t t = (size_t)(t0 + c * 64 + l);
                        const float x = bf2f(*(const LAS bf16*)(tb + SD_XN + l * SD_XS + pp * 2));
                        const float z = bf2f(*(const LAS bf16*)(tb + SD_ZN + l * SD_ZS + pp * 2));
                        const float yv = (Y[pi][j] + Dh * x) * silu_f(z);
                        if (YGF32) ((float*)YG)[t * 1024 + head * 64 + pp] = yv; else ((bf16*)YG)[t * 1024 + head * 64 + pp] = f2bf(yv);
                    }
                }
        }
        __syncthreads();
        {
            const float dec = SC[192 + 63];
#pragma unroll
            for (int i = 0; i < 4; ++i) {
                f32x4 acc = Sacc[i] * dec;
#pragma unroll
                for (int s = 0; s < 2; ++s) {
                    const bf16x8 a = frag_tr(tb + SD_XW, SD_XS, 32 * s, 16 * pt_s, r, q);
                    const bf16x8 bb = frag_tr(tb + SD_BN, SD_BS, 32 * s, 16 * (4 * nh + i), r, q);
                    acc = __builtin_amdgcn_mfma_f32_16x16x32_bf16(a, bb, acc, 0, 0, 0);
                }
                Sacc[i] = acc;
                u32x2 w; w.x = pack2(acc[0], acc[1]); w.y = pack2(acc[2], acc[3]);
                *(LAS u32x2*)(lds + SD_ST + (16 * (4 * nh + i) + r) * SD_SS + (16 * pt_s + 4 * q) * 2) = w;
            }
        }
    }
    float* so = p.out + (prompt ? O_P_SS : O_S_SS) + (((size_t)b * 16 + head) * 64) * 128;
#pragma unroll
    for (int i = 0; i < 4; ++i)
#pragma unroll
        for (int j = 0; j < 4; ++j) so[(size_t)(16 * pt_s + 4 * q + j) * 128 + 16 * (4 * nh + i) + r] = Sacc[i][j];
}

constexpr size_t DN_ITEM_BYTES = 73728;
constexpr int DN_NITEMS = 2048 + 1024;
constexpr size_t WS_DNI = WS_MIX;
constexpr size_t WS_DNGT = WS_DNI + (size_t)DN_NITEMS * DN_ITEM_BYTES;

constexpr int DP_RAW = 0, DP_RAWS = 784;
constexpr int DP_QN = 52736, DP_TS = 272;
constexpr int DP_KN = DP_QN + 64 * 272;
constexpr int DP_KB = DP_KN + 64 * 272;
constexpr int DP_VN = DP_KB + 64 * 272;
constexpr int DP_LB = DP_VN + 64 * 272, DP_LS = 144;
constexpr int DP_LF = DP_LB + 64 * 144;
constexpr int DP_TD = DP_LF + 4 * 16 * 17 * 4, DP_TDS = 80;
constexpr int DP_SC = DP_TD + 64 * 80;
constexpr int DP_END = DP_SC + 1024;

__device__ __forceinline__ float sigmoid_f(float x) { return __builtin_amdgcn_rcpf(1.0f + __expf(-x)); }

__device__ __forceinline__ void dn_item_decode(int item, bool& prompt, int& b, int& h, int& c) {
    prompt = item < 2048;
    if (prompt) { b = item >> 8; h = (item >> 5) & 7; c = item & 31; } else { b = (item - 2048) >> 3; h = (item - 2048) & 7; c = 0; }
}
__device__ __forceinline__ void dn_load_raw(const Params& p, int item, u32x4 (&raw)[7]) {
    const bf16* PROJB = (const bf16*)(p.ws + WS_PROJB);
    bool prompt; int b, h, c; dn_item_decode(item, prompt, b, h, c);
    const int nvalid = prompt ? 64 : DECS, t0 = prompt ? b * SEQ : TP + b * DECS;
    const int tid = tidx(), pcx = tid & 15, rg = tid >> 4;
#pragma unroll
    for (int i = 0; i < 6; ++i) {
        const int part = i >> 1, l = (i & 1) * 32 + rg;
        raw[i] = (l < nvalid) ? *(const u32x4*)(PROJB + (size_t)(t0 + c * 64 + l) * PROJW + part * 1024 + h * 128 + pcx * 8) : (u32x4){0u, 0u, 0u, 0u};
    }
    u32x4 v = (u32x4){0u, 0u, 0u, 0u};
    if (tid < 144) {
        const int part = rg >= 6 ? 2 : (rg >= 3 ? 1 : 0), hr = rg - 3 * part;
        const int col = part * 1024 + h * 128 + pcx * 8;
        const int ls = c * 64 + hr - 3;
        if (ls >= 0) v = *(const u32x4*)(PROJB + (size_t)(t0 + ls) * PROJW + col);
        else if (!prompt) {
            const float* s = p.in[2] + ((size_t)b * 3 + hr) * DN_QKV + col;
            const float4 a = *(const float4*)s, bb = *(const float4*)(s + 4);
            v.x = pack2(a.x, a.y); v.y = pack2(a.z, a.w); v.z = pack2(bb.x, bb.y); v.w = pack2(bb.z, bb.w);
        }
    }
    raw[6] = v;
}

__device__ __forceinline__ void dn_prep_item(const Params& p, LAS unsigned char* lds, int item) {
    unsigned char* ws = p.ws;
    const float* SMALL = (const float*)(ws + WS_SMALL);
    const float* conv_w = p.in[11];
    const int tid = tidx(), lane = tid & 63, wv = tid >> 6, r = lane & 15, q = lane >> 4;
    bool prompt; int b, h, c; dn_item_decode(item, prompt, b, h, c);
    const int nvalid = prompt ? 64 : DECS, t0 = prompt ? b * SEQ : TP + b * DECS;
    unsigned char* ib = ws + WS_DNI + (size_t)item * DN_ITEM_BYTES;
    bf16* UT = (bf16*)ib; bf16* WT = (bf16*)(ib + 16384); bf16* QD = (bf16*)(ib + 32768); bf16* KDT = (bf16*)(ib + 49152); bf16* ATT = (bf16*)(ib + 65536);
    LAS float* SC = (LAS float*)(lds + DP_SC);
    LAS float* LF = (LAS float*)(lds + DP_LF);
    const float Ah = -__expf(p.in[12][h]), dtb = p.in[13][h];

    __syncthreads();
    {
        u32x4 raw[7];
        dn_load_raw(p, item, raw);
        const int pcx = tid & 15, rg = tid >> 4;
#pragma unroll
        for (int i = 0; i < 6; ++i) *(LAS u32x4*)(lds + DP_RAW + ((i & 1) * 32 + rg + 3) * DP_RAWS + ((i >> 1) * 16 + pcx) * 16) = raw[i];
        if (tid < 144) { const int part = rg >= 6 ? 2 : (rg >= 3 ? 1 : 0), hr = rg - 3 * part; *(LAS u32x4*)(lds + DP_RAW + hr * DP_RAWS + (part * 16 + pcx) * 16) = raw[6]; }
    }
    for (int i = tid; i < (64 * 144 + 4 * 16 * 17 * 4 + 64 * 80) / 4; i += NT) ((LAS unsigned*)(lds + DP_LB))[i] = 0u;
    if (wv == 0) {
        const int l = lane; const bool valid = l < nvalid;
        const size_t t = (size_t)(t0 + c * 64 + (valid ? l : 0));
        const float beta = valid ? sigmoid_f(SMALL[t * 32 + h]) : 0.f;
        float gc = valid ? Ah * softplus_f(SMALL[t * 32 + 8 + h] + dtb) : 0.f;
#pragma unroll
        for (int o = 1; o < 64; o <<= 1) { const float up = __shfl_up(gc, o); if (lane >= o) gc += up; }
        const float last = __shfl(gc, 63);
        SC[l] = beta; SC[64 + l] = gc; SC[128 + l] = __expf(gc); SC[192 + l] = __expf(last - gc);
        if (lane == 0) ((float*)(ws + WS_DNGT))[item] = __expf(last);
    }
    __syncthreads();
    {
        const int l = tid >> 3, ch = tid & 7;
        const bool valid = l < nvalid;
        const float beta = SC[l], egc = SC[128 + l];
#pragma unroll 1
        for (int part = 2; part >= 0; --part) {
            float acc[16];
#pragma unroll
            for (int k = 0; k < 16; ++k) acc[k] = 0.f;
            const int col = part * 1024 + h * 128 + ch * 16;
#pragma unroll
            for (int tp = 0; tp < 4; ++tp) {
                const LAS unsigned char* rp = lds + DP_RAW + (l + tp) * DP_RAWS + (part * 16 + ch * 2) * 16;
                const u32x4 r0 = *(const LAS u32x4*)rp, r1 = *(const LAS u32x4*)(rp + 16);
                const float* wp = conv_w + tp * DN_QKV + col;
                const float4 w0 = *(const float4*)wp, w1 = *(const float4*)(wp + 4), w2 = *(const float4*)(wp + 8), w3 = *(const float4*)(wp + 12);
                acc[0] += w0.x * __uint_as_float(r0.x << 16); acc[1] += w0.y * __uint_as_float(r0.x & 0xffff0000u);
                acc[2] += w0.z * __uint_as_float(r0.y << 16); acc[3] += w0.w * __uint_as_float(r0.y & 0xffff0000u);
                acc[4] += w1.x * __uint_as_float(r0.z << 16); acc[5] += w1.y * __uint_as_float(r0.z & 0xffff0000u);
                acc[6] += w1.z * __uint_as_float(r0.w << 16); acc[7] += w1.w * __uint_as_float(r0.w & 0xffff0000u);
                acc[8] += w2.x * __uint_as_float(r1.x << 16); acc[9] += w2.y * __uint_as_float(r1.x & 0xffff0000u);
                acc[10] += w2.z * __uint_as_float(r1.y << 16); acc[11] += w2.w * __uint_as_float(r1.y & 0xffff0000u);
                acc[12] += w3.x * __uint_as_float(r1.z << 16); acc[13] += w3.y * __uint_as_float(r1.z & 0xffff0000u);
                acc[14] += w3.z * __uint_as_float(r1.w << 16); acc[15] += w3.w * __uint_as_float(r1.w & 0xffff0000u);
            }
            float ss = 0.f;
#pragma unroll
            for (int k = 0; k < 16; ++k) { acc[k] = valid ? silu_f(acc[k]) : 0.f; ss += acc[k] * acc[k]; }
            ss += __shfl_xor(ss, 1); ss += __shfl_xor(ss, 2); ss += __shfl_xor(ss, 4);
            const float sc = part == 2 ? 1.0f : (part == 1 ? rsqrtf(ss + 1e-6f) : rsqrtf(ss + 1e-6f) * 0.08838834764831845f);
            const float sc2 = part == 1 ? beta : egc;
            const int off = l * DP_TS + ch * 32;
#pragma unroll
            for (int hh = 0; hh < 2; ++hh) {
                unsigned w1[4], w2[4];
#pragma unroll
                for (int k = 0; k < 4; ++k) {
                    const float a0 = acc[hh * 8 + 2 * k] * sc, a1 = acc[hh * 8 + 2 * k + 1] * sc;
                    w1[k] = pack2(a0, a1); w2[k] = pack2(a0 * sc2, a1 * sc2);
                }
                const u32x4 o1 = (u32x4){w1[0], w1[1], w1[2], w1[3]}, o2 = (u32x4){w2[0], w2[1], w2[2], w2[3]};
                if (part == 2) *(LAS u32x4*)(lds + DP_VN + off + hh * 16) = o1;
                else if (part == 1) { *(LAS u32x4*)(lds + DP_KN + off + hh * 16) = o1; *(LAS u32x4*)(lds + DP_KB + off + hh * 16) = o2; }
                else { *(LAS u32x4*)(lds + DP_QN + off + hh * 16) = o1; *(u32x4*)(QD + l * 128 + ch * 16 + hh * 8) = o2; }
            }
        }
    }
    __syncthreads();
    for (int tile = wv; tile < 20; tile += 8) {
        const int id = tile % 10, isqk = tile / 10;
        int it = 0, jt = id; while (jt > it) { jt -= it + 1; ++it; }
        f32x4 acc = (f32x4){0.f, 0.f, 0.f, 0.f};
#pragma unroll
        for (int ks = 0; ks < 4; ++ks) {
            const bf16x8 a = frag_kc(lds + (isqk ? DP_QN : DP_KB), DP_TS, 16 * it, 32 * ks, r, q);
            const bf16x8 bb = frag_kc(lds + DP_KN, DP_TS, 16 * jt, 32 * ks, r, q);
            acc = __builtin_amdgcn_mfma_f32_16x16x32_bf16(a, bb, acc, 0, 0, 0);
        }
        const int j = 16 * jt + r;
        const float gcj = SC[64 + j];
#pragma unroll
        for (int jj = 0; jj < 4; ++jj) {
            const int i = 16 * it + 4 * q + jj;
            const float dec = __expf(SC[64 + i] - gcj);
            if (isqk) { ATT[i * 64 + j] = f2bf(j <= i ? acc[jj] * dec : 0.f); }
            else {
                const float lv = (j < i) ? acc[jj] * dec : 0.f;
                *(LAS bf16*)(lds + DP_LB + i * DP_LS + j * 2) = f2bf(-lv);
                if (it == jt) LF[(it * 16 + (4 * q + jj)) * 17 + r] = lv;
            }
        }
    }
    if (wv >= 4) {
        for (int e = tid - 256; e < 6 * 256; e += 256) {
            const int tix = e >> 8, w = e & 255; const int it = tix < 3 ? 0 : (tix < 5 ? 1 : 2), jt = tix < 3 ? tix + 1 : (tix < 5 ? tix - 1 : 3);
            ATT[(16 * it + (w >> 4)) * 64 + 16 * jt + (w & 15)] = 0;
        }
    }
    __syncthreads();
    if (wv == 0) {
        const int blk = lane >> 4, col = lane & 15;
        const LAS float* Lb = LF + blk * 16 * 17;
        float x[16];
#pragma unroll
        for (int k = 0; k < 16; ++k) {
            float s = (k == col) ? 1.f : 0.f;
#pragma unroll
            for (int m = 0; m < k; ++m) s -= Lb[k * 17 + m] * x[m];
            x[k] = s;
        }
#pragma unroll
        for (int k = 0; k < 16; ++k) *(LAS bf16*)(lds + DP_TD + (16 * blk + k) * DP_TDS + col * 2) = f2bf(x[k]);
    }
    {
        const int d = tid >> 2, lq = tid & 3;
        unsigned w[8];
#pragma unroll
        for (int k = 0; k < 8; ++k) {
            const int l0 = 16 * lq + 2 * k;
            const float a = bf2f(*(const LAS bf16*)(lds + DP_KN + l0 * DP_TS + d * 2)) * SC[192 + l0];
            const float bb = bf2f(*(const LAS bf16*)(lds + DP_KN + (l0 + 1) * DP_TS + d * 2)) * SC[192 + l0 + 1];
            w[k] = pack2(a, bb);
        }
        *(u32x4*)(KDT + d * 64 + 16 * lq) = (u32x4){w[0], w[1], w[2], w[3]};
        *(u32x4*)(KDT + d * 64 + 16 * lq + 8) = (u32x4){w[4], w[5], w[6], w[7]};
    }
    __syncthreads();
    const f32x4 zero4 = (f32x4){0.f, 0.f, 0.f, 0.f};
#pragma unroll
    for (int cc = 0; cc < 2; ++cc) {
        const int ct = 2 * wv + cc;
        const bool isw = ct >= 8;
        const int colb = (ct & 7) * 16 + r;
        f32x4 R[4];
#pragma unroll
        for (int I = 0; I < 4; ++I)
#pragma unroll
            for (int jj = 0; jj < 4; ++jj) {
                const int row = 16 * I + 4 * q + jj;
                R[I][jj] = isw ? bf2f(*(const LAS bf16*)(lds + DP_KB + row * DP_TS + colb * 2)) * SC[128 + row]
                               : bf2f(*(const LAS bf16*)(lds + DP_VN + row * DP_TS + colb * 2)) * SC[row];
            }
        f32x4 X[4];
        X[0] = __builtin_amdgcn_mfma_f32_16x16x32_bf16(frag_kc_pk(lds + DP_TD, DP_TDS, 0, 0, r, q), pack8(R[0], zero4), zero4, 0, 0, 0);
        f32x4 a1 = __builtin_amdgcn_mfma_f32_16x16x32_bf16(frag_kc_pk(lds + DP_LB, DP_LS, 16, 0, r, q), pack8(X[0], zero4), R[1], 0, 0, 0);
        X[1] = __builtin_amdgcn_mfma_f32_16x16x32_bf16(frag_kc_pk(lds + DP_TD, DP_TDS, 16, 0, r, q), pack8(a1, zero4), zero4, 0, 0, 0);
        f32x4 a2 = __builtin_amdgcn_mfma_f32_16x16x32_bf16(frag_kc_pk(lds + DP_LB, DP_LS, 32, 0, r, q), pack8(X[0], X[1]), R[2], 0, 0, 0);
        X[2] = __builtin_amdgcn_mfma_f32_16x16x32_bf16(frag_kc_pk(lds + DP_TD, DP_TDS, 32, 0, r, q), pack8(a2, zero4), zero4, 0, 0, 0);
        f32x4 a3 = __builtin_amdgcn_mfma_f32_16x16x32_bf16(frag_kc_pk(lds + DP_LB, DP_LS, 48, 0, r, q), pack8(X[0], X[1]), R[3], 0, 0, 0);
        a3 = __builtin_amdgcn_mfma_f32_16x16x32_bf16(frag_kc_pk(lds + DP_LB, DP_LS, 48, 32, r, q), pack8(X[2], zero4), a3, 0, 0, 0);
        X[3] = __builtin_amdgcn_mfma_f32_16x16x32_bf16(frag_kc_pk(lds + DP_TD, DP_TDS, 48, 0, r, q), pack8(a3, zero4), zero4, 0, 0, 0);
        bf16* dst = (isw ? WT : UT) + colb * 64;
#pragma unroll
        for (int I = 0; I < 4; ++I) { u32x2 w; w.x = pack2(X[I][0], X[I][1]); w.y = pack2(X[I][2], X[I][3]); *(u32x2*)(dst + 16 * I + 4 * q) = w; }
    }
}

constexpr int DS_ST = 0, DS_STS = 272;
constexpr int DS_WT = DS_ST + 64 * 272, DS_WTS = 160;
constexpr int DS_QD = DS_WT + 128 * 160, DS_QDS = 272;
constexpr int DS_AT = DS_QD + 64 * 272, DS_ATS = 144;
constexpr int DS_KD = DS_AT + 64 * 144, DS_KDS = 144;
constexpr int DS_UT = DS_KD + 2 * 128 * 144, DS_UTS = 144;
constexpr int DS_END = DS_UT + 64 * 144;

__device__ __forceinline__ void dn_load_item(const unsigned char* ib, int half, u32x4 (&rg)[8]) {
    const int tid = tidx();
#pragma unroll
    for (int i = 0; i < 2; ++i) rg[i] = *(const u32x4*)(ib + 16384 + (size_t)(tid + NT * i) * 16);
#pragma unroll
    for (int i = 0; i < 2; ++i) rg[2 + i] = *(const u32x4*)(ib + 32768 + (size_t)(tid + NT * i) * 16);
#pragma unroll
    for (int i = 0; i < 2; ++i) rg[4 + i] = *(const u32x4*)(ib + 49152 + (size_t)(tid + NT * i) * 16);
    rg[6] = *(const u32x4*)(ib + 65536 + (size_t)tid * 16);
    rg[7] = *(const u32x4*)(ib + (size_t)half * 8192 + (size_t)tid * 16);
}
__device__ __forceinline__ void dn_store_item_lds(LAS unsigned char* lds, const u32x4 (&rg)[8], int kdbuf) {
    const int tid = tidx();
#pragma unroll
    for (int i = 0; i < 2; ++i) { const int e = tid + NT * i; *(LAS u32x4*)(lds + DS_WT + (e >> 3) * DS_WTS + (e & 7) * 16) = rg[i]; }
#pragma unroll
    for (int i = 0; i < 2; ++i) { const int e = tid + NT * i; *(LAS u32x4*)(lds + DS_QD + (e >> 4) * DS_QDS + (e & 15) * 16) = rg[2 + i]; }
#pragma unroll
    for (int i = 0; i < 2; ++i) { const int e = tid + NT * i; *(LAS u32x4*)(lds + DS_KD + kdbuf * 128 * DS_KDS + (e >> 3) * DS_KDS + (e & 7) * 16) = rg[4 + i]; }
    *(LAS u32x4*)(lds + DS_AT + (tid >> 3) * DS_ATS + (tid & 7) * 16) = rg[6];
    *(LAS u32x4*)(lds + DS_UT + (tid >> 3) * DS_UTS + (tid & 7) * 16) = rg[7];
}

__device__ __forceinline__ void dn_scan_stream(const Params& p, LAS unsigned char* lds, bool prompt, int b, int h, int half, bf16* ODN) {
    unsigned char* ws = p.ws;
    const int tid = tidx(), lane = tid & 63, wv = tid >> 6, r = lane & 15, q = lane >> 4;
    const int nchunks = prompt ? 32 : 1, nvalid = prompt ? 64 : DECS, t0 = prompt ? b * SEQ : TP + b * DECS;
    const int item0 = prompt ? ((b * 8 + h) * 32) : (2048 + b * 8 + h);
    const float* GT = (const float*)(ws + WS_DNGT);
    const int et = wv & 3, hf = wv >> 2;
    f32x4 Sacc[4];
#pragma unroll
    for (int i = 0; i < 4; ++i) {
        if (prompt) Sacc[i] = (f32x4){0.f, 0.f, 0.f, 0.f};
        else {
            const float* s0 = p.in[3] + (((size_t)b * 8 + h) * 128 + 16 * (4 * hf + i) + 4 * q) * 128 + 64 * half + 16 * et + r;
            Sacc[i] = (f32x4){s0[0], s0[128], s0[256], s0[384]};
        }
    }
    __syncthreads();
#pragma unroll
    for (int i = 0; i < 4; ++i) {
        u32x2 w; w.x = pack2(Sacc[i][0], Sacc[i][1]); w.y = pack2(Sacc[i][2], Sacc[i][3]);
        *(LAS u32x2*)(lds + DS_ST + (16 * et + r) * DS_STS + (16 * (4 * hf + i) + 4 * q) * 2) = w;
    }
    u32x4 rg[8];
    dn_load_item(ws + WS_DNI + (size_t)item0 * DN_ITEM_BYTES, half, rg);
    dn_store_item_lds(lds, rg, 0);
    if (nchunks > 1) dn_load_item(ws + WS_DNI + (size_t)(item0 + 1) * DN_ITEM_BYTES, half, rg);
    for (int c = 0; c < nchunks; ++c) {
        const float gtot = GT[item0 + c];
        __syncthreads();
        f32x4 vn[4];
#pragma unroll
        for (int lt = 0; lt < 4; ++lt) vn[lt] = (f32x4){0.f, 0.f, 0.f, 0.f};
        bf16x8 sB[4];
#pragma unroll
        for (int ks = 0; ks < 4; ++ks) sB[ks] = frag_kc_pk(lds + DS_ST, DS_STS, 16 * et, 32 * ks, r, q);
#pragma unroll
        for (int ks = 0; ks < 4; ++ks)
#pragma unroll
            for (int lt = 0; lt < 4; ++lt) {
                const bf16x8 a = frag_tr(lds + DS_WT, DS_WTS, 32 * ks, 16 * lt, r, q);
                vn[lt] = __builtin_amdgcn_mfma_f32_16x16x32_bf16(a, sB[ks], vn[lt], 0, 0, 0);
            }
#pragma unroll
        for (int lt = 0; lt < 4; ++lt) {
            const u32x2 uu = *(const LAS u32x2*)(lds + DS_UT + (16 * et + r) * DS_UTS + (16 * lt + 4 * q) * 2);
            vn[lt][0] = __uint_as_float(uu.x << 16) - vn[lt][0]; vn[lt][1] = __uint_as_float(uu.x & 0xffff0000u) - vn[lt][1];
            vn[lt][2] = __uint_as_float(uu.y << 16) - vn[lt][2]; vn[lt][3] = __uint_as_float(uu.y & 0xffff0000u) - vn[lt][3];
        }
        const bf16x8 vB0 = pack8(vn[0], vn[1]), vB1 = pack8(vn[2], vn[3]);
#pragma unroll
        for (int li = 0; li < 2; ++li) {
            const int lt = 2 * hf + li;
            f32x4 o = (f32x4){0.f, 0.f, 0.f, 0.f};
#pragma unroll
            for (int ks = 0; ks < 4; ++ks) o = __builtin_amdgcn_mfma_f32_16x16x32_bf16(frag_kc_pk(lds + DS_QD, DS_QDS, 16 * lt, 32 * ks, r, q), sB[ks], o, 0, 0, 0);
            o = __builtin_amdgcn_mfma_f32_16x16x32_bf16(frag_kc_pk(lds + DS_AT, DS_ATS, 16 * lt, 0, r, q), vB0, o, 0, 0, 0);
            o = __builtin_amdgcn_mfma_f32_16x16x32_bf16(frag_kc_pk(lds + DS_AT, DS_ATS, 16 * lt, 32, r, q), vB1, o, 0, 0, 0);
#pragma unroll
            for (int j = 0; j < 4; ++j) {
                const int l = 16 * lt + 4 * q + j;
                if (l < nvalid) ODN[(size_t)(t0 + c * 64 + l) * 1024 + h * 128 + 64 * half + 16 * et + r] = f2bf(o[j]);
            }
        }
        __syncthreads();
#pragma unroll
        for (int i = 0; i < 4; ++i) {
            const int dt = 4 * hf + i;
            f32x4 acc = Sacc[i] * gtot;
            acc = __builtin_amdgcn_mfma_f32_16x16x32_bf16(frag_kc_pk(lds + DS_KD + (c & 1) * 128 * DS_KDS, DS_KDS, 16 * dt, 0, r, q), vB0, acc, 0, 0, 0);
            acc = __builtin_amdgcn_mfma_f32_16x16x32_bf16(frag_kc_pk(lds + DS_KD + (c & 1) * 128 * DS_KDS, DS_KDS, 16 * dt, 32, r, q), vB1, acc, 0, 0, 0);
            Sacc[i] = acc;
            u32x2 w; w.x = pack2(acc[0], acc[1]); w.y = pack2(acc[2], acc[3]);
            *(LAS u32x2*)(lds + DS_ST + (16 * et + r) * DS_STS + (16 * dt + 4 * q) * 2) = w;
        }
        if (c + 1 < nchunks) {
            dn_store_item_lds(lds, rg, (c + 1) & 1);
            if (c + 2 < nchunks) dn_load_item(ws + WS_DNI + (size_t)(item0 + c + 2) * DN_ITEM_BYTES, half, rg);
        }
    }
    float* so = p.out + (prompt ? O_P_DN : O_S_DN) + (((size_t)b * 8 + h) * 128) * 128;
#pragma unroll
    for (int i = 0; i < 4; ++i)
#pragma unroll
        for (int j = 0; j < 4; ++j) so[(size_t)(16 * (4 * hf + i) + 4 * q + j) * 128 + 64 * half + 16 * et + r] = Sacc[i][j];
}

__device__ __forceinline__ void mix_norm_phase(const Params& p, const bf16* ODN, const bf16* YGB) {
    unsigned char* ws = p.ws;
    const bf16* PROJB = (const bf16*)(ws + WS_PROJB);
    bf16* OCATB = (bf16*)(ws + WS_OCATB);
    const int lane = tidx() & 63, wv = tidx() >> 6;
    const float* dnw = p.in[14]; const float* ssw = p.in[20];
    for (int t = blockIdx.x * 8 + wv; t < T; t += gridDim.x * 8) {
        {
            const u32x4 a = *(const u32x4*)(ODN + (size_t)t * 1024 + 16 * lane), bq = *(const u32x4*)(ODN + (size_t)t * 1024 + 16 * lane + 8);
            const u32x4 za = *(const u32x4*)(PROJB + (size_t)t * PROJW + 4608 + 16 * lane), zb = *(const u32x4*)(PROJB + (size_t)t * PROJW + 4608 + 16 * lane + 8);
            const unsigned w[8] = {a.x, a.y, a.z, a.w, bq.x, bq.y, bq.z, bq.w}, zw[8] = {za.x, za.y, za.z, za.w, zb.x, zb.y, zb.z, zb.w};
            float v[16]; float ss = 0.f;
#pragma unroll
            for (int i = 0; i < 8; ++i) { v[2 * i] = __uint_as_float(w[i] << 16); v[2 * i + 1] = __uint_as_float(w[i] & 0xffff0000u); ss += v[2 * i] * v[2 * i] + v[2 * i + 1] * v[2 * i + 1]; }
            ss += __shfl_xor(ss, 1); ss += __shfl_xor(ss, 2); ss += __shfl_xor(ss, 4);
            const float rstd = rsqrtf(ss * (1.0f / 128.0f) + 1e-6f);
            unsigned o[8];
#pragma unroll
            for (int i = 0; i < 8; ++i) {
                const int cw = (16 * lane + 2 * i) & 127;
                const float z0 = __uint_as_float(zw[i] << 16), z1 = __uint_as_float(zw[i] & 0xffff0000u);
                o[i] = pack2(v[2 * i] * rstd * dnw[cw] * silu_f(z0), v[2 * i + 1] * rstd * dnw[cw + 1] * silu_f(z1));
            }
            *(u32x4*)(OCATB + (size_t)t * 2048 + 16 * lane) = (u32x4){o[0], o[1], o[2], o[3]};
            *(u32x4*)(OCATB + (size_t)t * 2048 + 16 * lane + 8) = (u32x4){o[4], o[5], o[6], o[7]};
        }
        {
            const u32x4 a = *(const u32x4*)(YGB + (size_t)t * 1024 + 16 * lane), bq = *(const u32x4*)(YGB + (size_t)t * 1024 + 16 * lane + 8);
            const unsigned w[8] = {a.x, a.y, a.z, a.w, bq.x, bq.y, bq.z, bq.w};
            float v[16]; float ss = 0.f;
#pragma unroll
            for (int i = 0; i < 8; ++i) { v[2 * i] = __uint_as_float(w[i] << 16); v[2 * i + 1] = __uint_as_float(w[i] & 0xffff0000u); ss += v[2 * i] * v[2 * i] + v[2 * i + 1] * v[2 * i + 1]; }
            ss += __shfl_xor(ss, 1); ss += __shfl_xor(ss, 2); ss += __shfl_xor(ss, 4); ss += __shfl_xor(ss, 8); ss += __shfl_xor(ss, 16);
            const float rstd = rsqrtf(ss * (1.0f / 512.0f) + 1e-6f);
            unsigned o[8];
#pragma unroll
            for (int i = 0; i < 8; ++i) { const int cw = 16 * lane + 2 * i; o[i] = pack2(v[2 * i] * rstd * ssw[cw], v[2 * i + 1] * rstd * ssw[cw + 1]); }
            *(u32x4*)(OCATB + (size_t)t * 2048 + 1024 + 16 * lane) = (u32x4){o[0], o[1], o[2], o[3]};
            *(u32x4*)(OCATB + (size_t)t * 2048 + 1024 + 16 * lane + 8) = (u32x4){o[4], o[5], o[6], o[7]};
        }
    }
    for (int s = blockIdx.x; s < 8 + 128; s += gridDim.x) {
        const bool prompt = s < 8; const int b = prompt ? s : s - 8;
        const int tlast = prompt ? (b * SEQ + SEQ - 3) : (TP + b * DECS + DECS - 3);
        float* dnc = p.out + (prompt ? O_P_DNC : O_S_DNC) + (size_t)b * 3 * DN_QKV;
        float* sc = p.out + (prompt ? O_P_SC : O_S_SC) + (size_t)b * 3 * SSM_XBC;
        for (int i = tidx(); i < 3 * (DN_QKV + SSM_XBC); i += NT) {
            const int rr = i / (DN_QKV + SSM_XBC), cc = i - rr * (DN_QKV + SSM_XBC);
            const float v = bf2f(PROJB[(size_t)(tlast + rr) * PROJW + cc]);
            if (cc < DN_QKV) dnc[rr * DN_QKV + cc] = v; else sc[rr * SSM_XBC + (cc - DN_QKV)] = v;
        }
    }
}

constexpr int DSM_ACT = 0, DSM_RED = 8 * 384 * 4, DSM_SC = DSM_RED + 2 * 512 * 4, DSM_END = DSM_SC + 256;
__device__ __forceinline__ void dn_sample_item(const Params& p, LAS unsigned char* lds, int b, int h, bf16* ODN) {
    unsigned char* ws = p.ws;
    const bf16* PROJB = (const bf16*)(ws + WS_PROJB);
    const float* SMALL = (const float*)(ws + WS_SMALL);
    const float* conv_w = p.in[11];
    const int tid = tidx(), lane = tid & 63, wv = tid >> 6, j = tid & 127, iq = tid >> 7;
    LAS float* act = (LAS float*)(lds + DSM_ACT);
    LAS float* red = (LAS float*)(lds + DSM_RED); LAS float* sc = (LAS float*)(lds + DSM_SC);
    const int t0 = TP + b * DECS;
    const float Ah = -__expf(p.in[12][h]), dtb = p.in[13][h];
    float S[32];
    const float* s0 = p.in[3] + (((size_t)b * 8 + h) * 128 + 32 * iq) * 128 + j;
#pragma unroll
    for (int i = 0; i < 32; ++i) S[i] = s0[(size_t)i * 128];
    __syncthreads();
#pragma unroll
    for (int it = 0; it < 6; ++it) {
        const int e = tid + NT * it, l = e / 384, cl3 = e - l * 384, part = cl3 >> 7, col = part * 1024 + h * 128 + (cl3 & 127);
        float a = 0.f;
#pragma unroll
        for (int tp = 0; tp < 4; ++tp) {
            const int ls = l - 3 + tp;
            const float x = ls >= 0 ? bf2f(PROJB[(size_t)(t0 + ls) * PROJW + col]) : bf2f(f2bf(p.in[2][((size_t)b * 3 + (3 + ls)) * DN_QKV + col]));
            a += conv_w[tp * DN_QKV + col] * x;
        }
        act[e] = silu_f(a);
    }
    if (tid < 8) { const size_t t = (size_t)(t0 + tid); sc[16 + tid] = sigmoid_f(SMALL[t * 32 + h]); sc[24 + tid] = __expf(Ah * softplus_f(SMALL[t * 32 + 8 + h] + dtb)); }
    __syncthreads();
    {
        const float q0 = act[wv * 384 + lane], q1 = act[wv * 384 + 64 + lane], k0 = act[wv * 384 + 128 + lane], k1 = act[wv * 384 + 192 + lane];
        const float sq = wave_sum_u(q0 * q0 + q1 * q1), sk2 = wave_sum_u(k0 * k0 + k1 * k1);
        if (lane == 0) { sc[wv] = rsqrtf(sq + 1e-6f) * 0.08838834764831845f; sc[8 + wv] = rsqrtf(sk2 + 1e-6f); }
    }
    __syncthreads();
    for (int l = 0; l < DECS; ++l) {
        const LAS float* qs = act + l * 384; const LAS float* ks = qs + 128; const LAS float* vs = qs + 256;
        LAS float* rd = red + (l & 1) * 512;
        const float rq = sc[l], rk = sc[8 + l], beta = sc[16 + l], a = sc[24 + l];
        float sk = 0.f;
#pragma unroll
        for (int i = 0; i < 32; ++i) { S[i] *= a; sk += S[i] * ks[32 * iq + i]; }
        rd[iq * 128 + j] = sk * rk;
        __syncthreads();
        const float delta = beta * (vs[j] - (rd[j] + rd[128 + j] + rd[256 + j] + rd[384 + j]));
        float o = 0.f;
#pragma unroll
        for (int i = 0; i < 32; ++i) { S[i] += ks[32 * iq + i] * rk * delta; o += S[i] * qs[32 * iq + i]; }
        __syncthreads();
        rd[iq * 128 + j] = o * rq;
        __syncthreads();
        if (iq == 0) ODN[(size_t)(t0 + l) * 1024 + h * 128 + j] = f2bf(rd[j] + rd[128 + j] + rd[256 + j] + rd[384 + j]);
    }
    float* so = p.out + O_S_DN + (((size_t)b * 8 + h) * 128 + 32 * iq) * 128 + j;
#pragma unroll
    for (int i = 0; i < 32; ++i) so[(size_t)i * 128] = S[i];
}

#ifndef PROBE_REP
#define PROBE_REP -1
#endif
#ifndef MIX_YGF32
#define MIX_YGF32 false
#endif
constexpr size_t WS_YGB = WS_XN;
enum { PH_PROLOGUE = 0, PH_INPROJ = 1, PH_MIX_PREP = 2, PH_MIX_SCAN = 3, PH_MIX_NORM = 4, PH_WOUT = 5, PH_QKV = 6, PH_ATTN = 7, PH_WXO = 8, PH_PQ = 9, PH_PEER = 10, PH_PEER_U = 11, PH_PEER_C = 12, PH_PEER_V = 13, PH_FINAL = 14, PH_END = 15 };

__global__ void __launch_bounds__(NT, 2) mega(Params p) {
    extern __shared__ __attribute__((aligned(16))) unsigned char lds_raw[];
    LAS unsigned char* lds = (LAS unsigned char*)lds_raw;
    volatile LAS unsigned* misc = (volatile LAS unsigned*)(lds + LDS_MISC);
    if (threadIdx.x < 4) misc[threadIdx.x] = 0u;
    __syncthreads();
    unsigned char* ws = p.ws;
    XcdBarrier bar; bar.bar = (unsigned*)(ws + WS_CTL); bar.x = 0; bar.st = misc;
    if (p.use_bar) bar = xcd_barrier_post((unsigned*)(ws + WS_CTL), misc);
    float* SS1 = (float*)(ws + WS_CTL + CTL_SS1);
    float* SS2 = (float*)(ws + WS_CTL + CTL_SS2);
#define IN(k) (p.ph_lo <= (k) && (k) < p.ph_hi)
#define REPS(k) ((PROBE_REP == (k)) ? 2 : 1)
#define SEAM(k) do { if (p.use_bar && IN((k) + 1)) xcd_barrier(bar); } while (0)
    if (IN(PH_PROLOGUE)) { for (int rr = 0; rr < REPS(PH_PROLOGUE); ++rr) p0_prologue(p, lds); SEAM(PH_PROLOGUE); }
    if (IN(PH_INPROJ)) {
        EpiProj E{(bf16*)(ws + WS_PROJB), (float*)(ws + WS_SMALL)};
        for (int rr = 0; rr < REPS(PH_INPROJ); ++rr) run_gemm(lds, (const bf16*)(ws + WS_XN), (const bf16*)(ws + WS_WIN), T, NPAD, 1024, E);
        SEAM(PH_INPROJ);
    }
    bf16* ODN = (bf16*)(p.out + O_Y);
    bf16* YGB = ODN + (size_t)T * 1024;
    float* SCAL = (float*)(ws + WS_OCATB + (size_t)T * SSM_XBC * 2);
    bf16* XBCA = (bf16*)(ws + WS_OCATB);
    if (IN(PH_MIX_PREP)) {
        for (int rr = 0; rr < REPS(PH_MIX_PREP); ++rr) {
            for (int r2 = 0; r2 < REPS(102); ++r2) { ssd_conv_prepass(p, XBCA); ssd_scalar_prepass(p, SCAL); }
            for (int r2 = 0; r2 < REPS(103); ++r2) for (int item = blockIdx.x; item < 2048; item += gridDim.x) dn_prep_item(p, lds, item);
        }
        SEAM(PH_MIX_PREP);
    }
    if (IN(PH_MIX_SCAN)) {
        for (int rr = 0; rr < REPS(PH_MIX_SCAN); ++rr) {
            for (int r2 = 0; r2 < REPS(104); ++r2)
            for (int it = blockIdx.x; it < 256; it += gridDim.x) {
                if (it < 128) { for (int r3 = 0; r3 < REPS(105); ++r3) dn_scan_stream(p, lds, true, it >> 4, (it >> 1) & 7, it & 1, ODN); }
                else { for (int r3 = 0; r3 < REPS(106); ++r3) ssd_stream<false>(p, lds, true, (it - 128) >> 4, (it - 128) & 15, (void*)YGB, XBCA, SCAL); }
            }
            unsigned* qctr = (unsigned*)(ws + WS_CTL + CTL_QUEUE) + rr * 64;
            for (;;) {
                __syncthreads();
                if (threadIdx.x == 0) misc[8] = atomicAdd(qctr, 1u);
                __syncthreads();
                const int it = (int)misc[8];
                if (it >= 3072) break;
                if (it < 1024) dn_sample_item(p, lds, it >> 3, it & 7, ODN);
                else ssd_stream<false>(p, lds, false, (it - 1024) >> 4, (it - 1024) & 15, (void*)YGB, XBCA, SCAL);
            }
        }
        SEAM(PH_MIX_SCAN);
    }
    if (IN(PH_MIX_NORM)) { for (int rr = 0; rr < REPS(PH_MIX_NORM); ++rr) mix_norm_phase(p, ODN, YGB); SEAM(PH_MIX_NORM); }
    if (IN(PH_WOUT)) {
        EpiRes E{p.in[0], p.in[1], (float*)(ws + (p.pad ? WS_MIX + (size_t)90 * 1048576 : WS_H)), (bf16*)(ws + (p.pad ? WS_MIX + (size_t)165 * 1048576 : WS_HB)), p.pad ? (float*)(ws + WS_MIX + (size_t)210 * 1048576) : SS1};
        run_gemm(lds, (const bf16*)(ws + WS_OCATB), (const bf16*)(ws + WS_WOUT), T, 1024, 2048, E);
        SEAM(PH_WOUT);
    }
    if (IN(PH_QKV)) {
        EpiScale E{(bf16*)(ws + WS_QB), 1024, SS1, 0.0625f};
        EpiMkv E2{p.out + O_P_MK, p.out + O_P_MV, (bf16*)(ws + WS_MKB), (bf16*)(ws + WS_MVB)};
        for (int rr = 0; rr < REPS(PH_QKV); ++rr) {
        run_gemm(lds, (const bf16*)(ws + WS_HB), (const bf16*)(ws + WS_WXQ), T, 1024, 1024, E);
        run_gemm(lds, (const bf16*)(ws + WS_MEMN), (const bf16*)(ws + WS_WMKV), 2048, 2048, 1024, E2, 16);
        }
        SEAM(PH_QKV);
    }
    if (IN(PH_ATTN)) { for (int rr = 0; rr < REPS(PH_ATTN); ++rr) attn_phase(p, lds); SEAM(PH_ATTN); }
    if (IN(PH_WXO)) {
        EpiRes E{(const float*)(ws + WS_H), (const float*)(ws + WS_H) + (size_t)TP * 1024, (float*)(ws + (p.pad ? WS_MIX + (size_t)90 * 1048576 : WS_H)), (bf16*)(ws + (p.pad ? WS_MIX + (size_t)165 * 1048576 : WS_HB)), p.pad ? (float*)(ws + WS_MIX + (size_t)210 * 1048576) : SS2};
        run_gemm(lds, (const bf16*)(ws + WS_OB), (const bf16*)(ws + WS_WXO), T, 1024, 1024, E);
        SEAM(PH_WXO);
    }
    if (IN(PH_PQ)) {
        EpiScale E{(bf16*)(ws + WS_PQB), 2048, SS2, 1.0f};
        for (int rr = 0; rr < REPS(PH_PQ); ++rr) run_gemm(lds, (const bf16*)(ws + WS_HB), (const bf16*)(ws + WS_WPQ), T, 2048, 1024, E);
        SEAM(PH_PQ);
    }
    if (IN(PH_PEER)) { for (int rr = 0; rr < REPS(PH_PEER); ++rr) peer_select_phase(p, lds); SEAM(PH_PEER); }
    if (IN(PH_PEER_U)) { for (int rr = 0; rr < REPS(PH_PEER_U); ++rr) peer_u_phase(p, lds); SEAM(PH_PEER_U); }
    if (IN(PH_PEER_C)) { peer_coef_phase(p); SEAM(PH_PEER_C); }
    if (IN(PH_PEER_V)) { peer_v_phase(p, lds); SEAM(PH_PEER_V); }
    if (IN(PH_FINAL)) { for (int rr = 0; rr < REPS(PH_FINAL); ++rr) final_norm_phase(p); }
#undef IN
#undef SEAM
}

__global__ void __launch_bounds__(256) cvt_bf16_to_f32(const bf16* __restrict__ s, float* __restrict__ d, size_t n) {
    for (size_t i = (size_t)blockIdx.x * 256 + threadIdx.x; i < n; i += (size_t)gridDim.x * 256) d[i] = bf2f(s[i]);
}
__global__ void __launch_bounds__(256) cvt_f32_to_bf16(const float* __restrict__ s, bf16* __restrict__ d, size_t n) {
    for (size_t i = (size_t)blockIdx.x * 256 + threadIdx.x; i < n; i += (size_t)gridDim.x * 256) d[i] = f2bf(s[i]);
}
}

static int g_grid = 0;
static void mega_setup() {
    if (g_grid) return;
    int dev = 0, cus = 0, per_cu = 0;
    hipGetDevice(&dev);
    hipDeviceGetAttribute(&cus, hipDeviceAttributeMultiprocessorCount, dev);
    hipFuncSetAttribute((const void*)fk::mega, hipFuncAttributeMaxDynamicSharedMemorySize, fk::LDS_BYTES);
    hipOccupancyMaxActiveBlocksPerMultiprocessor(&per_cu, (const void*)fk::mega, fk::NT, fk::LDS_BYTES);
    if (per_cu < 1) { fprintf(stderr, "occupancy query says %d blocks/CU\n", per_cu); per_cu = 1; }
    (void)hipGetLastError();
    g_grid = cus;
}
static void mega_launch(hipStream_t s, const fk::Params& base, int lo, int hi, int use_bar, int dry = 0) {
    fk::Params p = base; p.ph_lo = lo; p.ph_hi = hi; p.use_bar = use_bar; p.pad = dry;
    hipLaunchKernelGGL(fk::mega, dim3(g_grid), dim3(fk::NT), fk::LDS_BYTES, s, p);
}
static void cvt_b2f(hipStream_t s, const void* src, float* dst, size_t n) { fk::cvt_bf16_to_f32<<<2048, 256, 0, s>>>((const fk::bf16*)src, dst, n); }
static void cvt_f2b(hipStream_t s, const float* src, void* dst, size_t n) { fk::cvt_f32_to_bf16<<<2048, 256, 0, s>>>(src, (fk::bf16*)dst, n); }

extern "C" void kernel_launch(void* const* d_in, const int* in_sizes, int n_in, void* d_out, int out_size, void* d_ws, size_t ws_size, hipStream_t stream) {
    mega_setup();
    fk::Params P{};
    for (int i = 0; i < 33; ++i) P.in[i] = (const float*)d_in[i];
    P.out = (float*)d_out; P.ws = (unsigned char*)d_ws;
    hipMemsetAsync((unsigned char*)d_ws + fk::WS_CTL, 0, fk::CTL_BYTES, stream);
    mega_launch(stream, P, 0, fk::PH_END, 1);
}
```
